# Optimizing an MI355X kernel written in HIP

```python
import jax
import jax.numpy as jnp
from jax import lax
import numpy as np


D_MODEL = 1024
BATCH = 8
SEQ = 4096
DEPTH = 4

GRID_W = 64
CTX_LEN = 256

A_HEAD_DIM = 64
A_HEADS = D_MODEL // (2 * A_HEAD_DIM)
A_KV_HEADS = A_HEADS // 4
WINDOW = 128
A_BLOCK = WINDOW
ROPE_BASE = 10000.0
ROPE_AXIS = A_HEAD_DIM // 2

B_DV = 64
B_DK = B_DV // 2
B_HEADS = D_MODEL // (4 * B_DV)
GLA_RANK = 16
GLA_TAU = 16.0
GLA_CHUNK = 16

C_DH = 64
C_HEADS = D_MODEL // (4 * C_DH)
MLSTM_CHUNK = 64
MLSTM_CONV = 3

A_OUT = A_HEADS * A_HEAD_DIM
A_KV = A_KV_HEADS * A_HEAD_DIM
B_KW = B_HEADS * B_DK
B_VW = B_HEADS * B_DV
C_W = C_HEADS * C_DH
MIX_WIDTH = A_OUT + B_VW + C_W
IN_SPLITS = (A_OUT, A_KV, A_KV, B_KW, B_KW, B_VW, B_VW, GLA_RANK, GLA_RANK, C_W, C_W, C_W, 4 * C_HEADS, C_W)
IN_WIDTH = A_OUT + 2 * A_KV + 2 * B_KW + 2 * B_VW + 2 * GLA_RANK + 4 * C_W + 4 * C_HEADS

D_FF = 2816
FFN_RES = 0.5
N_MOD = 9
EPS = 1e-6

kernel_name = 'hybrid_headgroup_diffusion_block'


def rms_norm(x, g):
    xf = x.astype(jnp.float32)
    y = xf * lax.rsqrt(jnp.mean(xf * xf, axis=-1, keepdims=True) + EPS)
    return (y * g.astype(jnp.float32)).astype(x.dtype)


def modulate(x, g, shift, scale):
    return rms_norm(x, g) * (1.0 + scale) + shift


def adaln_params(cvec, w, b):
    m = jax.nn.silu(cvec) @ w + b
    return m.reshape(m.shape[:-1] + (N_MOD, D_MODEL))


def swiglu(u, wg, wu, wd):
    return (jax.nn.silu(u @ wg) * (u @ wu)) @ wd


def ffn_sublayer(x, shift, scale, gate, g_pre, g_post, wg, wu, wd):
    y = swiglu(modulate(x, g_pre, shift, scale), wg, wu, wd)
    return x + FFN_RES * gate * rms_norm(y, g_post)


def split_cols(z):
    parts = []
    start = 0
    for w in IN_SPLITS:
        parts.append(z[..., start:start + w])
        start += w
    return parts


def to_heads(t, n_heads):
    b, t_len, _ = t.shape
    return t.reshape(b, t_len, n_heads, -1).transpose(0, 2, 1, 3)


def from_heads(t):
    b, h, t_len, d = t.shape
    return t.transpose(0, 2, 1, 3).reshape(b, t_len, h * d)


def head_layernorm(o, g):
    of = o.astype(jnp.float32)
    mu = jnp.mean(of, axis=-1, keepdims=True)
    var = jnp.mean(jnp.square(of - mu), axis=-1, keepdims=True)
    y = from_heads((of - mu) * lax.rsqrt(var + EPS))
    return (y * g.astype(jnp.float32)).astype(o.dtype)


def centred_dwconv(x, w):
    k_w = w.shape[0]
    pad = k_w // 2
    t_len = x.shape[1]
    xp = jnp.pad(x, ((0, 0), (pad, pad), (0, 0)))
    out = xp[:, 0:t_len] * w[0]
    for j in range(1, k_w):
        out = out + xp[:, j:j + t_len] * w[j]
    return out


def axial_rope_tables(row_ids, col_ids):
    half = ROPE_AXIS // 2
    inv_freq = ROPE_BASE ** (-jnp.arange(half, dtype=jnp.float32) / half)
    ang_r = row_ids.astype(jnp.float32)[:, None] * inv_freq[None, :]
    ang_c = col_ids.astype(jnp.float32)[:, None] * inv_freq[None, :]
    return (jnp.cos(ang_r)[:, None, :], jnp.sin(ang_r)[:, None, :],
            jnp.cos(ang_c)[:, None, :], jnp.sin(ang_c)[:, None, :])


def axial_rope(x, cos_r, sin_r, cos_c, sin_c):
    def rot(u, cs, sn):
        cs = cs.astype(u.dtype)
        sn = sn.astype(u.dtype)
        hh = u.shape[-1] // 2
        u1, u2 = u[..., :hh], u[..., hh:]
        return jnp.concatenate([u1 * cs - u2 * sn, u1 * sn + u2 * cs], axis=-1)
    return jnp.concatenate([rot(x[..., :ROPE_AXIS], cos_r, sin_r),
                            rot(x[..., ROPE_AXIS:], cos_c, sin_c)], axis=-1)


def windowed_attention(q, k, v, kc, vc, sink):
    b, s_len, hq, d = q.shape
    g = k.shape[2]
    r = hq // g
    nb = s_len // A_BLOCK
    scale = d ** -0.5
    qb = q.reshape(b, nb, A_BLOCK, g, r, d)
    pad = ((0, 0), (A_BLOCK, A_BLOCK), (0, 0), (0, 0))
    kp = jnp.pad(k, pad).reshape(b, nb + 2, A_BLOCK, g, d)
    vp = jnp.pad(v, pad).reshape(b, nb + 2, A_BLOCK, g, d)
    kw = jnp.concatenate([kp[:, :-2], kp[:, 1:-1], kp[:, 2:]], axis=2)
    vw = jnp.concatenate([vp[:, :-2], vp[:, 1:-1], vp[:, 2:]], axis=2)
    qi = jnp.arange(A_BLOCK)[:, None]
    kj = jnp.arange(3 * A_BLOCK)[None, :]
    band = jnp.abs(qi + A_BLOCK - kj) <= WINDOW
    k_abs = (jnp.arange(nb)[:, None] - 1) * A_BLOCK + kj
    mask = band[None] & ((k_abs >= 0) & (k_abs < s_len))[:, None, :]
    s_win = jnp.einsum('bnqgrd,bnkgd->bgrnqk', qb, kw).astype(jnp.float32) * scale
    s_win = jnp.where(mask, s_win, -jnp.inf)
    s_ctx = jnp.einsum('bnqgrd,bcgd->bgrnqc', qb, kc).astype(jnp.float32) * scale
    s_sink = sink.astype(jnp.float32).reshape(1, g, r, 1, 1)
    m = jnp.maximum(jnp.maximum(jnp.max(s_win, axis=-1), jnp.max(s_ctx, axis=-1)), s_sink)
    e_win = jnp.exp(s_win - m[..., None])
    e_ctx = jnp.exp(s_ctx - m[..., None])
    den = jnp.sum(e_win, axis=-1) + jnp.sum(e_ctx, axis=-1) + jnp.exp(s_sink - m)
    o = (jnp.einsum('bgrnqk,bnkgd->bgrnqd', e_win.astype(v.dtype), vw)
         + jnp.einsum('bgrnqc,bcgd->bgrnqd', e_ctx.astype(v.dtype), vc))
    o = o / den[..., None]
    return o.transpose(0, 3, 4, 1, 2, 5).reshape(b, s_len, hq * d).astype(v.dtype)


def context_attention(qc, kc, vc, sink):
    b, l_c, hq, d = qc.shape
    g = kc.shape[2]
    r = hq // g
    s = jnp.einsum('blgrd,bcgd->bgrlc', qc.reshape(b, l_c, g, r, d), kc).astype(jnp.float32) * d ** -0.5
    s_sink = jnp.broadcast_to(sink.astype(jnp.float32).reshape(1, g, r, 1, 1), s.shape[:-1] + (1,))
    p = jax.nn.softmax(jnp.concatenate([s, s_sink], axis=-1), axis=-1)[..., :l_c]
    o = jnp.einsum('bgrlc,bcgd->blgrd', p.astype(vc.dtype), vc)
    return o.reshape(b, l_c, hq * d)


def gla_chunked(q, k, v, log_a, state):
    b, h, t_len, dk = q.shape
    dv = v.shape[-1]
    lc = GLA_CHUNK
    n = t_len // lc
    qf = q.astype(jnp.float32).reshape(b, h, n, lc, dk)
    kf = k.astype(jnp.float32).reshape(b, h, n, lc, dk)
    vf = v.astype(jnp.float32).reshape(b, h, n, lc, dv)
    bcum = jnp.cumsum(log_a.astype(jnp.float32).reshape(b, h, n, lc, dk), axis=3)
    b_last = bcum[:, :, :, -1]
    causal = jnp.tril(jnp.ones((lc, lc), dtype=bool))[:, :, None]
    decay = jnp.exp(jnp.where(causal, bcum[:, :, :, :, None, :] - bcum[:, :, :, None, :, :], -jnp.inf))
    attn = jnp.einsum('bhntd,bhnsd,bhntsd->bhnts', qf, kf, decay)
    o_intra = jnp.einsum('bhnts,bhnsv->bhntv', attn, vf)
    s_loc = jnp.einsum('bhnsd,bhnsv->bhndv', kf * jnp.exp(b_last[:, :, :, None, :] - bcum), vf)

    def step(s, inp):
        bl, sl = inp
        return jnp.exp(bl)[..., None] * s + sl, s

    s_final, s_prev = lax.scan(step, state, (jnp.moveaxis(b_last, 2, 0), jnp.moveaxis(s_loc, 2, 0)))
    s_prev = jnp.moveaxis(s_prev, 0, 2)
    o = o_intra + jnp.einsum('bhntd,bhndv->bhntv', qf * jnp.exp(bcum), s_prev)
    return o.reshape(b, h, t_len, dv).astype(v.dtype), s_final


def mlstm_chunked(q, k, v, log_i, log_f, state):
    b, h, t_len, d = q.shape
    lc = MLSTM_CHUNK
    n_ch = t_len // lc
    qf = q.astype(jnp.float32).reshape(b, h, n_ch, lc, d)
    kf = k.astype(jnp.float32).reshape(b, h, n_ch, lc, d)
    vf = v.astype(jnp.float32).reshape(b, h, n_ch, lc, d)
    li = log_i.astype(jnp.float32).reshape(b, h, n_ch, lc)
    bcum = jnp.cumsum(log_f.astype(jnp.float32).reshape(b, h, n_ch, lc), axis=-1)
    b_last = bcum[..., -1]
    causal = jnp.tril(jnp.ones((lc, lc), dtype=bool))
    dmat = jnp.where(causal, bcum[..., :, None] - bcum[..., None, :] + li[..., None, :], -jnp.inf)
    g_end = b_last[..., None] - bcum + li
    m_loc = jnp.max(g_end, axis=-1)
    w_end = jnp.exp(g_end - m_loc[..., None])
    c_loc = jnp.einsum('bhns,bhnsv,bhnsk->bhnvk', w_end, vf, kf)
    n_loc = jnp.einsum('bhns,bhnsk->bhnk', w_end, kf)

    def step(carry, inp):
        c_st, n_st, m_st = carry
        bl, ml, cl, nl = inp
        m_new = jnp.maximum(bl + m_st, ml)
        a = jnp.exp(bl + m_st - m_new)
        e = jnp.exp(ml - m_new)
        c_new = a[..., None, None] * c_st + e[..., None, None] * cl
        n_new = a[..., None] * n_st + e[..., None] * nl
        return (c_new, n_new, m_new), (c_st, n_st, m_st)

    xs = (jnp.moveaxis(b_last, 2, 0), jnp.moveaxis(m_loc, 2, 0), jnp.moveaxis(c_loc, 2, 0), jnp.moveaxis(n_loc, 2, 0))
    final, (c_prev, n_prev, m_prev) = lax.scan(step, state, xs)
    c_prev = jnp.moveaxis(c_prev, 0, 2)
    n_prev = jnp.moveaxis(n_prev, 0, 2)
    m_prev = jnp.moveaxis(m_prev, 0, 2)
    inter = bcum + m_prev[..., None]
    m_t = jnp.maximum(inter, jnp.max(dmat, axis=-1))
    a_t = jnp.exp(inter - m_t)
    sc = jnp.einsum('bhntd,bhnsd->bhnts', qf, kf) * jnp.exp(dmat - m_t[..., None])
    num = a_t[..., None] * jnp.einsum('bhntk,bhnvk->bhntv', qf, c_prev) + jnp.einsum('bhnts,bhnsv->bhntv', sc, vf)
    den = a_t * jnp.einsum('bhntk,bhnk->bhnt', qf, n_prev) + jnp.sum(sc, axis=-1)
    hid = num / jnp.maximum(jnp.abs(den), jnp.exp(-m_t))[..., None]
    return hid.reshape(b, h, t_len, d).astype(v.dtype), final


def bidirectional(scan_fn, state0, lat, ctx, need_ctx):
    def flip(ts):
        return tuple(jnp.flip(t, axis=2) for t in ts)
    (cqkv, cgf, cgb), (lqkv, lgf, lgb) = ctx, lat
    oc_f, sc_f = scan_fn(*cqkv, *cgf, state0)
    oc_b, sc_b = scan_fn(*flip(cqkv), *flip(cgb), state0)
    o_f, _ = scan_fn(*lqkv, *lgf, sc_f)
    o_b, _ = scan_fn(*flip(lqkv), *flip(lgb), sc_b)
    o = o_f + jnp.flip(o_b, axis=2)
    oc = oc_f + jnp.flip(oc_b, axis=2) if need_ctx else None
    return o, oc


def token_mixing(u, uc, rope, w_in, b_in, w_out, sink, gla_wa, gla_ba, gla_g, conv_w, f_bias, mlstm_g, need_ctx):
    b, t_len, _ = u.shape
    l_c = uc.shape[1]
    pl = split_cols(u @ w_in + b_in)
    pc = split_cols(uc @ w_in + b_in)

    q = axial_rope(pl[0].reshape(b, t_len, A_HEADS, A_HEAD_DIM), *rope)
    k = axial_rope(pl[1].reshape(b, t_len, A_KV_HEADS, A_HEAD_DIM), *rope)
    v = pl[2].reshape(b, t_len, A_KV_HEADS, A_HEAD_DIM)
    kc = pc[1].reshape(b, l_c, A_KV_HEADS, A_HEAD_DIM)
    vc = pc[2].reshape(b, l_c, A_KV_HEADS, A_HEAD_DIM)
    y_a = windowed_attention(q, k, v, kc, vc, sink)

    def gla_inputs(p):
        qkv = (to_heads(p[3], B_HEADS) * B_DK ** -0.5, to_heads(p[4], B_HEADS), to_heads(p[5], B_HEADS))
        def gate(dirn):
            z = (p[7 + dirn] @ gla_wa[dirn] + gla_ba[dirn]).astype(jnp.float32)
            return (to_heads(jax.nn.log_sigmoid(z) / GLA_TAU, B_HEADS),)
        return qkv, gate(0), gate(1)
    gla_state0 = jnp.zeros((b, B_HEADS, B_DK, B_DV), jnp.float32)
    o_b, oc_b = bidirectional(gla_chunked, gla_state0, gla_inputs(pl), gla_inputs(pc), need_ctx)
    y_b = jax.nn.silu(pl[6]) * head_layernorm(o_b, gla_g)

    def mlstm_inputs(p):
        qk = jax.nn.silu(centred_dwconv(jnp.concatenate([p[9], p[10]], axis=-1), conv_w))
        qkv = (to_heads(qk[..., :C_W], C_HEADS), to_heads(qk[..., C_W:], C_HEADS) * C_DH ** -0.5, to_heads(p[11], C_HEADS))
        gt = p[12].astype(jnp.float32).reshape(p[12].shape[:2] + (4, C_HEADS)).transpose(2, 0, 3, 1)
        fwd = (gt[0], jax.nn.log_sigmoid(gt[1] + f_bias[0][None, :, None]))
        bwd = (gt[2], jax.nn.log_sigmoid(gt[3] + f_bias[1][None, :, None]))
        return qkv, fwd, bwd
    mstate0 = (jnp.zeros((b, C_HEADS, C_DH, C_DH), jnp.float32),
               jnp.zeros((b, C_HEADS, C_DH), jnp.float32),
               jnp.zeros((b, C_HEADS), jnp.float32))
    o_c, oc_c = bidirectional(mlstm_chunked, mstate0, mlstm_inputs(pl), mlstm_inputs(pc), need_ctx)
    y_c = jax.nn.sigmoid(pl[13]) * head_layernorm(o_c, mlstm_g)

    y = jnp.concatenate([y_a, y_b, y_c], axis=-1) @ w_out
    if not need_ctx:
        return y, None
    qc = pc[0].reshape(b, l_c, A_HEADS, A_HEAD_DIM)
    yc_a = context_attention(qc, kc, vc, sink)
    yc_b = jax.nn.silu(pc[6]) * head_layernorm(oc_b, gla_g)
    yc_c = jax.nn.sigmoid(pc[13]) * head_layernorm(oc_c, mlstm_g)
    yc = jnp.concatenate([yc_a, yc_b, yc_c], axis=-1) @ w_out
    return y, yc


def setup_inputs(seed: int = 0) -> dict:
    key = jax.random.key(seed)
    ks = jax.random.split(key, 24)

    def nrm(k, shape, s):
        return jax.random.normal(k, shape, jnp.float32) * s

    n_l = DEPTH
    return {
        'x': nrm(ks[0], (BATCH, SEQ, D_MODEL), 1.0),
        'c': nrm(ks[1], (BATCH, D_MODEL), 1.0),
        'ctx': nrm(ks[2], (BATCH, CTX_LEN, D_MODEL), 1.0),
        'c_ctx': nrm(ks[3], (D_MODEL,), 1.0),
        'ada_w': nrm(ks[4], (n_l, D_MODEL, N_MOD * D_MODEL), D_MODEL ** -0.5),
        'ada_b': nrm(ks[5], (n_l, N_MOD * D_MODEL), 0.02),
        'norm_g': 1.0 + nrm(ks[6], (n_l, 6, D_MODEL), 0.02),
        'ffn1_wg': nrm(ks[7], (n_l, D_MODEL, D_FF), D_MODEL ** -0.5),
        'ffn1_wu': nrm(ks[8], (n_l, D_MODEL, D_FF), D_MODEL ** -0.5),
        'ffn1_wd': nrm(ks[9], (n_l, D_FF, D_MODEL), D_FF ** -0.5),
        'ffn2_wg': nrm(ks[10], (n_l, D_MODEL, D_FF), D_MODEL ** -0.5),
        'ffn2_wu': nrm(ks[11], (n_l, D_MODEL, D_FF), D_MODEL ** -0.5),
        'ffn2_wd': nrm(ks[12], (n_l, D_FF, D_MODEL), D_FF ** -0.5),
        'w_in': nrm(ks[13], (n_l, D_MODEL, IN_WIDTH), D_MODEL ** -0.5),
        'b_in': nrm(ks[14], (n_l, IN_WIDTH), 0.02),
        'w_out': nrm(ks[15], (n_l, MIX_WIDTH, D_MODEL), MIX_WIDTH ** -0.5),
        'attn_sink': nrm(ks[16], (n_l, A_HEADS), 0.5),
        'gla_w_alpha': nrm(ks[17], (n_l, 2, GLA_RANK, B_KW), GLA_RANK ** -0.5),
        'gla_b_alpha': nrm(ks[18], (n_l, 2, B_KW), 0.1),
        'gla_norm': 1.0 + nrm(ks[19], (n_l, B_VW), 0.02),
        'mlstm_conv': nrm(ks[20], (n_l, MLSTM_CONV, 2 * C_W), MLSTM_CONV ** -0.5),
        'mlstm_f_bias': jnp.linspace(3.0, 6.0, C_HEADS, dtype=jnp.float32) + nrm(ks[21], (n_l, 2, C_HEADS), 0.1),
        'mlstm_norm': 1.0 + nrm(ks[22], (n_l, C_W), 0.02),
    }


def reference(x, c, ctx, c_ctx, ada_w, ada_b, norm_g, ffn1_wg, ffn1_wu, ffn1_wd, ffn2_wg, ffn2_wu, ffn2_wd,
              w_in, b_in, w_out, attn_sink, gla_w_alpha, gla_b_alpha, gla_norm, mlstm_conv, mlstm_f_bias, mlstm_norm):
    s_len = x.shape[1]
    rows = s_len // GRID_W
    row_ids = jnp.broadcast_to(jnp.arange(rows)[:, None], (rows, GRID_W)).reshape(-1)
    col_ids = jnp.broadcast_to(jnp.arange(GRID_W)[None, :], (rows, GRID_W)).reshape(-1)
    rope = axial_rope_tables(row_ids, col_ids)

    h, hc = x, ctx
    for layer in range(DEPTH):
        need_ctx = layer < DEPTH - 1
        mod = adaln_params(c, ada_w[layer], ada_b[layer])[:, :, None, :]
        modc = adaln_params(c_ctx, ada_w[layer], ada_b[layer])
        g = norm_g[layer]

        h = ffn_sublayer(h, mod[:, 0], mod[:, 1], mod[:, 2], g[0], g[1], ffn1_wg[layer], ffn1_wu[layer], ffn1_wd[layer])
        hc = ffn_sublayer(hc, modc[0], modc[1], modc[2], g[0], g[1], ffn1_wg[layer], ffn1_wu[layer], ffn1_wd[layer])

        y, yc = token_mixing(modulate(h, g[2], mod[:, 3], mod[:, 4]), modulate(hc, g[2], modc[3], modc[4]), rope,
                             w_in[layer], b_in[layer], w_out[layer], attn_sink[layer],
                             gla_w_alpha[layer], gla_b_alpha[layer], gla_norm[layer],
                             mlstm_conv[layer], mlstm_f_bias[layer], mlstm_norm[layer], need_ctx)
        h = h + mod[:, 5] * rms_norm(y, g[3])

        h = ffn_sublayer(h, mod[:, 6], mod[:, 7], mod[:, 8], g[4], g[5], ffn2_wg[layer], ffn2_wu[layer], ffn2_wd[layer])
        if need_ctx:
            hc = hc + modc[5] * rms_norm(yc, g[3])
            hc = ffn_sublayer(hc, modc[6], modc[7], modc[8], g[4], g[5], ffn2_wg[layer], ffn2_wu[layer], ffn2_wd[layer])
    return h
```

```cpp
#ifndef CPU_EMU
#include <hip/hip_runtime.h>
#include <cstdio>
#include <cstdint>
#define DEV __device__ __forceinline__
#else
#include <cstdio>
#include <cstdint>
#include <cmath>
#include <cstring>
#define DEV static inline
#define __host__
#define __device__
#define __forceinline__ inline
struct EmuIdx { int x; };
static thread_local EmuIdx threadIdx, blockIdx, gridDim;
struct float4 { float x, y, z, w; };
#define __expf expf
#endif

#ifndef CFG_DM
#define CFG_DM 1024
#define CFG_NB 8
#define CFG_SEQ 4096
#define CFG_DEPTH 4
#define CFG_GRIDW 64
#define CFG_CTXL 256
#define CFG_DFF 2816
#define CFG_SC 256
#endif
constexpr int DM = CFG_DM, NB = CFG_NB, SEQ = CFG_SEQ, DEPTH = CFG_DEPTH, GRIDW = CFG_GRIDW, CTXL = CFG_CTXL, DFF = CFG_DFF, SC = CFG_SC;
constexpr int AH = DM / 128, AKV = AH / 4, AGRP = AH / AKV, WIN = 128;
constexpr int BH = DM / 256, CH = DM / 256, RANK = 16;
constexpr int A_OUT = AH * 64, A_KVW = AKV * 64, B_KW = BH * 32, B_VW = BH * 64, C_W = CH * 64;
constexpr int INW = A_OUT + 2 * A_KVW + 2 * B_KW + 2 * B_VW + 2 * RANK + 4 * C_W + 4 * CH;
constexpr int ZQ = 0, ZK = A_OUT, ZV = ZK + A_KVW, ZBQ = ZV + A_KVW, ZBK = ZBQ + B_KW, ZBV = ZBK + B_KW, ZBG = ZBV + B_VW, ZAF = ZBG + B_VW, ZAB = ZAF + RANK,
              ZCQ = ZAB + RANK, ZCK = ZCQ + C_W, ZCV = ZCK + C_W, ZCG = ZCV + C_W, ZCO = ZCG + 4 * CH;
static_assert(ZCO + C_W == INW, "in-proj split");
constexpr int ZP = (INW + 255) / 256 * 256;
constexpr int ML = NB * SEQ, MC = NB * CTXL, M = ML + MC;
constexpr int NMOD = NB + 1;
constexpr int NSCC = CTXL / SC, NSCL = SEQ / SC, NSC = NSCC + NSCL;
constexpr int NCHAIN = NB * BH * 2;
constexpr int OW = B_VW + C_W;
static_assert(BH == CH && M % 256 == 0 && (2 * DFF) % 256 == 0 && DFF % 128 == 0 && DM % 256 == 0 && CTXL % SC == 0 && SEQ % SC == 0, "shape assumptions");
constexpr float EPS = 1e-6f;
constexpr int KSPLIT = 8;
constexpr int NPOS = (SEQ / GRIDW > GRIDW) ? SEQ / GRIDW : GRIDW;

typedef unsigned short bf16;
#ifndef CPU_EMU
typedef float f32x4g __attribute__((ext_vector_type(4)));
#endif
DEV float bf2f(bf16 h) { unsigned u = (unsigned)h << 16; float f; __builtin_memcpy(&f, &u, 4); return f; }
DEV bf16 f2bf(float f) { unsigned u; __builtin_memcpy(&u, &f, 4); return (bf16)((u + 0x7fffu + ((u >> 16) & 1u)) >> 16); }
#ifndef CPU_EMU
typedef float f32x2g __attribute__((ext_vector_type(2))); typedef __bf16 bf16x2g __attribute__((ext_vector_type(2)));
DEV unsigned pkbf(float lo, float hi) { const f32x2g v = {lo, hi}; return __builtin_bit_cast(unsigned, __builtin_convertvector(v, bf16x2g)); }
#else
DEV unsigned pkbf(float lo, float hi) { return (unsigned)f2bf(lo) | ((unsigned)f2bf(hi) << 16); }
#endif
DEV bf16 f2bfh(float f) { return (bf16)pkbf(f, 0.f); }
DEV void ld8(const bf16* p, float* f) {
#ifndef CPU_EMU
    const uint4 v = *(const uint4*)p;
    f[0] = __uint_as_float(v.x << 16); f[1] = __uint_as_float(v.x & 0xffff0000u); f[2] = __uint_as_float(v.y << 16); f[3] = __uint_as_float(v.y & 0xffff0000u);
    f[4] = __uint_as_float(v.z << 16); f[5] = __uint_as_float(v.z & 0xffff0000u); f[6] = __uint_as_float(v.w << 16); f[7] = __uint_as_float(v.w & 0xffff0000u);
#else
    for (int i = 0; i < 8; ++i) f[i] = bf2f(p[i]);
#endif
}
#ifndef CPU_EMU
DEV float siluf(float x) { return x * __builtin_amdgcn_rcpf(1.f + __expf(-x)); }
DEV float sigmf(float x) { return __builtin_amdgcn_rcpf(1.f + __expf(-x)); }
DEV float logsigf(float x) { return fminf(x, 0.f) - __logf(1.f + __expf(-fabsf(x))); }
DEV void ldf8(const float* p, float* f) { const f32x4g a = *(const f32x4g*)p, b = *(const f32x4g*)(p + 4); f[0] = a.x; f[1] = a.y; f[2] = a.z; f[3] = a.w; f[4] = b.x; f[5] = b.y; f[6] = b.z; f[7] = b.w; }
#else
DEV float siluf(float x) { return x / (1.f + __expf(-x)); }
DEV float sigmf(float x) { return 1.f / (1.f + __expf(-x)); }
DEV float logsigf(float x) { return fminf(x, 0.f) - log1pf(__expf(-fabsf(x))); }
DEV void ldf8(const float* p, float* f) { for (int i = 0; i < 8; ++i) f[i] = p[i]; }
#endif

enum { I_X = 0, I_C, I_CTX, I_CCTX, I_ADAW, I_ADAB, I_NORMG, I_F1G, I_F1U, I_F1D, I_F2G, I_F2U, I_F2D, I_WIN, I_BIN, I_WOUT, I_SINK, I_GWA, I_GBA, I_GNORM, I_CONV, I_FBIAS, I_MNORM, N_IN };

constexpr size_t al256(size_t x) { return (x + 255) / 256 * 256; }
constexpr size_t WS_CTL = 0, CTL_BYTES = 1u << 20;
constexpr size_t W_GU = (size_t)2 * DFF * DM, W_D = (size_t)DM * DFF, W_IN = (size_t)ZP * DM, W_OUT = (size_t)DM * DM;
constexpr size_t WL_GU1 = 0, WL_D1 = WL_GU1 + W_GU, WL_IN = WL_D1 + W_D, WL_OUT = WL_IN + W_IN, WL_GU2 = WL_OUT + W_OUT, WL_D2 = WL_GU2 + W_GU, WL_ELEMS = WL_D2 + W_D;
constexpr size_t WS_W = WS_CTL + CTL_BYTES;
constexpr size_t WS_MODP = al256(WS_W + (size_t)WL_ELEMS * 2 * 2);
constexpr size_t WS_VEC = al256(WS_MODP + (size_t)KSPLIT * DEPTH * NMOD * 9 * DM * 4);
constexpr size_t WS_BINP = al256(WS_VEC + (size_t)DEPTH * 9 * NMOD * DM * 4);
constexpr size_t WS_ROPE = al256(WS_BINP + (size_t)DEPTH * ZP * 4);
constexpr size_t PRM_SINK = 0, PRM_GWA = PRM_SINK + (size_t)DEPTH * AH, PRM_GBA = PRM_GWA + (size_t)DEPTH * 2 * RANK * B_KW, PRM_GNORM = PRM_GBA + (size_t)DEPTH * 2 * B_KW,
                 PRM_CONV = PRM_GNORM + (size_t)DEPTH * B_VW, PRM_FBIAS = PRM_CONV + (size_t)DEPTH * 3 * 2 * C_W, PRM_MNORM = PRM_FBIAS + (size_t)DEPTH * 2 * CH, PRM_END = PRM_MNORM + (size_t)DEPTH * C_W;
constexpr size_t WS_PRM = al256(WS_ROPE + (size_t)NPOS * 32 * 4);
constexpr size_t WS_HC = al256(WS_PRM + PRM_END * 4);
constexpr size_t WS_U = al256(WS_HC + (size_t)MC * DM * 4);
constexpr size_t ACTW = (DFF > ZP ? DFF : ZP);
constexpr size_t WS_ACT = al256(WS_U + (size_t)M * DM * 2);
constexpr size_t WS_Y = al256(WS_ACT + (size_t)M * ACTW * 2);
constexpr size_t YBYTES = ((size_t)M * DM * 2 > (size_t)M * OW * 4) ? (size_t)M * DM * 2 : (size_t)M * OW * 4;
constexpr size_t WS_GST = al256(WS_Y + YBYTES);
constexpr size_t GST_S = (size_t)NCHAIN * NSC * 32 * 64, GST_D = (size_t)NCHAIN * NSC * 32;
constexpr size_t WS_MST = al256(WS_GST + (GST_S + GST_D) * 4);
constexpr size_t MST_C = (size_t)NCHAIN * NSC * 64 * 64, MST_N = (size_t)NCHAIN * NSC * 64, MST_M = (size_t)NCHAIN * NSC;
constexpr size_t WS_GA = al256(WS_MST + (MST_C + MST_N + 3 * MST_M) * 4);
constexpr size_t WS_CQK = al256(WS_GA + (size_t)2 * M * B_KW * 2);
constexpr size_t WS_SG = al256(WS_CQK + (size_t)M * 2 * C_W * 2);
constexpr size_t WS_HB = al256(WS_SG + (size_t)NCHAIN * ((CTXL + SEQ) / 64) * 2048 * 2);
constexpr size_t WS_XS = al256(WS_HB + (size_t)M * DM * 2);
constexpr size_t WS_END = al256(WS_XS + (size_t)3 * ML * 4 * 4);

struct P {
    const float* in[N_IN]; float* out; unsigned char* ws;
    int layer, ph_lo, ph_hi, one;
};

DEV bf16* wsb(const P& p, size_t off) { return (bf16*)(p.ws + off); }
DEV float* wsf(const P& p, size_t off) { return (float*)(p.ws + off); }
DEV float* hrow(const P& p, int r) { return r < ML ? p.out + (size_t)r * DM : wsf(p, WS_HC) + (size_t)(r - ML) * DM; }
DEV int modidx(int r) { return r < ML ? r / SEQ : NB; }
DEV float* vecp(const P& p, int l, int s, int kind, int bi) { return wsf(p, WS_VEC) + ((((size_t)l * 3 + s) * 3 + kind) * NMOD + bi) * DM; }
DEV const float* prm(const P& p, size_t off) { return (const float*)(p.ws + WS_PRM) + off; }
DEV bf16* wl(const P& p, int l, size_t off) { return wsb(p, WS_W) + (size_t)(l & 1) * WL_ELEMS + off; }
DEV void sc_rows(int b, int dir, int n, int& row0, int& step) {
    if (n < NSCC) { const int c = dir ? (NSCC - 1 - n) : n; const int base = ML + b * CTXL + c * SC; row0 = dir ? base + SC - 1 : base; }
    else { const int c = dir ? (NSCL - 1 - (n - NSCC)) : (n - NSCC); const int base = b * SEQ + c * SC; row0 = dir ? base + SC - 1 : base; }
    step = dir ? -1 : 1;
}
DEV int sc_chain_index(int t, int dir) { if (!dir) return t; return t < NSCC ? (NSCC - 1 - t) : NSCC + (NSCL - 1 - (t - NSCC)); }
DEV int sc_first_row(int b, int t) { return t < NSCC ? ML + b * CTXL + t * SC : b * SEQ + (t - NSCC) * SC; }

DEV void ph_modpart(const P& p, int gtid, int nth) {
    const float* c = p.in[I_C]; const float* cc = p.in[I_CCTX];
    constexpr int KS = DM / KSPLIT;
    for (long it = gtid; it < (long)KSPLIT * DEPTH * 9 * DM; it += nth) {
        const int col = (int)(it % (9 * DM)); const int l = (int)((it / (9 * DM)) % DEPTH); const int ks = (int)(it / ((long)9 * DM * DEPTH));
        const float* w = p.in[I_ADAW] + (size_t)l * DM * 9 * DM + col;
        float acc[NMOD];
#pragma unroll
        for (int b = 0; b < NMOD; ++b) acc[b] = 0.f;
        for (int k = ks * KS; k < (ks + 1) * KS; ++k) {
            const float wv = w[(size_t)k * 9 * DM];
#pragma unroll
            for (int b = 0; b < NMOD; ++b) { const float cv = b < NB ? c[b * DM + k] : cc[k]; acc[b] += siluf(cv) * wv; }
        }
#pragma unroll
        for (int b = 0; b < NMOD; ++b) wsf(p, WS_MODP)[(((size_t)ks * DEPTH + l) * NMOD + b) * 9 * DM + col] = acc[b];
    }
}
DEV void ph_init(const P& p, int gtid, int nth) {
#ifdef CPU_EMU
    const float4* x4 = (const float4*)p.in[I_X]; float4* o4 = (float4*)p.out;
    for (long i = gtid; i < (long)ML * DM / 4; i += nth) o4[i] = x4[i];
    const float4* c4 = (const float4*)p.in[I_CTX]; float4* h4 = (float4*)wsf(p, WS_HC);
    for (long i = gtid; i < (long)MC * DM / 4; i += nth) h4[i] = c4[i];
#else
    { const f32x4g* x4 = (const f32x4g*)p.in[I_X]; const f32x4g* c4 = (const f32x4g*)p.in[I_CTX]; uint2* hb = (uint2*)wsb(p, WS_HB);
      const long NV4 = (long)M * DM / 4, NL4 = (long)ML * DM / 4;
      for (long i0 = gtid; i0 < NV4; i0 += 4L * nth) { f32x4g v[4];
#pragma unroll
          for (int q = 0; q < 4; ++q) { const long i = i0 + (long)q * nth; if (i < NV4) v[q] = i < NL4 ? x4[i] : c4[i - NL4]; }
#pragma unroll
          for (int q = 0; q < 4; ++q) { const long i = i0 + (long)q * nth; if (i < NV4) { uint2 o; o.x = pkbf(v[q].x, v[q].y); o.y = pkbf(v[q].z, v[q].w); hb[i] = o; } } } }
#endif
    for (int i = gtid; i < NPOS * 16; i += nth) { const int pos = i / 16, f = i % 16; const float inv = powf(10000.f, -(float)f / 16.f); const float a = (float)pos * inv;
        wsf(p, WS_ROPE)[2 * i] = cosf(a); wsf(p, WS_ROPE)[2 * i + 1] = sinf(a); }
    { float* pr = wsf(p, WS_PRM);
      for (int i = gtid; i < DEPTH * AH; i += nth) pr[PRM_SINK + i] = p.in[I_SINK][i];
      for (int i = gtid; i < DEPTH * 2 * RANK * B_KW; i += nth) pr[PRM_GWA + i] = p.in[I_GWA][i];
      for (int i = gtid; i < DEPTH * 2 * B_KW; i += nth) pr[PRM_GBA + i] = p.in[I_GBA][i];
      for (int i = gtid; i < DEPTH * B_VW; i += nth) pr[PRM_GNORM + i] = p.in[I_GNORM][i];
      for (int i = gtid; i < DEPTH * 3 * 2 * C_W; i += nth) pr[PRM_CONV + i] = p.in[I_CONV][i];
      for (int i = gtid; i < DEPTH * 2 * CH; i += nth) pr[PRM_FBIAS + i] = p.in[I_FBIAS][i];
      for (int i = gtid; i < DEPTH * C_W; i += nth) pr[PRM_MNORM + i] = p.in[I_MNORM][i]; }
    for (int i = gtid; i < DEPTH * ZP; i += nth) { const int l = i / ZP, c = i % ZP; wsf(p, WS_BINP)[i] = c < INW ? p.in[I_BIN][l * INW + c] : 0.f; }
}
DEV void ph_vec(const P& p, int gtid, int nth) {
    for (long it = gtid; it < (long)DEPTH * 3 * NMOD * DM; it += nth) {
        const int col = (int)(it % DM); const int bi = (int)((it / DM) % NMOD); const int s = (int)((it / ((long)DM * NMOD)) % 3); const int l = (int)(it / ((long)DM * NMOD * 3));
        float m3[3];
#pragma unroll
        for (int j = 0; j < 3; ++j) { const int c9 = (3 * s + j) * DM + col; float a = p.in[I_ADAB][l * 9 * DM + c9];
            for (int ks = 0; ks < KSPLIT; ++ks) a += wsf(p, WS_MODP)[(((size_t)ks * DEPTH + l) * NMOD + bi) * 9 * DM + c9];
            m3[j] = a; }
        const float gpre = p.in[I_NORMG][(l * 6 + 2 * s) * DM + col], gpost = p.in[I_NORMG][(l * 6 + 2 * s + 1) * DM + col];
        vecp(p, l, s, 0, bi)[col] = gpre * (1.f + m3[1]);
        vecp(p, l, s, 1, bi)[col] = m3[0];
        vecp(p, l, s, 2, bi)[col] = (s == 1 ? 1.f : 0.5f) * m3[2] * gpost;
    }
}
DEV void st8(bf16* p, const float* f) {
#ifndef CPU_EMU
    uint4 v; v.x = pkbf(f[0], f[1]); v.y = pkbf(f[2], f[3]); v.z = pkbf(f[4], f[5]); v.w = pkbf(f[6], f[7]);
    *(uint4*)p = v;
#else
    for (int i = 0; i < 8; ++i) p[i] = f2bf(f[i]);
#endif
}
DEV void ph_zpost(const P& p, int l, int gtid, int nth) {
    bf16* Z = wsb(p, WS_ACT);
    const float* rt = wsf(p, WS_ROPE);
#ifdef CPU_EMU
    constexpr int RH0 = 0, RHN = AH + AKV;
#else
    constexpr int RH0 = AH, RHN = AKV;
#endif
    for (long it = gtid; it < (long)ML * RHN * 2; it += nth) {
        const int hf = (int)(it % 2); const int hs = RH0 + (int)((it / 2) % RHN); const int r = (int)(it / (2 * RHN));
        const int t = r % SEQ; const int pos = hf == 0 ? t / GRIDW : t % GRIDW;
        bf16* z = Z + (size_t)r * ZP + (hs < AH ? ZQ + hs * 64 : ZK + (hs - AH) * 64) + hf * 32;
        float x1[16], x2[16], y1[16], y2[16];
        ld8(z, x1); ld8(z + 8, x1 + 8); ld8(z + 16, x2); ld8(z + 24, x2 + 8);
        float cs_[32];
#ifndef CPU_EMU
#pragma unroll
        for (int i = 0; i < 8; ++i) { const f32x4g v = ((const f32x4g*)(rt + 32 * pos))[i]; cs_[4 * i] = v.x; cs_[4 * i + 1] = v.y; cs_[4 * i + 2] = v.z; cs_[4 * i + 3] = v.w; }
#else
        for (int i = 0; i < 32; ++i) cs_[i] = rt[32 * pos + i];
#endif
#pragma unroll
        for (int i = 0; i < 16; ++i) { const float cs = cs_[2 * i], sn = cs_[2 * i + 1]; y1[i] = x1[i] * cs - x2[i] * sn; y2[i] = x1[i] * sn + x2[i] * cs; }
        st8(z, y1); st8(z + 8, y1 + 8); st8(z + 16, y2); st8(z + 24, y2 + 8);
    }
    const float* wa = prm(p, PRM_GWA) + (size_t)l * 2 * RANK * B_KW; const float* ba = prm(p, PRM_GBA) + (size_t)l * 2 * B_KW;
    bf16* GA = wsb(p, WS_GA);
    { const long NI = (long)2 * M * (B_KW / 8);
      for (long it0 = gtid; it0 < NI; it0 += 2L * nth) {
        float zl[2][16], a[2][8]; int c8v[2], rv[2], dv[2]; bool ok[2];
#pragma unroll
        for (int q = 0; q < 2; ++q) { long it = it0 + (long)q * nth; ok[q] = it < NI; if (!ok[q]) it = it0;
            c8v[q] = (int)(it % (B_KW / 8)) * 8; rv[q] = (int)((it / (B_KW / 8)) % M); dv[q] = (int)(it / ((long)(B_KW / 8) * M));
            const bf16* zp = Z + (size_t)rv[q] * ZP + (dv[q] ? ZAB : ZAF); ld8(zp, zl[q]); ld8(zp + 8, zl[q] + 8); }
#pragma unroll
        for (int q = 0; q < 2; ++q) {
            ldf8(ba + dv[q] * B_KW + c8v[q], a[q]);
#pragma unroll
            for (int k = 0; k < RANK; ++k) { float w8[8]; ldf8(wa + (dv[q] * RANK + k) * B_KW + c8v[q], w8);
#pragma unroll
                for (int j = 0; j < 8; ++j) a[q][j] += zl[q][k] * w8[j]; }
#pragma unroll
            for (int j = 0; j < 8; ++j) a[q][j] = logsigf(a[q][j]) * (1.f / 16.f);
            if (ok[q]) st8(GA + ((size_t)dv[q] * M + rv[q]) * B_KW + c8v[q], a[q]); } } }
    const float* cw = prm(p, PRM_CONV) + (size_t)l * 3 * 2 * C_W;
    bf16* CQK = wsb(p, WS_CQK);
    { const long NI = (long)M * (2 * C_W / 8);
      for (long it0 = gtid; it0 < NI; it0 += 4L * nth) {
        float x0[4][8], xm[4][8], xp[4][8]; int chv[4], rv[4]; bool ok[4];
#pragma unroll
        for (int q = 0; q < 4; ++q) { long it = it0 + (long)q * nth; ok[q] = it < NI; if (!ok[q]) it = it0;
            const int ch = (int)(it % (2 * C_W / 8)) * 8; const int r = (int)(it / (2 * C_W / 8)); chv[q] = ch; rv[q] = r;
            int t, len; if (r < ML) { t = r % SEQ; len = SEQ; } else { t = (r - ML) % CTXL; len = CTXL; }
            const bf16* z = Z + (size_t)r * ZP + (ch < C_W ? ZCQ + ch : ZCK + (ch - C_W));
            ld8(z, x0[q]);
            if (t > 0) ld8(z - (long)ZP, xm[q]); else { for (int j = 0; j < 8; ++j) xm[q][j] = 0.f; }
            if (t < len - 1) ld8(z + ZP, xp[q]); else { for (int j = 0; j < 8; ++j) xp[q][j] = 0.f; } }
#pragma unroll
        for (int q = 0; q < 4; ++q) { float o[8], w0[8], w1[8], w2[8]; const int ch = chv[q];
            ldf8(cw + 0 * 2 * C_W + ch, w0); ldf8(cw + 1 * 2 * C_W + ch, w1); ldf8(cw + 2 * 2 * C_W + ch, w2);
#pragma unroll
            for (int j = 0; j < 8; ++j) o[j] = siluf(xm[q][j] * w0[j] + x0[q][j] * w1[j] + xp[q][j] * w2[j]);
            if (ok[q]) st8(CQK + (size_t)rv[q] * 2 * C_W + ch, o); } } }
}
DEV void ph_attn_naive(const P& p, int l, int gtid, int nth) {
    const bf16* Z = wsb(p, WS_ACT); bf16* Y = wsb(p, WS_U);
    const float* sink = prm(p, PRM_SINK) + l * AH;
    for (long it = gtid; it < (long)M * AH; it += nth) {
        const int r = (int)(it % M); const int hq = (int)(it / M); const int g = hq / AGRP;
        float q[64], o[64];
        const bf16* zq = Z + (size_t)r * ZP + ZQ + hq * 64;
#pragma unroll
        for (int d = 0; d < 64; d += 8) ld8(zq + d, q + d);
#pragma unroll
        for (int d = 0; d < 64; ++d) { q[d] *= 0.125f; o[d] = 0.f; }
        float m = sink[hq], lsum = 1.f;
        int b, j0, j1, crow0;
        if (r < ML) { b = r / SEQ; const int t = r % SEQ; j0 = t - WIN < 0 ? 0 : t - WIN; j1 = t + WIN > SEQ - 1 ? SEQ - 1 : t + WIN; }
        else { b = (r - ML) / CTXL; j0 = 0; j1 = -1; }
        crow0 = ML + b * CTXL;
        const int nwin = j1 - j0 + 1;
        for (int jj = 0; jj < nwin + CTXL; ++jj) {
            const int kr = jj < nwin ? b * SEQ + j0 + jj : crow0 + (jj - nwin);
            const bf16* zk = Z + (size_t)kr * ZP + ZK + g * 64; const bf16* zv = Z + (size_t)kr * ZP + ZV + g * 64;
            float s = 0.f;
#pragma unroll
            for (int d = 0; d < 64; d += 8) { float kk[8]; ld8(zk + d, kk);
#pragma unroll
                for (int e = 0; e < 8; ++e) s += q[d + e] * kk[e]; }
            const float mn = fmaxf(m, s); const float f = __expf(m - mn), e = __expf(s - mn);
            lsum = lsum * f + e; m = mn;
#pragma unroll
            for (int d = 0; d < 64; d += 8) { float vv[8]; ld8(zv + d, vv);
#pragma unroll
                for (int e2 = 0; e2 < 8; ++e2) o[d + e2] = o[d + e2] * f + e * vv[e2]; }
        }
        const float inv = 1.f / lsum;
        bf16* y = Y + (size_t)r * DM + hq * 64;
#pragma unroll
        for (int d = 0; d < 64; ++d) y[d] = f2bf(o[d] * inv);
    }
}
DEV void gla_tok(const P& p, int r, int h, int dir, float (&a)[32], float (&k)[32], float& v, int vc) {
    const bf16* Z = wsb(p, WS_ACT); const bf16* ga = wsb(p, WS_GA) + ((size_t)dir * M + r) * B_KW + h * 32;
    const bf16* zk = Z + (size_t)r * ZP + ZBK + h * 32;
#pragma unroll
    for (int d = 0; d < 32; d += 8) { ld8(ga + d, a + d); ld8(zk + d, k + d); }
#pragma unroll
    for (int d = 0; d < 32; ++d) a[d] = __expf(a[d]);
    v = bf2f(Z[(size_t)r * ZP + ZBV + h * 64 + vc]);
}
DEV void ph_gla1(const P& p, int gtid, int nth) {
    float* S = wsf(p, WS_GST); float* D = S + GST_S;
    for (long it = gtid; it < (long)NCHAIN * NSC * 64; it += nth) {
        const int vc = (int)(it % 64); const int n = (int)((it / 64) % NSC); const int ch = (int)(it / (64 * NSC));
        const int dir = ch & 1, h = (ch >> 1) % BH, b = ch / (2 * BH);
        int row0, step; sc_rows(b, dir, n, row0, step);
        float s[32], pd[32];
#pragma unroll
        for (int d = 0; d < 32; ++d) { s[d] = 0.f; pd[d] = 1.f; }
        for (int i = 0; i < SC; ++i) {
            float a[32], k[32], v; gla_tok(p, row0 + i * step, h, dir, a, k, v, vc);
#pragma unroll
            for (int d = 0; d < 32; ++d) { s[d] = a[d] * s[d] + k[d] * v; pd[d] *= a[d]; }
        }
        float* so = S + ((size_t)ch * NSC + n) * 32 * 64;
#pragma unroll
        for (int d = 0; d < 32; ++d) so[d * 64 + vc] = s[d];
        if (vc == 0) {
#pragma unroll
            for (int d = 0; d < 32; ++d) D[((size_t)ch * NSC + n) * 32 + d] = pd[d]; }
    }
}
DEV void ph_gla2(const P& p, int gtid, int nth) {
    float* S = wsf(p, WS_GST); const float* D = S + GST_S;
    for (long it = gtid; it < (long)NCHAIN * 32 * 64; it += nth) {
        const int e = (int)(it % (32 * 64)); const int ch = (int)(it / (32 * 64)); const int d = e / 64;
        float st = 0.f;
        for (int n = 0; n < NSC; ++n) { float* x = S + ((size_t)ch * NSC + n) * 32 * 64 + e; const float loc = *x; *x = st; st = D[((size_t)ch * NSC + n) * 32 + d] * st + loc; }
    }
}
DEV void ph_gla3(const P& p, int gtid, int nth) {
    const float* S = wsf(p, WS_GST); const bf16* Z = wsb(p, WS_ACT); float* O = wsf(p, WS_Y);
    for (long it = gtid; it < (long)NB * BH * NSC * 64; it += nth) {
        const int vc = (int)(it % 64); const int t = (int)((it / 64) % NSC); const int h = (int)((it / (64 * NSC)) % BH); const int b = (int)(it / ((long)64 * NSC * BH));
        for (int dir = 0; dir < 2; ++dir) {
            const int ch = (b * BH + h) * 2 + dir; const int n = sc_chain_index(t, dir);
            int row0, step; sc_rows(b, dir, n, row0, step);
            float s[32];
            const float* sp = S + ((size_t)ch * NSC + n) * 32 * 64;
#pragma unroll
            for (int d = 0; d < 32; ++d) s[d] = sp[d * 64 + vc];
            for (int i = 0; i < SC; ++i) {
                const int r = row0 + i * step;
                float a[32], k[32], v; gla_tok(p, r, h, dir, a, k, v, vc);
                const bf16* zq = Z + (size_t)r * ZP + ZBQ + h * 32;
                float o = 0.f, qq[32];
#pragma unroll
                for (int d = 0; d < 32; d += 8) ld8(zq + d, qq + d);
#pragma unroll
                for (int d = 0; d < 32; ++d) { s[d] = a[d] * s[d] + k[d] * v; o += qq[d] * s[d]; }
                o *= 0.17677669529663687f;
                float* op = O + (size_t)r * OW + h * 64 + vc;
                if (dir == 0) *op = o; else *op += o;
            }
        }
    }
}
DEV void ml_tok(const P& p, int l, int r, int h, int dir, const bf16*& ck, float& v, float& li, float& lf, int vc) {
    const bf16* Z = wsb(p, WS_ACT); ck = wsb(p, WS_CQK) + (size_t)r * 2 * C_W + C_W + h * 64;
    v = bf2f(Z[(size_t)r * ZP + ZCV + h * 64 + vc]);
    li = bf2f(Z[(size_t)r * ZP + ZCG + (2 * dir) * CH + h]);
    lf = logsigf(bf2f(Z[(size_t)r * ZP + ZCG + (2 * dir + 1) * CH + h]) + prm(p, PRM_FBIAS)[(l * 2 + dir) * CH + h]);
}
DEV void ph_ml1(const P& p, int l, int gtid, int nth) {
    float* C = wsf(p, WS_MST); float* N = C + MST_C; float* Mm = N + MST_N; float* F = Mm + MST_M;
    for (long it = gtid; it < (long)NCHAIN * NSC * 64; it += nth) {
        const int vc = (int)(it % 64); const int n = (int)((it / 64) % NSC); const int ch = (int)(it / (64 * NSC));
        const int dir = ch & 1, h = (ch >> 1) % CH, b = ch / (2 * CH);
        int row0, step; sc_rows(b, dir, n, row0, step);
        float c[64], nn[64]; float m = -1e30f, fs = 0.f;
#pragma unroll
        for (int d = 0; d < 64; ++d) { c[d] = 0.f; nn[d] = 0.f; }
        for (int i = 0; i < SC; ++i) {
            const bf16* ck; float v, li, lf; ml_tok(p, l, row0 + i * step, h, dir, ck, v, li, lf, vc);
            const float mn = fmaxf(lf + m, li); const float fp = __expf(lf + m - mn), ip = __expf(li - mn) * 0.125f; m = mn; fs += lf;
#pragma unroll
            for (int d0 = 0; d0 < 64; d0 += 8) { float k8[8]; ld8(ck + d0, k8);
#pragma unroll
                for (int e = 0; e < 8; ++e) { const int d = d0 + e; c[d] = fp * c[d] + ip * v * k8[e]; nn[d] = fp * nn[d] + ip * k8[e]; } }
        }
        float* co = C + (((size_t)ch * NSC + n) * 64 + vc) * 64;
#pragma unroll
        for (int d = 0; d < 64; ++d) co[d] = c[d];
        if (vc == 0) {
#pragma unroll
            for (int d = 0; d < 64; ++d) N[((size_t)ch * NSC + n) * 64 + d] = nn[d];
            Mm[(size_t)ch * NSC + n] = m; F[(size_t)ch * NSC + n] = fs; }
    }
}
DEV void ph_ml2(const P& p, int gtid, int nth) {
    float* C = wsf(p, WS_MST); float* N = C + MST_C; float* Mm = N + MST_N; const float* F = Mm + MST_M; float* MP = Mm + 2 * MST_M;
    for (long it = gtid; it < (long)NCHAIN * 65 * 64; it += nth) {
        const int e = (int)(it % (65 * 64)); const int ch = (int)(it / (65 * 64));
        float st = 0.f, mst = 0.f;
        for (int n = 0; n < NSC; ++n) {
            const size_t cn = (size_t)ch * NSC + n;
            const float ml = Mm[cn], fl = F[cn];
            const float mn = fmaxf(fl + mst, ml); const float a = __expf(fl + mst - mn), ee = __expf(ml - mn);
            float* x = e < 64 * 64 ? C + cn * 64 * 64 + e : N + cn * 64 + (e - 64 * 64);
            const float loc = *x; *x = st; st = a * st + ee * loc;
            if (e == 0) MP[cn] = mst;
            mst = mn;
        }
    }
}
DEV void ph_ml3(const P& p, int l, int gtid, int nth) {
    const float* C = wsf(p, WS_MST); const float* N = C + MST_C; const float* MP = N + MST_N + 2 * MST_M; float* O = wsf(p, WS_Y);
    for (long it = gtid; it < (long)NB * CH * NSC * 64; it += nth) {
        const int vc = (int)(it % 64); const int t = (int)((it / 64) % NSC); const int h = (int)((it / (64 * NSC)) % CH); const int b = (int)(it / ((long)64 * NSC * CH));
        for (int dir = 0; dir < 2; ++dir) {
            const int ch = (b * CH + h) * 2 + dir; const int n = sc_chain_index(t, dir);
            int row0, step; sc_rows(b, dir, n, row0, step);
            const size_t cn = (size_t)ch * NSC + n;
            float c[64], nn[64]; float m = MP[cn];
#pragma unroll
            for (int d = 0; d < 64; ++d) { c[d] = C[(cn * 64 + vc) * 64 + d]; nn[d] = N[cn * 64 + d]; }
            for (int i = 0; i < SC; ++i) {
                const int r = row0 + i * step;
                const bf16* ck; float v, li, lf; ml_tok(p, l, r, h, dir, ck, v, li, lf, vc);
                const float mn = fmaxf(lf + m, li); const float fp = __expf(lf + m - mn), ip = __expf(li - mn) * 0.125f; m = mn;
                const bf16* cq = wsb(p, WS_CQK) + (size_t)r * 2 * C_W + h * 64;
                float num = 0.f, den = 0.f;
#pragma unroll
                for (int d0 = 0; d0 < 64; d0 += 8) { float qq[8], k8[8]; ld8(cq + d0, qq); ld8(ck + d0, k8);
#pragma unroll
                    for (int e = 0; e < 8; ++e) { const int d = d0 + e; c[d] = fp * c[d] + ip * v * k8[e]; nn[d] = fp * nn[d] + ip * k8[e]; num += c[d] * qq[e]; den += nn[d] * qq[e]; } }
                const float hv = num / fmaxf(fabsf(den), __expf(-m));
                float* op = O + (size_t)r * OW + B_VW + h * 64 + vc;
                if (dir == 0) *op = hv; else *op += hv;
            }
        }
    }
}
DEV void ph_headln(const P& p, int l, int gtid, int nth, int h0 = 0) {
    const float* O = wsf(p, WS_Y); const bf16* Z = wsb(p, WS_ACT); bf16* Y = wsb(p, WS_U);
    for (long it = gtid; it < (long)M * (BH + CH - h0); it += nth) {
        const int r = (int)(it % M); const int hh = h0 + (int)(it / M);
        const float* o = O + (size_t)r * OW + hh * 64;
        float mu = 0.f;
#pragma unroll
        for (int d = 0; d < 64; ++d) mu += o[d];
        mu *= (1.f / 64.f); float var = 0.f;
#pragma unroll
        for (int d = 0; d < 64; ++d) { const float x = o[d] - mu; var += x * x; }
        const float rs = 1.f / sqrtf(var * (1.f / 64.f) + EPS);
        const bool isb = hh < BH; const int h = isb ? hh : hh - BH;
        const float* g = isb ? prm(p, PRM_GNORM) + l * B_VW + h * 64 : prm(p, PRM_MNORM) + l * C_W + h * 64;
        const bf16* zg = Z + (size_t)r * ZP + (isb ? ZBG : ZCO) + h * 64;
        bf16* y = Y + (size_t)r * DM + A_OUT + hh * 64;
#pragma unroll
        for (int d = 0; d < 64; ++d) { const float gz = bf2f(zg[d]); const float gate = isb ? siluf(gz) : sigmf(gz); y[d] = f2bf(gate * (o[d] - mu) * rs * g[d]); }
    }
}

#ifndef CPU_EMU
namespace pg8 {
#define PG8_LAS __attribute__((address_space(3)))
typedef unsigned short bf16_t;
typedef short bf16x8 __attribute__((ext_vector_type(8)));
typedef float f32x4 __attribute__((ext_vector_type(4)));
typedef unsigned u32x4 __attribute__((ext_vector_type(4)));
constexpr int BM = 256, BK = 64, HALF = 128, HTB = HALF * BK * 2  , STAGE_BYTES = 8 * HTB, NXCD = 8, WGM = 8;

__host__ __device__ __forceinline__ int lds_byte(int r, int c) { const int st = (r >> 4) * 2 + (c >> 5), rr = r & 15, cc = c & 31, ob = rr * 64 + cc * 2; return st * 1024 + (ob ^ (((ob >> 9) & 1) << 5)); }
__host__ __device__ __forceinline__ void stage_rc(int b, int& R, int& C) { const int st = b / 1024, sb = b % 1024, swz = sb ^ (((sb >> 9) & 1) << 5); R = (st >> 1) * 16 + swz / 64; C = (st & 1) * 32 + (swz % 64) / 2; }
__host__ __device__ __forceinline__ int perm32(int rho) { const int n = rho >> 4, i = rho & 15; return 8 * (i >> 2) + 4 * n + (i & 3); }

struct Unit { int pm, pn; };
struct Gemm { const bf16_t* A; const bf16_t* Bt; int M, N, K; int ld = 0; };

struct StaticOrder {
    int nM, nN, nwg, G, c;
    __host__ __device__ void init(int M, int N, int G_, int c_) { nM = M / BM; nN = N / BM; nwg = nM * nN; G = G_; c = c_; }
    __host__ __device__ bool next(int i, Unit& u) const {
        const long L = (long)i * G + c; if (L >= nwg) return false;
        int wgid = (int)L; { const int q = nwg / NXCD, r = nwg % NXCD, xcd = wgid % NXCD, off = wgid / NXCD; wgid = (xcd < r ? xcd * (q + 1) : r * (q + 1) + (xcd - r) * q) + off; }
        const int nig = WGM * nN, gid = wgid / nig, fm = gid * WGM, gsz = (nM - fm) < WGM ? (nM - fm) : WGM;
        u.pm = fm + ((wgid % nig) % gsz); u.pn = (wgid % nig) / gsz; return true;
    }
    __device__ __forceinline__ void a_ready(const Unit&) const {}
    __device__ __forceinline__ void done(const Unit&) const {}
};

__device__ __forceinline__ unsigned cvt_pk_bf16(float lo, float hi) { unsigned r; asm volatile("v_cvt_pk_bf16_f32 %0, %1, %2" : "=v"(r) : "v"(lo), "v"(hi)); return r; }
typedef float f32x2 __attribute__((ext_vector_type(2)));

struct EpiPlain {
    static constexpr bool PERM = true, AFTER_DRAIN = false;
    bf16_t* O; int ldc; const float* bias;
    __device__ __forceinline__ void operator()(const f32x4 (&acc)[2][2][4][2], const Unit& u, int wr, int wc, int fr, int fq) const {
        const int row0 = u.pm * BM + wr * 64 + fr; const int col0 = u.pn * BM + wc * 32 + 8 * fq;
        f32x4 bv[2][2];
#pragma unroll
        for (int bj = 0; bj < 2; ++bj)
#pragma unroll
            for (int n = 0; n < 2; ++n) bv[bj][n] = bias ? *(const f32x4*)(bias + col0 + bj * HALF + 4 * n) : (f32x4){0.f, 0.f, 0.f, 0.f};
#pragma unroll
        for (int ai = 0; ai < 2; ++ai)
#pragma unroll
            for (int m = 0; m < 4; ++m) { bf16_t* rowp = O + (size_t)(row0 + ai * HALF + m * 16) * ldc + col0;
#pragma unroll
                for (int bj = 0; bj < 2; ++bj) { const f32x4 v0 = acc[ai][bj][m][0] + bv[bj][0], v1 = acc[ai][bj][m][1] + bv[bj][1];
                    u32x4 w; w.x = cvt_pk_bf16(v0[0], v0[1]); w.y = cvt_pk_bf16(v0[2], v0[3]); w.z = cvt_pk_bf16(v1[0], v1[1]); w.w = cvt_pk_bf16(v1[2], v1[3]);
                    *(u32x4*)(rowp + bj * HALF) = w; } }
    }
};
struct RoundOrder : StaticOrder { int rnd;
    __host__ __device__ bool next(int i, Unit& u) const { return i == 0 && StaticOrder::next(rnd, u); } };
struct PanelSS {
    float* xbuf; unsigned* cnt;
    __device__ __forceinline__ void run(const f32x4 (&v)[2][2][4][2], const Unit& u, int wr, int wc, int fr, int fq, PG8_LAS unsigned char* lds, int wid, int lane) const {
        PG8_LAS float* Pt = (PG8_LAS float*)lds;
        PG8_LAS float* S = (PG8_LAS float*)(lds + 8192);
#pragma unroll
        for (int ai = 0; ai < 2; ++ai)
#pragma unroll
            for (int m = 0; m < 4; ++m) { float s = 0.f;
#pragma unroll
                for (int bj = 0; bj < 2; ++bj)
#pragma unroll
                    for (int n = 0; n < 2; ++n) { const f32x4 x = v[ai][bj][m][n]; s += (x[0] * x[0] + x[1] * x[1]) + (x[2] * x[2] + x[3] * x[3]); }
                s += __shfl_xor(s, 16); s += __shfl_xor(s, 32);
                if (fq == 0) Pt[(ai * HALF + wr * 64 + m * 16 + fr) * 4 + wc] = s; }
        asm volatile("s_waitcnt lgkmcnt(0)" ::: "memory"); __builtin_amdgcn_s_barrier(); asm volatile("" ::: "memory");
        const int row = wid * 32 + (lane & 31);
        if (lane < 32) { const float t = (Pt[row * 4 + 0] + Pt[row * 4 + 1]) + (Pt[row * 4 + 2] + Pt[row * 4 + 3]);
            __hip_atomic_store((unsigned*)xbuf + ((size_t)(u.pm * BM + row) * 4 + u.pn), __float_as_uint(t), __ATOMIC_RELAXED, __HIP_MEMORY_SCOPE_AGENT); }
        asm volatile("s_waitcnt vmcnt(0)" ::: "memory");
        if (lane == 0) __hip_atomic_fetch_add(cnt + 64 * u.pm, 1u, __ATOMIC_RELAXED, __HIP_MEMORY_SCOPE_AGENT);
        if (wid == 0) { unsigned sp = 0;
            while ((unsigned)__builtin_amdgcn_readfirstlane(__hip_atomic_load(cnt + 64 * u.pm, __ATOMIC_RELAXED, __HIP_MEMORY_SCOPE_AGENT)) < 32u) { __builtin_amdgcn_s_sleep(2); if (++sp > (1u << 20)) break; }
            __builtin_amdgcn_fence(__ATOMIC_ACQUIRE, "agent"); }
        asm volatile("s_waitcnt vmcnt(0) lgkmcnt(0)" ::: "memory"); __builtin_amdgcn_s_barrier(); asm volatile("" ::: "memory");
        if (lane < 32) { const unsigned* slot = (const unsigned*)xbuf + (size_t)(u.pm * BM + row) * 4; float t = 0.f;
#pragma unroll
            for (int k = 0; k < 4; ++k) t += __uint_as_float(__hip_atomic_load(slot + k, __ATOMIC_RELAXED, __HIP_MEMORY_SCOPE_AGENT));
            S[row] = t; }
        asm volatile("s_waitcnt vmcnt(0) lgkmcnt(0)" ::: "memory"); __builtin_amdgcn_s_barrier(); asm volatile("" ::: "memory");
    }
};
struct EpiFinal {
    static constexpr bool PERM = false, AFTER_DRAIN = true;
    const bf16_t* hb; float* out; const float* pmv0; int seq; float eps; PanelSS st;
    __device__ __forceinline__ void fused(f32x4 (&acc)[2][2][4][2], const Unit& u, int wr, int wc, int fr, int fq, PG8_LAS unsigned char* lds, int wid, int lane) const {
        const PG8_LAS float* S = (const PG8_LAS float*)(lds + 8192);
        st.run(acc, u, wr, wc, fr, fq, lds, wid, lane);
        const int col0 = u.pn * BM + wc * 32 + 4 * fq; const float* pm = pmv0 + (size_t)((u.pm * BM) / seq) * 1024;
        f32x4 pv[2][2];
#pragma unroll
        for (int bj = 0; bj < 2; ++bj)
#pragma unroll
            for (int n = 0; n < 2; ++n) pv[bj][n] = *(const f32x4*)(pm + col0 + bj * HALF + n * 16);
#pragma unroll
        for (int ai = 0; ai < 2; ++ai)
#pragma unroll
            for (int m = 0; m < 4; ++m) { const int r = ai * HALF + wr * 64 + m * 16 + fr; const float rs = __builtin_amdgcn_rsqf(S[r] * (1.f / 1024.f) + eps); const size_t off = (size_t)(u.pm * BM + r) * 1024 + col0;
#pragma unroll
                for (int bj = 0; bj < 2; ++bj)
#pragma unroll
                    for (int n = 0; n < 2; ++n) { const f32x2 hw = *(const f32x2*)(hb + off + bj * HALF + n * 16); const unsigned h0 = __float_as_uint(hw.x), h1 = __float_as_uint(hw.y);
                        const f32x4 hv = {__uint_as_float(h0 << 16), __uint_as_float(h0 & 0xffff0000u), __uint_as_float(h1 << 16), __uint_as_float(h1 & 0xffff0000u)};
                        *(f32x4*)(out + off + bj * HALF + n * 16) = hv + pv[bj][n] * acc[ai][bj][m][n] * rs; }
                asm volatile("" ::: "memory"); }
    }
};
struct EpiMid {
    static constexpr bool PERM = false, AFTER_DRAIN = true;
    bf16_t* hb; bf16_t* uo; const float* pmv0; const float* av0; const float* bv0; int seq; float eps; PanelSS st1, st2;
    __device__ __forceinline__ void fused(f32x4 (&acc)[2][2][4][2], const Unit& u, int wr, int wc, int fr, int fq, PG8_LAS unsigned char* lds, int wid, int lane) const {
        const PG8_LAS float* S = (const PG8_LAS float*)(lds + 8192);
        st1.run(acc, u, wr, wc, fr, fq, lds, wid, lane);
        const int col0 = u.pn * BM + wc * 32 + 4 * fq; const size_t vo = (size_t)((u.pm * BM) / seq) * 1024;
        { f32x4 pv[2][2];
#pragma unroll
          for (int bj = 0; bj < 2; ++bj)
#pragma unroll
              for (int n = 0; n < 2; ++n) pv[bj][n] = *(const f32x4*)(pmv0 + vo + col0 + bj * HALF + n * 16);
#pragma unroll
          for (int ai = 0; ai < 2; ++ai)
#pragma unroll
              for (int m = 0; m < 4; ++m) { const int r = ai * HALF + wr * 64 + m * 16 + fr; const float rs = __builtin_amdgcn_rsqf(S[r] * (1.f / 1024.f) + eps); const size_t off = (size_t)(u.pm * BM + r) * 1024 + col0;
#pragma unroll
                  for (int bj = 0; bj < 2; ++bj)
#pragma unroll
                      for (int n = 0; n < 2; ++n) { const f32x2 hw = *(const f32x2*)(hb + off + bj * HALF + n * 16); const unsigned h0 = __float_as_uint(hw.x), h1 = __float_as_uint(hw.y);
                          const f32x4 hv = {__uint_as_float(h0 << 16), __uint_as_float(h0 & 0xffff0000u), __uint_as_float(h1 << 16), __uint_as_float(h1 & 0xffff0000u)};
                          const f32x4 hn = hv + pv[bj][n] * acc[ai][bj][m][n] * rs;
                          const unsigned w0 = pkbf(hn[0], hn[1]), w1 = pkbf(hn[2], hn[3]);
                          *(f32x2*)(hb + off + bj * HALF + n * 16) = (f32x2){__uint_as_float(w0), __uint_as_float(w1)};
                          acc[ai][bj][m][n] = (f32x4){__uint_as_float(w0 << 16), __uint_as_float(w0 & 0xffff0000u), __uint_as_float(w1 << 16), __uint_as_float(w1 & 0xffff0000u)}; }
                  asm volatile("" ::: "memory"); } }
        st2.run(acc, u, wr, wc, fr, fq, lds, wid, lane);
        { f32x4 av[2][2], bv[2][2];
#pragma unroll
          for (int bj = 0; bj < 2; ++bj)
#pragma unroll
              for (int n = 0; n < 2; ++n) { av[bj][n] = *(const f32x4*)(av0 + vo + col0 + bj * HALF + n * 16); bv[bj][n] = *(const f32x4*)(bv0 + vo + col0 + bj * HALF + n * 16); }
#pragma unroll
          for (int ai = 0; ai < 2; ++ai)
#pragma unroll
              for (int m = 0; m < 4; ++m) { const int r = ai * HALF + wr * 64 + m * 16 + fr; const float rs = __builtin_amdgcn_rsqf(S[r] * (1.f / 1024.f) + eps); const size_t off = (size_t)(u.pm * BM + r) * 1024 + col0;
#pragma unroll
                  for (int bj = 0; bj < 2; ++bj)
#pragma unroll
                      for (int n = 0; n < 2; ++n) { const f32x4 o = acc[ai][bj][m][n] * rs * av[bj][n] + bv[bj][n];
                          *(f32x2*)(uo + off + bj * HALF + n * 16) = (f32x2){__uint_as_float(pkbf(o[0], o[1])), __uint_as_float(pkbf(o[2], o[3]))}; } } }
    }
};
__device__ __forceinline__ float silu_mul(float g, float u) { return g * __builtin_amdgcn_rcpf(1.f + __builtin_amdgcn_exp2f(-g)) * u; }
struct EpiSwiglu {
    static constexpr bool PERM = true, AFTER_DRAIN = false;
    bf16_t* O; int ldc;
    __device__ __forceinline__ void operator()(const f32x4 (&acc)[2][2][4][2], const Unit& u, int wr, int wc, int fr, int fq) const {
        const int row0 = u.pm * BM + wr * 64 + fr; const int col0 = u.pn * HALF + wc * 32 + 8 * fq;
#pragma unroll
        for (int ai = 0; ai < 2; ++ai)
#pragma unroll
            for (int m = 0; m < 4; ++m) { bf16_t* rowp = O + (size_t)(row0 + ai * HALF + m * 16) * ldc + col0;
                const f32x4 g0 = acc[ai][0][m][0], g1 = acc[ai][0][m][1], u0 = acc[ai][1][m][0], u1 = acc[ai][1][m][1];
                u32x4 w; w.x = cvt_pk_bf16(silu_mul(g0[0], u0[0]), silu_mul(g0[1], u0[1])); w.y = cvt_pk_bf16(silu_mul(g0[2], u0[2]), silu_mul(g0[3], u0[3]));
                w.z = cvt_pk_bf16(silu_mul(g1[0], u1[0]), silu_mul(g1[1], u1[1])); w.w = cvt_pk_bf16(silu_mul(g1[2], u1[2]), silu_mul(g1[3], u1[3]));
                *(u32x4*)rowp = w; }
    }
};
template <class Epi, class Sched, bool ALIGN_EPI = false, bool SP2 = false>
__device__ __forceinline__ void gemm_phase(PG8_LAS unsigned char* lds, const Gemm g, const Sched& S, const Epi& E) {
    int tid_ = threadIdx.x; asm volatile("" : "+v"(tid_));
    const int tid = tid_, wid = __builtin_amdgcn_readfirstlane(tid >> 6), lane = tid & 63, wr = wid >> 2, wc = wid & 3, fr = lane & 15, fq = lane >> 4;
    const int K = g.K, nt = K / BK, LD = g.ld ? g.ld : g.K;
    unsigned voffA[2], voffB[2];
#pragma unroll
    for (int i = 0; i < 2; ++i) { int R, C; stage_rc(tid * 16 + i * 8192, R, C); const int Rb = Epi::PERM ? ((R & ~31) + perm32(R & 31)) : R;
        voffA[i] = (unsigned)(R * LD + C) * 2u; voffB[i] = (unsigned)(Rb * LD + C) * 2u; }
    const size_t kstep = (size_t)(BK * 2);
    const size_t hstep = (size_t)HALF * LD * 2;
    const size_t tstep = 2 * hstep;
    const unsigned ldsw = (unsigned)wid * 1024u;
    const int aoff = lds_byte(wr * 64 + fr, fq * 8), boff = lds_byte(wc * 32 + fr, fq * 8);
#define PG8_SA(b, h) (((b) * 2 + (h)) * HTB)
#define PG8_SB(b, h) ((4 + (b) * 2 + (h)) * HTB)
#define PG8_STAGE(bufoff, gbase, voff) do { _Pragma("unroll") for (int _i = 0; _i < 2; ++_i) \
        __builtin_amdgcn_global_load_lds((const unsigned*)((const char*)(gbase) + (voff)[_i]), (PG8_LAS unsigned*)(lds + (bufoff) + ldsw + _i * 8192), 16, 0, 0); } while (0)
#define PG8_LDA(dst, b, h) do { _Pragma("unroll") for (int m = 0; m < 4; ++m) _Pragma("unroll") for (int k = 0; k < 2; ++k) dst[m][k] = *(const PG8_LAS bf16x8*)(lds + PG8_SA(b, h) + aoff + m * 2048 + k * 1024); } while (0)
#define PG8_LDB(dst, b, h) do { _Pragma("unroll") for (int n = 0; n < 2; ++n) _Pragma("unroll") for (int k = 0; k < 2; ++k) dst[n][k] = *(const PG8_LAS bf16x8*)(lds + PG8_SB(b, h) + boff + n * 2048 + k * 1024); } while (0)
#define PG8_MMA(ai, bj, At, Bt) do { __builtin_amdgcn_s_setprio(1); _Pragma("unroll") for (int m = 0; m < 4; ++m) _Pragma("unroll") for (int n = 0; n < 2; ++n) _Pragma("unroll") for (int k = 0; k < 2; ++k) \
        acc[ai][bj][m][n] = __builtin_amdgcn_mfma_f32_16x16x32_bf16(Bt[n][k], At[m][k], acc[ai][bj][m][n], 0, 0, 0); __builtin_amdgcn_s_setprio(0); } while (0)
#define PG8_WAIT_V(n) asm volatile("s_waitcnt vmcnt(" #n ")" ::: "memory")
#define PG8_WAIT_L(n) asm volatile("s_waitcnt lgkmcnt(" #n ")" ::: "memory")
#define PG8_BAR __builtin_amdgcn_s_barrier()
#define PG8_SCHED __builtin_amdgcn_sched_barrier(0)
    Unit cur, nxt; int ui = 0;
    if (!S.next(0, cur)) return;
    f32x4 acc[2][2][4][2];
#pragma unroll
    for (int a = 0; a < 2; ++a)
#pragma unroll
        for (int b = 0; b < 2; ++b)
#pragma unroll
            for (int m = 0; m < 4; ++m)
#pragma unroll
                for (int n = 0; n < 2; ++n) acc[a][b][m][n] = (f32x4){0.f, 0.f, 0.f, 0.f};
    bf16x8 At[4][2], B0[2][2], B1[2][2];
    const char* cA = (const char*)g.A + (size_t)cur.pm * tstep; const char* cB = (const char*)g.Bt + (size_t)cur.pn * tstep;
    S.a_ready(cur);
    if constexpr (SP2) {
        PG8_STAGE(PG8_SB(0, 0), cB, voffB); PG8_STAGE(PG8_SB(0, 1), cB + hstep, voffB); PG8_STAGE(PG8_SA(0, 0), cA, voffA); PG8_STAGE(PG8_SA(0, 1), cA + hstep, voffA);
        if (wr == 1) PG8_BAR;
        PG8_WAIT_V(2); PG8_BAR;
        PG8_STAGE(PG8_SB(1, 0), cB + kstep, voffB); PG8_STAGE(PG8_SA(1, 0), cA + kstep, voffA); PG8_STAGE(PG8_SB(1, 1), cB + hstep + kstep, voffB);
        PG8_WAIT_V(6); PG8_BAR;
    } else {
        PG8_STAGE(PG8_SB(0, 0), cB, voffB); PG8_STAGE(PG8_SA(0, 0), cA, voffA); PG8_STAGE(PG8_SB(0, 1), cB + hstep, voffB); PG8_STAGE(PG8_SA(0, 1), cA + hstep, voffA);
        if (wr == 1) PG8_BAR;
        PG8_WAIT_V(4); PG8_BAR;
        PG8_STAGE(PG8_SB(1, 0), cB + kstep, voffB); PG8_STAGE(PG8_SA(1, 0), cA + kstep, voffA); PG8_STAGE(PG8_SB(1, 1), cB + hstep + kstep, voffB);
        PG8_WAIT_V(6); PG8_BAR;
    }
    for (;;) {
        const bool has_next = S.next(ui + 1, nxt);
        const char* nA = has_next ? (const char*)g.A + (size_t)nxt.pm * tstep : cA; const char* nB = has_next ? (const char*)g.Bt + (size_t)nxt.pn * tstep : cB;
        for (int t = 0; t < nt; t += 2) {
            const bool last = (t == nt - 2);
            const char* a1 = cA + (size_t)(t + 1) * kstep;
            const char* a2 = last ? nA : cA + (size_t)(t + 2) * kstep; const char* b2 = last ? nB : cB + (size_t)(t + 2) * kstep;
            const char* a3 = a2 + kstep; const char* b3 = b2 + kstep;
            if (last && has_next) S.a_ready(nxt);
            if constexpr (SP2) {
            PG8_LDB(B0, 0, 0); PG8_LDB(B1, 0, 1); PG8_SCHED; PG8_LDA(At, 0, 0); PG8_STAGE(PG8_SA(1, 1), a1 + hstep, voffA);
            PG8_WAIT_V(8); PG8_WAIT_L(0); PG8_BAR; PG8_MMA(0, 0, At, B0); PG8_MMA(0, 1, At, B1); PG8_BAR; PG8_SCHED;
            PG8_LDA(At, 0, 1); PG8_STAGE(PG8_SB(0, 0), b2, voffB); PG8_STAGE(PG8_SB(0, 1), b2 + hstep, voffB); PG8_STAGE(PG8_SA(0, 0), a2, voffA);
            PG8_WAIT_V(8); PG8_WAIT_L(0); PG8_BAR; PG8_MMA(1, 0, At, B0); PG8_MMA(1, 1, At, B1); PG8_BAR; PG8_SCHED;
            PG8_LDB(B0, 1, 0); PG8_LDB(B1, 1, 1); PG8_SCHED; PG8_LDA(At, 1, 0); PG8_STAGE(PG8_SA(0, 1), a2 + hstep, voffA);
            PG8_WAIT_V(8); PG8_WAIT_L(0); PG8_BAR; PG8_MMA(0, 0, At, B0); PG8_MMA(0, 1, At, B1); PG8_BAR; PG8_SCHED;
            PG8_LDA(At, 1, 1); PG8_STAGE(PG8_SB(1, 0), b3, voffB); PG8_STAGE(PG8_SB(1, 1), b3 + hstep, voffB); PG8_STAGE(PG8_SA(1, 0), a3, voffA);
            PG8_WAIT_V(8); PG8_WAIT_L(0); PG8_BAR; PG8_MMA(1, 0, At, B0); PG8_MMA(1, 1, At, B1); PG8_BAR; PG8_SCHED;
            } else {
            PG8_LDB(B0, 0, 0); PG8_SCHED; PG8_LDA(At, 0, 0); PG8_STAGE(PG8_SA(1, 1), a1 + hstep, voffA);
            PG8_WAIT_L(8); PG8_BAR; PG8_WAIT_L(0); PG8_MMA(0, 0, At, B0); PG8_BAR; PG8_SCHED;
            PG8_LDB(B1, 0, 1); PG8_STAGE(PG8_SB(0, 0), b2, voffB);
            PG8_BAR; PG8_WAIT_L(0); PG8_MMA(0, 1, At, B1); PG8_BAR;
            PG8_LDA(At, 0, 1); PG8_STAGE(PG8_SA(0, 0), a2, voffA);
            PG8_BAR; PG8_WAIT_L(0); PG8_MMA(1, 0, At, B0); PG8_BAR; PG8_SCHED;
            PG8_STAGE(PG8_SB(0, 1), b2 + hstep, voffB);
            PG8_WAIT_V(6); PG8_BAR; PG8_MMA(1, 1, At, B1); PG8_BAR;
            PG8_LDB(B0, 1, 0); PG8_SCHED; PG8_LDA(At, 1, 0); PG8_STAGE(PG8_SA(0, 1), a2 + hstep, voffA);
            PG8_WAIT_L(8); PG8_BAR; PG8_WAIT_L(0); PG8_MMA(0, 0, At, B0); PG8_BAR; PG8_SCHED;
            PG8_LDB(B1, 1, 1); PG8_STAGE(PG8_SB(1, 0), b3, voffB);
            PG8_BAR; PG8_WAIT_L(0); PG8_MMA(0, 1, At, B1); PG8_BAR;
            PG8_LDA(At, 1, 1); PG8_STAGE(PG8_SA(1, 0), a3, voffA);
            PG8_BAR; PG8_WAIT_L(0); PG8_MMA(1, 0, At, B0); PG8_BAR; PG8_SCHED;
            PG8_STAGE(PG8_SB(1, 1), b3 + hstep, voffB);
            PG8_WAIT_V(6); PG8_BAR; PG8_MMA(1, 1, At, B1); PG8_BAR;
            }
        }
        if constexpr (ALIGN_EPI) { if (wr == 0) PG8_BAR; }
        if constexpr (!Epi::AFTER_DRAIN) { E(acc, cur, wr, wc, fr, fq); S.done(cur); }
        if (!has_next) break;
#pragma unroll
        for (int a = 0; a < 2; ++a)
#pragma unroll
            for (int b = 0; b < 2; ++b)
#pragma unroll
                for (int m = 0; m < 4; ++m)
#pragma unroll
                    for (int n = 0; n < 2; ++n) acc[a][b][m][n] = (f32x4){0.f, 0.f, 0.f, 0.f};
        cur = nxt; cA = nA; cB = nB; ++ui;
        if constexpr (ALIGN_EPI) { if (wr == 1) PG8_BAR; }
    }
    PG8_WAIT_V(0);
    if constexpr (!ALIGN_EPI) { if (wr == 0) PG8_BAR; }
    PG8_BAR;
    if constexpr (Epi::AFTER_DRAIN) { E.fused(acc, cur, wr, wc, fr, fq, lds, wid, lane); S.done(cur); }
#undef PG8_SA
#undef PG8_SB
#undef PG8_STAGE
#undef PG8_LDA
#undef PG8_LDB
#undef PG8_MMA
#undef PG8_WAIT_V
#undef PG8_WAIT_L
#undef PG8_BAR
#undef PG8_SCHED
}
}

#define XB_TMO      128
#define XB_XCNT(j)  (256  + 64 * (j))
#define XB_XSUB(j)  (1280 + 64 * (j))
#define XB_XGEN(j)  (2304 + 64 * (j))
#define XB_TOP      3328
#define XB_TOPGEN   3392
#define XCD_BAR_WORDS 3456
#define XB_SPIN_CAP (1u << 18)
#define LAS __attribute__((address_space(3)))

__device__ __forceinline__ unsigned xb_ld(unsigned* p)              { return __hip_atomic_load(p, __ATOMIC_RELAXED, __HIP_MEMORY_SCOPE_AGENT); }
__device__ __forceinline__ unsigned xb_add(unsigned* p, unsigned v) { return __hip_atomic_fetch_add(p, v, __ATOMIC_RELAXED, __HIP_MEMORY_SCOPE_AGENT); }
__device__ __forceinline__ unsigned xb_xcc_id() { return (unsigned)__builtin_amdgcn_s_getreg((3 << 11) | 20) & 0xFu; }
#define XB_SPIN(cond, bar) do { unsigned _sp = 0; while (cond) { __builtin_amdgcn_s_sleep(12); \
    if ((++_sp & 255u) == 0u) { if (xb_ld(&(bar)[XB_TMO])) break; if (_sp > XB_SPIN_CAP) { atomicAdd(&(bar)[XB_TMO], 1u); break; } } } } while (0)

struct XcdBarrier {
    unsigned* bar; unsigned x;
    volatile LAS unsigned* st;
};

__device__ __forceinline__ XcdBarrier xcd_barrier_post(unsigned* bar, volatile LAS unsigned* st) {
    XcdBarrier b; b.bar = bar; b.x = xb_xcc_id(); b.st = st;
    if (threadIdx.x == 0) (void)xb_add(&bar[XB_XCNT(b.x)], 1u);
    return b;
}
__device__ __forceinline__ void xcd_barrier_complete(unsigned* bar, unsigned x, unsigned& nloc, unsigned& nx) {
    const unsigned G = gridDim.x * gridDim.y * gridDim.z;
    unsigned sum, cnt, mine, sp = 0u;
    for (;;) {
        sum = 0u; cnt = 0u; mine = 0u;
#pragma unroll
        for (unsigned j = 0; j < 16; ++j) { const unsigned c = xb_ld(&bar[XB_XCNT(j)]); sum += c; cnt += (c > 0u) ? 1u : 0u; mine = (j == x) ? c : mine; }
        if (sum == G) break;
        __builtin_amdgcn_s_sleep(1);
        if ((++sp & 255u) == 0u) { if (xb_ld(&bar[XB_TMO])) break; if (sp > XB_SPIN_CAP) { atomicAdd(&bar[XB_TMO], 1u); break; } }
    }
    nloc = mine > 0u ? mine : 1u; nx = cnt > 0u ? cnt : 1u;
}

__device__ __forceinline__ void xcd_barrier(const XcdBarrier& b) {
    asm volatile("s_waitcnt vmcnt(0)" ::: "memory");
    __syncthreads();
    if (threadIdx.x == 0) {
        unsigned* bar = b.bar;
        __builtin_amdgcn_s_waitcnt(0);
        unsigned nloc = b.st[0], nx = b.st[1];
        if (nloc == 0u) { xcd_barrier_complete(bar, b.x, nloc, nx); b.st[0] = nloc; b.st[1] = nx; }
        const unsigned old = xb_add(&bar[XB_XSUB(b.x)], 1u);
        const unsigned gen = old / nloc;
        if (old + 1u == (gen + 1u) * nloc) {
            __builtin_amdgcn_fence(__ATOMIC_RELEASE, "agent");
            asm volatile("s_waitcnt vmcnt(0)" ::: "memory");
            const unsigned og = xb_add(&bar[XB_TOP], 1u);
            const unsigned tg = og / nx;
            if (og + 1u == (tg + 1u) * nx) xb_add(&bar[XB_TOPGEN], 1u);
            else XB_SPIN(xb_ld(&bar[XB_TOPGEN]) == tg, bar);
            __builtin_amdgcn_fence(__ATOMIC_ACQUIRE, "agent");
            xb_add(&bar[XB_XGEN(b.x)], 1u);
            asm volatile("s_waitcnt vmcnt(0)" ::: "memory");
        } else {
            XB_SPIN(xb_ld(&bar[XB_XGEN(b.x)]) == gen, bar);
            __builtin_amdgcn_fence(__ATOMIC_ACQUIRE, "agent");
            asm volatile("s_waitcnt vmcnt(0)" ::: "memory");
        }
    }
    __syncthreads();
}

#define GAS __attribute__((address_space(1)))
typedef float f32x4 __attribute__((ext_vector_type(4)));
typedef unsigned v4u __attribute__((ext_vector_type(4)));
typedef unsigned v2u __attribute__((ext_vector_type(2)));
constexpr int NWAVES = 8, NTHREADS = NWAVES * 64;
constexpr int RING_BYTES = 131072, LDS_BYTES = 147456, MISC_OFF = LDS_BYTES - 512;
constexpr int CW_BAR = 4096;
static_assert((CW_BAR + XCD_BAR_WORDS) * 4 <= (int)CTL_BYTES, "ctl");
constexpr int CW_PAN = 16384;
constexpr int CW_SUB = 8192, NSUBWG = 64;
__device__ __forceinline__ void sub_barrier(unsigned* cnt, unsigned target) {
    asm volatile("s_waitcnt vmcnt(0)" ::: "memory");
    __syncthreads();
    if (threadIdx.x == 0) {
        __builtin_amdgcn_fence(__ATOMIC_RELEASE, "agent"); asm volatile("s_waitcnt vmcnt(0)" ::: "memory");
        (void)xb_add(cnt, 1u);
        unsigned sp = 0; while (xb_ld(cnt) < target) { __builtin_amdgcn_s_sleep(12); if (++sp > XB_SPIN_CAP) break; }
        __builtin_amdgcn_fence(__ATOMIC_ACQUIRE, "agent"); asm volatile("s_waitcnt vmcnt(0)" ::: "memory");
    }
    __syncthreads();
}

template <int CTRL, int RM> __device__ __forceinline__ float dppf0(float src) { return __int_as_float(__builtin_amdgcn_update_dpp(0, __float_as_int(src), CTRL, RM, 0xf, false)); }
__device__ __forceinline__ float gla_scan_add(float v) {
    v += dppf0<0x111, 0xf>(v); v += dppf0<0x112, 0xf>(v); v += dppf0<0x114, 0xf>(v); v += dppf0<0x118, 0xf>(v); v += dppf0<0x142, 0xa>(v); v += dppf0<0x143, 0xc>(v); return v; }
__device__ __forceinline__ float wave_sum(float v) {
#pragma unroll
    for (int o = 1; o < 64; o <<= 1) v += __shfl_xor(v, o);
    return v;
}
__device__ __forceinline__ unsigned pk2(float lo, float hi) { return pkbf(lo, hi); }

__device__ __forceinline__ void wt_item(const float* W, int ldw, int lim, int col0, int k0, bf16* WT, int K, int n0, LAS float* scr, int lane, float scl = 1.f) {
    const int cc = col0 + (lane & 31); const bool ok = cc < lim;
    float wv_[32];
#pragma unroll
    for (int i = 0; i < 32; ++i) { const int kk = 2 * i + (lane >> 5); wv_[i] = ok ? W[(size_t)(k0 + kk) * ldw + cc] : 0.f; }
#pragma unroll
    for (int i = 0; i < 32; ++i) { const int kk = 2 * i + (lane >> 5); scr[kk * 33 + (lane & 31)] = wv_[i] * scl; }
    asm volatile("s_waitcnt lgkmcnt(0)" ::: "memory");
    const int c = lane & 7;
#pragma unroll
    for (int j = 0; j < 4; ++j) { const int n = (lane >> 3) + 8 * j; const LAS float* s = scr + (8 * c) * 33 + n;
        v4u o; o.x = pk2(s[0 * 33], s[1 * 33]); o.y = pk2(s[2 * 33], s[3 * 33]); o.z = pk2(s[4 * 33], s[5 * 33]); o.w = pk2(s[6 * 33], s[7 * 33]);
        *(GAS v4u*)(WT + (size_t)(n0 + n) * K + k0 + 8 * c) = o; }
    asm volatile("s_waitcnt lgkmcnt(0)" ::: "memory");
}
constexpr int WCONV_ITEMS = 2 * ((DM / 64) * (2 * DFF / 32)) + 2 * ((DFF / 64) * (DM / 32)) + (DM / 64) * (ZP / 32) + (DM / 64) * (DM / 32);
__device__ __forceinline__ void ph_wconv(const P& p, int l, LAS unsigned char* lds, int gw, int ngw, int wave, int lane, int i0 = 0, int i1 = WCONV_ITEMS) {
    LAS float* scr = (LAS float*)(lds + wave * 16384);
    constexpr int I_GU = (DM / 64) * (2 * DFF / 32), I_D = (DFF / 64) * (DM / 32), I_IN = (DM / 64) * (ZP / 32), I_OUT = (DM / 64) * (DM / 32);
    constexpr int PER_L = 2 * I_GU + 2 * I_D + I_IN + I_OUT;
    static_assert(PER_L == WCONV_ITEMS, "items");
    for (int it = i0 + gw; it < i1; it += ngw) {
        int r = it;
        if (r < 2 * I_GU) { const int sub = r / I_GU; r %= I_GU; const int nblk = 2 * DFF / 32, kb = r / nblk, nb = r % nblk, n0 = nb * 32; const int tile = n0 / 256, w = n0 % 256;
            const float* src = p.in[w < 128 ? (sub ? I_F2G : I_F1G) : (sub ? I_F2U : I_F1U)] + (size_t)l * DM * DFF;
            wt_item(src, DFF, DFF, tile * 128 + (w & 127), kb * 64, wl(p, l, sub ? WL_GU2 : WL_GU1), DM, n0, scr, lane, w < 128 ? 1.4426950408889634f : 0.6931471805599453f); continue; }
        r -= 2 * I_GU;
        if (r < 2 * I_D) { const int sub = r / I_D; r %= I_D; const int nblk = DM / 32, kb = r / nblk, nb = r % nblk;
            wt_item(p.in[sub ? I_F2D : I_F1D] + (size_t)l * DFF * DM, DM, DM, nb * 32, kb * 64, wl(p, l, sub ? WL_D2 : WL_D1), DFF, nb * 32, scr, lane); continue; }
        r -= 2 * I_D;
        if (r < I_IN) { const int nblk = ZP / 32, kb = r / nblk, nb = r % nblk;
            wt_item(p.in[I_WIN] + (size_t)l * DM * INW, INW, INW, nb * 32, kb * 64, wl(p, l, WL_IN), DM, nb * 32, scr, lane); continue; }
        r -= I_IN;
        { const int nblk = DM / 32, kb = r / nblk, nb = r % nblk;
            wt_item(p.in[I_WOUT] + (size_t)l * DM * DM, DM, DM, nb * 32, kb * 64, wl(p, l, WL_OUT), DM, nb * 32, scr, lane); }
    }
}
__device__ __forceinline__ void ph_modpart_gpu(const P& p, LAS unsigned char* lds, int tid, int gtid, int nth) {
    LAS float* sc = (LAS float*)lds;
    for (int i = tid; i < NMOD * DM; i += NTHREADS) { const int b = i / DM, k = i % DM; sc[i] = siluf(b < NB ? p.in[I_C][b * DM + k] : p.in[I_CCTX][k]); }
    __syncthreads();
    constexpr int KS = DM / KSPLIT;
    for (long it = gtid; it < (long)KSPLIT * DEPTH * 9 * DM; it += nth) {
        const int col = (int)(it % (9 * DM)); const int l = (int)((it / (9 * DM)) % DEPTH); const int ks = (int)(it / ((long)9 * DM * DEPTH));
        const float* w = p.in[I_ADAW] + (size_t)l * DM * 9 * DM + col;
        float acc[NMOD];
#pragma unroll
        for (int b = 0; b < NMOD; ++b) acc[b] = 0.f;
        for (int k0 = ks * KS; k0 < (ks + 1) * KS; k0 += 8) { float wv[8];
#pragma unroll
            for (int j = 0; j < 8; ++j) wv[j] = w[(size_t)(k0 + j) * 9 * DM];
#pragma unroll
            for (int j = 0; j < 8; ++j)
#pragma unroll
                for (int b = 0; b < NMOD; ++b) acc[b] += sc[b * DM + k0 + j] * wv[j]; }
#pragma unroll
        for (int b = 0; b < NMOD; ++b) wsf(p, WS_MODP)[(((size_t)ks * DEPTH + l) * NMOD + b) * 9 * DM + col] = acc[b];
    }
    __syncthreads();
}
__device__ __forceinline__ f32x4 up4(v2u w) { return (f32x4){__uint_as_float(w.x << 16), __uint_as_float(w.x & 0xffff0000u), __uint_as_float(w.y << 16), __uint_as_float(w.y & 0xffff0000u)}; }
__device__ __forceinline__ float sq4(f32x4 v) { return (v.x * v.x + v.y * v.y) + (v.z * v.z + v.w * v.w); }
__device__ __forceinline__ f32x4 lo4(v4u w) { return up4((v2u){w.x, w.y}); }
__device__ __forceinline__ f32x4 hi4(v4u w) { return up4((v2u){w.z, w.w}); }
template <bool UPD, bool MK, bool Y2 = false> __device__ __forceinline__ void ph_thin(const P& p, int lu, int su, int lm, int sm, int gw, int ngw, int lane, int mrows = M, int rbase = 0) {
    constexpr int NV = DM / 512, RB = 6;
    const int rpw = (mrows - rbase + ngw - 1) / ngw, rbeg = rbase + gw * rpw, rend = (rbeg + rpw < mrows) ? rbeg + rpw : mrows;
    for (int r0 = rbeg; r0 < rend; r0 += RB) {
        v4u hp[RB][NV], yp[RB][NV]; float ss[RB];
#pragma unroll
        for (int q = 0; q < RB; ++q) { const int r = (r0 + q < rend) ? r0 + q : rend - 1;
            const v4u* hr = (const v4u*)(wsb(p, WS_HB) + (size_t)r * DM); const v4u* yr = (const v4u*)(wsb(p, WS_Y) + (size_t)r * DM);
#pragma unroll
            for (int j = 0; j < NV; ++j) { hp[q][j] = hr[lane + 64 * j]; if (UPD) yp[q][j] = yr[lane + 64 * j]; } }
        if (UPD && Y2) {
            v4u yq[RB][NV];
#pragma unroll
            for (int q = 0; q < RB; ++q) { const int r = (r0 + q < rend) ? r0 + q : rend - 1; const v4u* yr2 = (const v4u*)(wsb(p, WS_HC) + (size_t)(r - ML) * DM);
#pragma unroll
                for (int j = 0; j < NV; ++j) yq[q][j] = yr2[lane + 64 * j]; }
#pragma unroll
            for (int q = 0; q < RB; ++q)
#pragma unroll
                for (int j = 0; j < NV; ++j) { const f32x4 a0 = lo4(yp[q][j]) + lo4(yq[q][j]), a1 = hi4(yp[q][j]) + hi4(yq[q][j]);
                    v4u w; w.x = pk2(a0.x, a0.y); w.y = pk2(a0.z, a0.w); w.z = pk2(a1.x, a1.y); w.w = pk2(a1.z, a1.w); yp[q][j] = w; } }
        if (UPD) {
#pragma unroll
            for (int q = 0; q < RB; ++q) { ss[q] = 0.f;
#pragma unroll
                for (int j = 0; j < NV; ++j) ss[q] += sq4(lo4(yp[q][j])) + sq4(hi4(yp[q][j])); }
#pragma unroll
            for (int q = 0; q < RB; ++q) ss[q] = __int_as_float(__builtin_amdgcn_readlane(__float_as_int(gla_scan_add(ss[q])), 63));
#pragma unroll
            for (int q = 0; q < RB; ++q) { const int r = (r0 + q < rend) ? r0 + q : rend - 1; const bool ok = r0 + q < rend;
                const float rs = __builtin_amdgcn_rsqf(ss[q] * (1.f / DM) + EPS); const f32x4* pm = (const f32x4*)vecp(p, lu, su, 2, modidx(r));
#pragma unroll
                for (int j = 0; j < NV; ++j) { const int c4 = 2 * (lane + 64 * j);
                    const f32x4 h0 = lo4(hp[q][j]) + pm[c4] * lo4(yp[q][j]) * rs, h1 = hi4(hp[q][j]) + pm[c4 + 1] * hi4(yp[q][j]) * rs;
                    if (MK) { v4u w; w.x = pk2(h0.x, h0.y); w.y = pk2(h0.z, h0.w); w.z = pk2(h1.x, h1.y); w.w = pk2(h1.z, h1.w); hp[q][j] = w; if (ok) ((v4u*)(wsb(p, WS_HB) + (size_t)r * DM))[lane + 64 * j] = w; }
                    else if (ok) { f32x4* op = (f32x4*)(p.out + (size_t)r * DM); op[c4] = h0; op[c4 + 1] = h1; } } }
        }
        if (MK) {
#pragma unroll
            for (int q = 0; q < RB; ++q) { ss[q] = 0.f;
#pragma unroll
                for (int j = 0; j < NV; ++j) ss[q] += sq4(lo4(hp[q][j])) + sq4(hi4(hp[q][j])); }
#pragma unroll
            for (int q = 0; q < RB; ++q) ss[q] = __int_as_float(__builtin_amdgcn_readlane(__float_as_int(gla_scan_add(ss[q])), 63));
#pragma unroll
            for (int q = 0; q < RB; ++q) { const int r = r0 + q; if (r < rend) { const int bi = modidx(r);
                const float rs = __builtin_amdgcn_rsqf(ss[q] * (1.f / DM) + EPS);
                const f32x4* a = (const f32x4*)vecp(p, lm, sm, 0, bi); const f32x4* b = (const f32x4*)vecp(p, lm, sm, 1, bi); v4u* ur = (v4u*)(wsb(p, WS_U) + (size_t)r * DM);
#pragma unroll
                for (int j = 0; j < NV; ++j) { const int c4 = 2 * (lane + 64 * j); const f32x4 o0 = lo4(hp[q][j]) * rs * a[c4] + b[c4], o1 = hi4(hp[q][j]) * rs * a[c4 + 1] + b[c4 + 1];
                    v4u w; w.x = pk2(o0.x, o0.y); w.y = pk2(o0.z, o0.w); w.z = pk2(o1.x, o1.y); w.w = pk2(o1.z, o1.w); ur[lane + 64 * j] = w; } } }
        }
    }
}


namespace att {
typedef short bf16x8 __attribute__((ext_vector_type(8)));
typedef short s16x4 __attribute__((ext_vector_type(4)));
typedef float f32x16 __attribute__((ext_vector_type(16)));
constexpr int KBUF = 0, VBUF = 32768, SLOT = 8192;
constexpr float C2 = 0.125f * 1.4426950408889634f;
__device__ __forceinline__ int crow(int r, int hi) { return (r & 3) + 8 * (r >> 2) + 4 * hi; }
typedef float f32x2_t __attribute__((ext_vector_type(2))); typedef __bf16 bf16x2_t __attribute__((ext_vector_type(2)));
__device__ __forceinline__ unsigned cvtpk(float lo, float hi) { const f32x2_t v = {lo, hi}; const bf16x2_t b = __builtin_convertvector(v, bf16x2_t); return __builtin_bit_cast(unsigned, b); }

__device__ __forceinline__ float max3f(float a, float b, float c) { float r; asm("v_max3_f32 %0, %1, %2, %3" : "=v"(r) : "v"(a), "v"(b), "v"(c)); return r; }
__device__ __forceinline__ float max32(float x) { const auto r = __builtin_amdgcn_permlane32_swap(__float_as_uint(x), __float_as_uint(x), false, false); return fmaxf(__uint_as_float(r[0]), __uint_as_float(r[1])); }
__device__ __forceinline__ float sum32(float x) { const auto r = __builtin_amdgcn_permlane32_swap(__float_as_uint(x), __float_as_uint(x), false, false); return __uint_as_float(r[0]) + __uint_as_float(r[1]); }
__device__ __forceinline__ s16x4 vtr(const LAS unsigned char* p) { return __builtin_bit_cast(s16x4, __builtin_amdgcn_ds_read_tr16_b64_v4i16((LAS s16x4*)p)); }

__device__ __forceinline__ void unit(const P& p, LAS unsigned char* lds, int l, int b, int g, int qrow0, int qpos0, int kw0, int ntw, int tid) {
    const int lane = tid & 63, r32 = lane & 31, hi = lane >> 5; const int wave = __builtin_amdgcn_readfirstlane(tid >> 6);
    const int hq = g * AGRP + (wave & 3), qh = wave >> 2;
    const bf16* Z = wsb(p, WS_ACT);
    const int nt = ntw + CTXL / 64;
    const bf16* ksrc = Z + (size_t)lane * ZP + ZK + g * 64 + wave * 8;
    const bf16* vsrc = Z + (size_t)(16 * (wave & 3) + (lane >> 2)) * ZP + ZV + g * 64 + (wave >> 2) * 32 + (lane & 3) * 8;
#define ATT_DMA(t, slot) do { const int kr_ = (t) < ntw ? b * SEQ + kw0 + 64 * (t) : ML + b * CTXL + 64 * ((t) - ntw); \
        __builtin_amdgcn_global_load_lds((const unsigned*)(ksrc + (size_t)kr_ * ZP), (LAS unsigned*)(lds + KBUF + (slot) * SLOT + wave * 1024), 16, 0, 0); \
        __builtin_amdgcn_global_load_lds((const unsigned*)(vsrc + (size_t)kr_ * ZP), (LAS unsigned*)(lds + VBUF + (slot) * SLOT + wave * 1024), 16, 0, 0); } while (0)
#define ATT_DMA2(tp, ps) do { ATT_DMA(2 * (tp), 2 * (ps)); if (2 * (tp) + 1 < nt) ATT_DMA(2 * (tp) + 1, 2 * (ps) + 1); } while (0)
    ATT_DMA2(0, 0);
    bf16x8 qf[1][4];
    { const int j = 0; const bf16* qp = Z + (size_t)(qrow0 + qh * 32 + r32) * ZP + ZQ + hq * 64 + hi * 8;
        v4u x[4]; f32x4 ct[2][4]; const bool lat = qrow0 < ML;
        { const int t = qpos0 + qh * 32 + r32; const float* rt = wsf(p, WS_ROPE);
#pragma unroll
          for (int d0 = 0; d0 < 4; ++d0) x[d0] = *(const v4u*)(qp + d0 * 16);
          if (lat) {
#pragma unroll
            for (int hf = 0; hf < 2; ++hf) { const int pos = hf == 0 ? t / GRIDW : t % GRIDW; const f32x4* cp = (const f32x4*)(rt + 32 * pos + 16 * hi);
#pragma unroll
                for (int c = 0; c < 4; ++c) ct[hf][c] = cp[c]; } } }
        float f[4][8];
#pragma unroll
        for (int d0 = 0; d0 < 4; ++d0) { f[d0][0] = __uint_as_float(x[d0].x << 16); f[d0][1] = __uint_as_float(x[d0].x & 0xffff0000u); f[d0][2] = __uint_as_float(x[d0].y << 16); f[d0][3] = __uint_as_float(x[d0].y & 0xffff0000u);
            f[d0][4] = __uint_as_float(x[d0].z << 16); f[d0][5] = __uint_as_float(x[d0].z & 0xffff0000u); f[d0][6] = __uint_as_float(x[d0].w << 16); f[d0][7] = __uint_as_float(x[d0].w & 0xffff0000u); }
        if (lat) {
#pragma unroll
            for (int hf = 0; hf < 2; ++hf)
#pragma unroll
                for (int e = 0; e < 8; ++e) { const float cs = ct[hf][e >> 1][2 * (e & 1)], sn = ct[hf][e >> 1][2 * (e & 1) + 1], x1 = f[2 * hf][e], x2 = f[2 * hf + 1][e]; f[2 * hf][e] = x1 * cs - x2 * sn; f[2 * hf + 1][e] = x1 * sn + x2 * cs; }
        }
#pragma unroll
        for (int d0 = 0; d0 < 4; ++d0) { v4u y;
            y.x = cvtpk(f[d0][0] * C2, f[d0][1] * C2); y.y = cvtpk(f[d0][2] * C2, f[d0][3] * C2); y.z = cvtpk(f[d0][4] * C2, f[d0][5] * C2); y.w = cvtpk(f[d0][6] * C2, f[d0][7] * C2);
            qf[j][d0] = __builtin_bit_cast(bf16x8, y); } }
    const float sink2 = prm(p, PRM_SINK)[l * AH + hq] * 1.4426950408889634f;
    float m[1] = {sink2}, lsum[1] = {hi == 0 ? 1.f : 0.f};
    f32x16 negm;
#pragma unroll
    for (int r = 0; r < 16; ++r) negm[r] = -sink2;
    f32x16 o[1][2];
#pragma unroll
    for (int j = 0; j < 1; ++j)
#pragma unroll
        for (int dh = 0; dh < 2; ++dh)
#pragma unroll
            for (int r = 0; r < 16; ++r) o[j][dh][r] = 0.f;
    const int npair = (nt + 1) >> 1;
    for (int tp = 0; tp < npair; ++tp) {
        asm volatile("s_waitcnt vmcnt(0)" ::: "memory"); __syncthreads();
        if (tp + 1 < npair) ATT_DMA2(tp + 1, (tp + 1) & 1);
#pragma unroll 1
      for (int sub = 0; sub < 2; ++sub) { const int t = 2 * tp + sub; if (t >= nt) break;
        const int sl = 2 * (tp & 1) + sub;
        const LAS unsigned char* kb = lds + KBUF + sl * SLOT + hi * 1024 + r32 * 16;
        const LAS unsigned char* vb = lds + VBUF + sl * SLOT + ((lane >> 4) & 1) * 32 + (lane & 3) * 8 + (4 * hi + ((lane & 15) >> 2)) * 64;
        bf16x8 kf[2][4], vf[2][4];
#pragma unroll
        for (int d0 = 0; d0 < 4; ++d0) { kf[0][d0] = *(const LAS bf16x8*)(kb + d0 * 2048); kf[1][d0] = *(const LAS bf16x8*)(kb + d0 * 2048 + 512); }
#pragma unroll
        for (int dh = 0; dh < 2; ++dh)
#pragma unroll
            for (int ks = 0; ks < 4; ++ks) { const s16x4 a = vtr(vb + dh * 4096 + ks * 1024), c = vtr(vb + dh * 4096 + ks * 1024 + 512);
                vf[dh][ks] = (bf16x8){a[0], a[1], a[2], a[3], c[0], c[1], c[2], c[3]}; }
        const int kpos = kw0 + 64 * t;
        const bool win = t < ntw && ((kpos + 63 - qpos0 > WIN) || (qpos0 + 63 - kpos > WIN));
#pragma unroll
        for (int j = 0; j < 1; ++j) {
            f32x16 p0 = __builtin_amdgcn_mfma_f32_32x32x16_bf16(kf[0][0], qf[j][0], negm, 0, 0, 0), p1 = __builtin_amdgcn_mfma_f32_32x32x16_bf16(kf[1][0], qf[j][0], negm, 0, 0, 0);
#pragma unroll
            for (int d0 = 1; d0 < 4; ++d0) { p0 = __builtin_amdgcn_mfma_f32_32x32x16_bf16(kf[0][d0], qf[j][d0], p0, 0, 0, 0); p1 = __builtin_amdgcn_mfma_f32_32x32x16_bf16(kf[1][d0], qf[j][d0], p1, 0, 0, 0); }
            asm volatile("s_nop 15\n\ts_nop 7" : "+v"(p0), "+v"(p1));
            if (win) { asm volatile("; window mask" ::: "memory");
                const int qpos = qpos0 + qh * 32 + r32;
#pragma unroll
                for (int r = 0; r < 16; ++r) { const int d0_ = kpos + crow(r, hi) - qpos, d1_ = d0_ + 32;
                    if (d0_ > WIN || d0_ < -WIN) p0[r] = -INFINITY; if (d1_ > WIN || d1_ < -WIN) p1[r] = -INFINITY; } }
            float mxa = max3f(p0[0], p0[1], p1[0]), mxb = max3f(p0[2], p0[3], p1[1]); mxa = max3f(mxa, p1[2], p1[3]);
#pragma unroll
            for (int r = 4; r < 16; r += 4) { mxa = max3f(mxa, p0[r], p0[r + 1]); mxb = max3f(mxb, p0[r + 2], p0[r + 3]); mxa = max3f(mxa, p1[r], p1[r + 1]); mxb = max3f(mxb, p1[r + 2], p1[r + 3]); }
            const float mx = max32(max3f(mxa, mxb, mxb));
            if (__any(mx > 0.f)) {
                const float dl = fmaxf(mx, 0.f), alpha = __builtin_amdgcn_exp2f(-dl); m[j] += dl; lsum[j] *= alpha;
#pragma unroll
                for (int r = 0; r < 16; ++r) { p0[r] -= dl; p1[r] -= dl; negm[r] = -m[j]; }
#pragma unroll
                for (int dh = 0; dh < 2; ++dh)
#pragma unroll
                    for (int r = 0; r < 16; ++r) o[j][dh][r] *= alpha; }
            float rs = 0.f;
#pragma unroll
            for (int r = 0; r < 16; ++r) { p0[r] = __builtin_amdgcn_exp2f(p0[r]); p1[r] = __builtin_amdgcn_exp2f(p1[r]); rs += p0[r] + p1[r]; }
            lsum[j] += rs;
            bf16x8 pf[4];
#pragma unroll
            for (int ks = 0; ks < 4; ++ks) { unsigned w[4];
#pragma unroll
                for (int i = 0; i < 4; ++i) w[i] = (ks < 2) ? cvtpk(p0[8 * ks + 2 * i], p0[8 * ks + 2 * i + 1]) : cvtpk(p1[8 * (ks - 2) + 2 * i], p1[8 * (ks - 2) + 2 * i + 1]);
                v4u wv = {w[0], w[1], w[2], w[3]}; pf[ks] = __builtin_bit_cast(bf16x8, wv); }
#pragma unroll
            for (int dh = 0; dh < 2; ++dh)
#pragma unroll
                for (int ks = 0; ks < 4; ++ks) o[j][dh] = __builtin_amdgcn_mfma_f32_32x32x16_bf16(vf[dh][ks], pf[ks], o[j][dh], 0, 0, 0);
        }
      }
    }
    bf16* Y = wsb(p, WS_U);
#pragma unroll
    for (int j = 0; j < 1; ++j) { const float lt = sum32(lsum[j]); const float inv = __builtin_amdgcn_rcpf(lt);
        bf16* yp = Y + (size_t)(qrow0 + qh * 32 + r32) * DM + hq * 64 + 4 * hi;
#pragma unroll
        for (int dh = 0; dh < 2; ++dh)
#pragma unroll
            for (int rg = 0; rg < 4; ++rg) { v2u w; w.x = cvtpk(o[j][dh][4 * rg] * inv, o[j][dh][4 * rg + 1] * inv); w.y = cvtpk(o[j][dh][4 * rg + 2] * inv, o[j][dh][4 * rg + 3] * inv);
                *(v2u*)(yp + 32 * dh + 8 * rg) = w; } }
    __syncthreads();
#undef ATT_DMA2
#undef ATT_DMA
}
__device__ __forceinline__ void phase(const P& p, LAS unsigned char* lds, int l, bool ctxq, int tid) {
    constexpr int NQB = SEQ / 64, NLAT = NB * AKV * NQB, NCQ = CTXL / 64, NCTX = NB * AKV * NCQ;
    const int G = gridDim.x; const int vcu = (G % 8 == 0) ? ((int)blockIdx.x % 8) * (G / 8) + (int)blockIdx.x / 8 : (int)blockIdx.x;
    const int per = (NLAT + G - 1) / G;
    for (int i = 0; i < per; ++i) { const int u = vcu * per + i; if (u >= NLAT) break;
        const int qb = u % NQB, g = (u / NQB) % AKV, b = u / (NQB * AKV);
        const int kw0 = (64 * qb - WIN < 0) ? 0 : 64 * qb - WIN; const int kend = (64 * qb + 64 + WIN > SEQ) ? SEQ : 64 * qb + 64 + WIN;
        unit(p, lds, l, b, g, b * SEQ + 64 * qb, 64 * qb, kw0, (kend - kw0) / 64, tid); }
    if (ctxq) for (int v = vcu; v < NCTX; v += G) { const int cq = v % NCQ, g = (v / NCQ) % AKV, b = v / (NCQ * AKV);
        unit(p, lds, l, b, g, ML + b * CTXL + 64 * cq, 0, 0, 0, tid); }
}
}

namespace gla {
using att::bf16x8; using att::s16x4; using att::f32x16; using att::crow; using att::cvtpk; using att::vtr;
constexpr int NCC = CTXL / 64, NCL = SEQ / 64, NCH = NCC + NCL;
constexpr int WREG = 17408;
constexpr int L_Q = 0, L_K = 4096, L_V = 8192;
constexpr int PB = 17;
__device__ __forceinline__ int chunk_row0(int b, int dir, int n) {
    if (n < NCC) { const int c = dir ? NCC - 1 - n : n; return ML + b * CTXL + 64 * c; }
    const int c = dir ? NCL - 1 - (n - NCC) : n - NCC; return b * SEQ + 64 * c;
}
__device__ __forceinline__ int chain_index(int t, int dir) { return !dir ? t : (t < NCC ? NCC - 1 - t : NCC + NCL - 1 - (t - NCC)); }
__device__ __forceinline__ int nat_row0(int b, int t) { return t < NCC ? ML + b * CTXL + 64 * t : b * SEQ + 64 * (t - NCC); }
__device__ __forceinline__ bf16* stg(const P& p) { return wsb(p, WS_SG); }
__device__ __forceinline__ float* dec(const P& p) { return wsf(p, WS_GST); }

__device__ __forceinline__ void load_v_issue(const bf16* Z, int row0, int vcol, int lane, v4u (&x)[8]) {
#pragma unroll
    for (int i = 0; i < 8; ++i) { const int idx = i * 64 + lane, s = idx >> 3, c = idx & 7; x[i] = *(const v4u*)(Z + (size_t)(row0 + s) * ZP + vcol + c * 8); }
}
__device__ __forceinline__ void load_v_store(LAS unsigned char* w, int lane, const v4u (&x)[8]) {
#pragma unroll
    for (int i = 0; i < 8; ++i) { const int idx = i * 64 + lane, s = idx >> 3, c = idx & 7; *(LAS v4u*)(w + L_V + ((c >> 2) * 4 + (s >> 4)) * 1024 + (s & 15) * 64 + (c & 3) * 16) = x[i]; }
}
__device__ __forceinline__ void load_v(const bf16* Z, int row0, int vcol, LAS unsigned char* w, int lane) { v4u x[8]; load_v_issue(Z, row0, vcol, lane, x); load_v_store(w, lane, x); }
template <int CTRL, int RM> __device__ __forceinline__ float dppf(float old, float src) { return __int_as_float(__builtin_amdgcn_update_dpp(__float_as_int(old), __float_as_int(src), CTRL, RM, 0xf, false)); }
__device__ __forceinline__ float scan_add_dpp(float v) {
    v += dppf<0x111, 0xf>(0.f, v); v += dppf<0x112, 0xf>(0.f, v); v += dppf<0x114, 0xf>(0.f, v); v += dppf<0x118, 0xf>(0.f, v);
    v += dppf<0x142, 0xa>(0.f, v); v += dppf<0x143, 0xc>(0.f, v); return v; }
__device__ __forceinline__ float scan_max_dpp(float v) {
    constexpr float NI = -3.0e38f;
    v = fmaxf(v, dppf<0x111, 0xf>(NI, v)); v = fmaxf(v, dppf<0x112, 0xf>(NI, v)); v = fmaxf(v, dppf<0x114, 0xf>(NI, v)); v = fmaxf(v, dppf<0x118, 0xf>(NI, v));
    v = fmaxf(v, dppf<0x142, 0xa>(NI, v)); v = fmaxf(v, dppf<0x143, 0xc>(NI, v)); return v; }
constexpr int L_BL = 16384;
__device__ __forceinline__ void up8(v4u x, float* f) { f[0] = __uint_as_float(x.x << 16); f[1] = __uint_as_float(x.x & 0xffff0000u); f[2] = __uint_as_float(x.y << 16); f[3] = __uint_as_float(x.y & 0xffff0000u);
    f[4] = __uint_as_float(x.z << 16); f[5] = __uint_as_float(x.z & 0xffff0000u); f[6] = __uint_as_float(x.w << 16); f[7] = __uint_as_float(x.w & 0xffff0000u); }
struct PrepRaw { v4u b[4], k[4], q[4]; };
template <bool WQ> __device__ __forceinline__ void prep_issue(const P& p, int row0, int h, int dir, int lane, PrepRaw& r) {
    const int t = dir ? 63 - lane : lane;
    const bf16* zr = wsb(p, WS_ACT) + (size_t)(row0 + t) * ZP; const bf16* gp = wsb(p, WS_GA) + ((size_t)dir * M + row0 + t) * B_KW + h * 32;
#pragma unroll
    for (int c4 = 0; c4 < 4; ++c4) { r.b[c4] = *(const v4u*)(gp + 8 * c4); r.k[c4] = *(const v4u*)(zr + ZBK + h * 32 + 8 * c4); if (WQ) r.q[c4] = *(const v4u*)(zr + ZBQ + h * 32 + 8 * c4); }
}
template <bool KT, bool WQ> __device__ __forceinline__ float prep_compute(const PrepRaw& r, int dir, LAS unsigned char* w, int lane) {
    const int t = dir ? 63 - lane : lane;
    float b[32];
#pragma unroll
    for (int c4 = 0; c4 < 4; ++c4) up8(r.b[c4], b + 8 * c4);
#pragma unroll
    for (int d = 0; d < 32; ++d) b[d] = scan_add_dpp(b[d]);
    if (lane == 63) {
#pragma unroll
        for (int c = 0; c < 8; ++c) *(LAS f32x4*)(w + L_BL + 16 * c) = (f32x4){b[4 * c], b[4 * c + 1], b[4 * c + 2], b[4 * c + 3]}; }
#pragma unroll
    for (int c4 = 0; c4 < 4; ++c4) { v4u kw, qw; float e[8], kk[8];
        up8(r.k[c4], kk);
#pragma unroll
        for (int i = 0; i < 8; ++i) e[i] = __expf(-b[8 * c4 + i]);
        kw.x = cvtpk(kk[0] * e[0], kk[1] * e[1]); kw.y = cvtpk(kk[2] * e[2], kk[3] * e[3]); kw.z = cvtpk(kk[4] * e[4], kk[5] * e[5]); kw.w = cvtpk(kk[6] * e[6], kk[7] * e[7]);
        if (KT) *(LAS v4u*)(w + L_K + (t >> 4) * 1024 + (t & 15) * 64 + c4 * 16) = kw; else *(LAS v4u*)(w + L_K + c4 * 1024 + t * 16) = kw;
        if (WQ) { float qq[8]; up8(r.q[c4], qq);
#pragma unroll
            for (int i = 0; i < 8; ++i) e[i] = 0.17677669529663687f * __expf(b[8 * c4 + i]);
            qw.x = cvtpk(qq[0] * e[0], qq[1] * e[1]); qw.y = cvtpk(qq[2] * e[2], qq[3] * e[3]); qw.z = cvtpk(qq[4] * e[4], qq[5] * e[5]); qw.w = cvtpk(qq[6] * e[6], qq[7] * e[7]);
            *(LAS v4u*)(w + L_Q + c4 * 1024 + t * 16) = qw; } }
    asm volatile("s_waitcnt lgkmcnt(0)" ::: "memory");
    return *(const LAS float*)(w + L_BL + 4 * (lane & 31));
}
__device__ __forceinline__ bf16x8 vfrag(const LAS unsigned char* vb, int vh, int ks) {
    const s16x4 a = vtr(vb + vh * 4096 + ks * 1024), c = vtr(vb + vh * 4096 + ks * 1024 + 512);
    return (bf16x8){a[0], a[1], a[2], a[3], c[0], c[1], c[2], c[3]};
}
__device__ __forceinline__ void unit1(const P& p, LAS unsigned char* lds, int u, int wave, int lane) {
    LAS unsigned char* w = lds + wave * WREG; const int r32 = lane & 31, hi = lane >> 5;
    const LAS unsigned char* trb = w + ((lane >> 4) & 1) * 32 + (lane & 3) * 8 + (4 * hi + ((lane & 15) >> 2)) * 64;
    {
        const int n = u % NCH, ch = u / NCH; const int dir = ch & 1, h = (ch >> 1) % BH, b = ch / (2 * BH);
        const int row0 = chunk_row0(b, dir, n);
        v4u vx[8]; PrepRaw pr;
        load_v_issue(wsb(p, WS_ACT), row0, ZBV + h * 64, lane, vx); prep_issue<false>(p, row0, h, dir, lane, pr);
        load_v_store(w, lane, vx);
        const float bl = prep_compute<true, false>(pr, dir, w, lane);
        asm volatile("s_waitcnt lgkmcnt(0)" ::: "memory");
        const float eb = __expf(bl);
        bf16* so = stg(p) + ((size_t)ch * NCH + n) * 2048;
        bf16x8 kfr[4], vfr1[2][4];
#pragma unroll
        for (int ks = 0; ks < 4; ++ks) { kfr[ks] = vfrag(trb + L_K, 0, ks); vfr1[0][ks] = vfrag(trb + L_V, 0, ks); vfr1[1][ks] = vfrag(trb + L_V, 1, ks); }
#pragma unroll
        for (int vh = 0; vh < 2; ++vh) { f32x16 acc;
#pragma unroll
            for (int r = 0; r < 16; ++r) acc[r] = 0.f;
#pragma unroll
            for (int ks = 0; ks < 4; ++ks) acc = __builtin_amdgcn_mfma_f32_32x32x16_bf16(vfr1[vh][ks], kfr[ks], acc, 0, 0, 0);
#pragma unroll
            for (int r = 0; r < 16; ++r) so[(32 * vh + crow(r, hi)) * 32 + r32] = f2bfh(acc[r] * eb); }
        if (lane < 32) dec(p)[((size_t)ch * NCH + n) * 32 + lane] = eb;
        asm volatile("s_waitcnt lgkmcnt(0)" ::: "memory");
    }
}
__device__ __forceinline__ void pass1(const P& p, LAS unsigned char* lds, int gw, int ngw, int wave, int lane) {
    for (int u = ngw - 1 - gw; u < NCHAIN * NCH; u += ngw) unit1(p, lds, u, wave, lane);
}
__device__ __forceinline__ void pass2(const P& p, int gtid, int nth) {
    bf16* S = stg(p); const float* D = dec(p); static_assert(NCH % (2 * PB) == 0, "pass 2 batch pairs");
    for (int it = gtid; it < NCHAIN * 2048; it += nth) { const int e = it % 2048, ch = it / 2048, d = e & 31;
        float st = 0.f; float locA[PB], ddA[PB], locB[PB], ddB[PB];
#define GLA_P2_LD(loc, dd, n0) _Pragma("unroll") for (int j = 0; j < PB; ++j) { loc[j] = bf2f(S[((size_t)ch * NCH + (n0) + j) * 2048 + e]); dd[j] = D[((size_t)ch * NCH + (n0) + j) * 32 + d]; }
#define GLA_P2_RUN(loc, dd, n0) _Pragma("unroll") for (int j = 0; j < PB; ++j) { S[((size_t)ch * NCH + (n0) + j) * 2048 + e] = f2bfh(st); st = dd[j] * st + loc[j]; }
        GLA_P2_LD(locA, ddA, 0)
        for (int n0 = 0; n0 < NCH; n0 += 2 * PB) {
            GLA_P2_LD(locB, ddB, n0 + PB)
            GLA_P2_RUN(locA, ddA, n0)
            if (n0 + 2 * PB < NCH) { GLA_P2_LD(locA, ddA, n0 + 2 * PB) }
            GLA_P2_RUN(locB, ddB, n0 + PB)
        }
#undef GLA_P2_LD
#undef GLA_P2_RUN
    }
}
__device__ __forceinline__ void unit3(const P& p, LAS unsigned char* lds, int l, bool ctxo, int u, int wave, int lane) {
    LAS unsigned char* w = lds + wave * WREG; const int r32 = lane & 31, hi = lane >> 5;
    const LAS unsigned char* trb = w + ((lane >> 4) & 1) * 32 + (lane & 3) * 8 + (4 * hi + ((lane & 15) >> 2)) * 64;
    const bf16* Z = wsb(p, WS_ACT); bf16* Y = wsb(p, WS_U);
    {
        const int t = u % NCH, h = (u / NCH) % BH, b = u / (NCH * BH);
        if (!ctxo && t < NCC) return;
        const int row0 = nat_row0(b, t);
        f32x16 o[2][2];
#pragma unroll
        for (int tt = 0; tt < 2; ++tt)
#pragma unroll
            for (int vh = 0; vh < 2; ++vh)
#pragma unroll
                for (int r = 0; r < 16; ++r) o[tt][vh][r] = 0.f;
        { v4u vx[8]; load_v_issue(Z, row0, ZBV + h * 64, lane, vx); load_v_store(w, lane, vx); }
#pragma unroll 1
        for (int dir = 0; dir < 2; ++dir) {
            PrepRaw pr; prep_issue<true>(p, row0, h, dir, lane, pr);
            const int ch = (b * BH + h) * 2 + dir; const bf16* sp = stg(p) + ((size_t)ch * NCH + chain_index(t, dir)) * 2048;
            bf16x8 sf[2][2];
#pragma unroll
            for (int vh = 0; vh < 2; ++vh)
#pragma unroll
                for (int d0 = 0; d0 < 2; ++d0) sf[vh][d0] = *(const bf16x8*)(sp + (r32 + 32 * vh) * 32 + 16 * d0 + 8 * hi);
            (void)prep_compute<false, true>(pr, dir, w, lane);
            bf16x8 vfr[2][4];
#pragma unroll
            for (int vh = 0; vh < 2; ++vh)
#pragma unroll
                for (int ks = 0; ks < 4; ++ks) vfr[vh][ks] = vfrag(trb + L_V, vh, ks);
#pragma unroll
            for (int tt = 0; tt < 2; ++tt) {
                bf16x8 qf[2];
#pragma unroll
                for (int d0 = 0; d0 < 2; ++d0) qf[d0] = *(const LAS bf16x8*)(w + L_Q + (2 * d0 + hi) * 1024 + (r32 + 32 * tt) * 16);
#pragma unroll
                for (int vh = 0; vh < 2; ++vh)
#pragma unroll
                    for (int d0 = 0; d0 < 2; ++d0) o[tt][vh] = __builtin_amdgcn_mfma_f32_32x32x16_bf16(sf[vh][d0], qf[d0], o[tt][vh], 0, 0, 0);
#pragma unroll
                for (int sh = 0; sh < 2; ++sh) {
                    if (dir == 0 ? (sh > tt) : (sh < tt)) continue;
                    f32x16 pt;
#pragma unroll
                    for (int r = 0; r < 16; ++r) pt[r] = 0.f;
#pragma unroll
                    for (int d0 = 0; d0 < 2; ++d0) { const bf16x8 kf = *(const LAS bf16x8*)(w + L_K + (2 * d0 + hi) * 1024 + (r32 + 32 * sh) * 16); pt = __builtin_amdgcn_mfma_f32_32x32x16_bf16(kf, qf[d0], pt, 0, 0, 0); }
                    if (sh == tt) {
#pragma unroll
                        for (int r = 0; r < 16; ++r) { const int s = crow(r, hi); if (dir == 0 ? (s > r32) : (s < r32)) pt[r] = 0.f; } }
#pragma unroll
                    for (int k2 = 0; k2 < 2; ++k2) { v4u wv;
                        wv.x = cvtpk(pt[8 * k2], pt[8 * k2 + 1]); wv.y = cvtpk(pt[8 * k2 + 2], pt[8 * k2 + 3]); wv.z = cvtpk(pt[8 * k2 + 4], pt[8 * k2 + 5]); wv.w = cvtpk(pt[8 * k2 + 6], pt[8 * k2 + 7]);
                        const bf16x8 pf = __builtin_bit_cast(bf16x8, wv);
#pragma unroll
                        for (int vh = 0; vh < 2; ++vh) o[tt][vh] = __builtin_amdgcn_mfma_f32_32x32x16_bf16(vfr[vh][2 * sh + k2], pf, o[tt][vh], 0, 0, 0); }
                }
            }
            asm volatile("s_waitcnt lgkmcnt(0)" ::: "memory");
        }
        const float* gn = prm(p, PRM_GNORM) + l * B_VW + h * 64;
#pragma unroll
        for (int tt = 0; tt < 2; ++tt) {
            float s1 = 0.f;
#pragma unroll
            for (int vh = 0; vh < 2; ++vh)
#pragma unroll
                for (int r = 0; r < 16; ++r) s1 += o[tt][vh][r];
            s1 = att::sum32(s1); const float mu = s1 * (1.f / 64.f); float s2 = 0.f;
#pragma unroll
            for (int vh = 0; vh < 2; ++vh)
#pragma unroll
                for (int r = 0; r < 16; ++r) { const float x = o[tt][vh][r] - mu; s2 += x * x; }
            s2 = att::sum32(s2); const float rs = __builtin_amdgcn_rsqf(s2 * (1.f / 64.f) + EPS);
            const int row = row0 + 32 * tt + r32;
            const bf16* zg = Z + (size_t)row * ZP + ZBG + h * 64 + 4 * hi; bf16* yp = Y + (size_t)row * DM + A_OUT + h * 64 + 4 * hi;
#pragma unroll
            for (int vh = 0; vh < 2; ++vh)
#pragma unroll
                for (int rg = 0; rg < 4; ++rg) { const int vo = 32 * vh + 8 * rg; const v2u gz = *(const v2u*)(zg + vo); const f32x4 gg = *(const f32x4*)(gn + vo + 4 * hi);
                    const float g0 = __uint_as_float(gz.x << 16), g1 = __uint_as_float(gz.x & 0xffff0000u), g2 = __uint_as_float(gz.y << 16), g3 = __uint_as_float(gz.y & 0xffff0000u);
                    v2u wv; wv.x = cvtpk(siluf(g0) * (o[tt][vh][4 * rg] - mu) * rs * gg.x, siluf(g1) * (o[tt][vh][4 * rg + 1] - mu) * rs * gg.y);
                    wv.y = cvtpk(siluf(g2) * (o[tt][vh][4 * rg + 2] - mu) * rs * gg.z, siluf(g3) * (o[tt][vh][4 * rg + 3] - mu) * rs * gg.w);
                    *(v2u*)(yp + vo) = wv; }
        }
    }
}
__device__ __forceinline__ void pass3(const P& p, LAS unsigned char* lds, int l, bool ctxo, int gw, int ngw, int wave, int lane) {
    for (int u = ngw - 1 - gw; u < NB * BH * NCH; u += ngw) unit3(p, lds, l, ctxo, u, wave, lane);
}
}

namespace mls {
using att::bf16x8; using att::s16x4; using att::f32x16; using att::crow; using att::cvtpk; using att::vtr; using gla::NCC; using gla::NCL; using gla::NCH; using gla::vfrag; using gla::load_v;
constexpr int WREG = 17408;
constexpr int L_KW = 0, L_T = 16384;
__device__ __forceinline__ bf16* cst(const P& p) { return wsb(p, WS_Y); }
__device__ __forceinline__ float* nst(const P& p) { return wsf(p, WS_MST); }
__device__ __forceinline__ float* sst(const P& p, int which) { return wsf(p, WS_MST) + (size_t)NCHAIN * NCH * (64 + which); }
__device__ __forceinline__ float scan_add(float v, int lane) {
#pragma unroll
    for (int o = 1; o < 64; o <<= 1) { const float u = __shfl_up(v, o); if (lane >= o) v += u; }
    return v;
}
__device__ __forceinline__ float scan_max(float v, int lane) {
#pragma unroll
    for (int o = 1; o < 64; o <<= 1) { const float u = __shfl_up(v, o); if (lane >= o) v = fmaxf(v, u); }
    return v;
}
__device__ __forceinline__ void gates(const P& p, int l, int row0, int h, int dir, int lane, int& t, float& c, float& pm, float& bc) {
    t = dir ? 63 - lane : lane;
    const bf16* zg = wsb(p, WS_ACT) + (size_t)(row0 + t) * ZP + ZCG;
    const float li = bf2f(zg[(2 * dir) * CH + h]), lf = logsigf(bf2f(zg[(2 * dir + 1) * CH + h]) + prm(p, PRM_FBIAS)[(l * 2 + dir) * CH + h]);
    bc = gla::scan_add_dpp(lf); c = li - bc; pm = gla::scan_max_dpp(c);
}
__device__ __forceinline__ void unit1(const P& p, LAS unsigned char* lds, int l, int u, int wave, int lane) {
    LAS unsigned char* w = lds + wave * WREG; const int r32 = lane & 31, hi = lane >> 5;
    const LAS unsigned char* trb = w + ((lane >> 4) & 1) * 32 + (lane & 3) * 8 + (4 * hi + ((lane & 15) >> 2)) * 64;
    LAS float* wt = (LAS float*)(w + L_T);
    const bf16* CQK = wsb(p, WS_CQK);
    {
        const int n = u % NCH, ch = u / NCH; const int dir = ch & 1, h = (ch >> 1) % CH, b = ch / (2 * CH);
        const int row0 = gla::chunk_row0(b, dir, n);
        int t; float c, pm, bc; gates(p, l, row0, h, dir, lane, t, c, pm, bc);
        const float cmax = __int_as_float(__builtin_amdgcn_readlane(__float_as_int(pm), 63)), blast = __int_as_float(__builtin_amdgcn_readlane(__float_as_int(bc), 63));
        wt[t] = __expf(c - cmax) * 0.125f;
        load_v(wsb(p, WS_ACT), row0, ZCV + h * 64, w, lane);
        asm volatile("s_waitcnt lgkmcnt(0)" ::: "memory");
#pragma unroll
        for (int i = 0; i < 8; ++i) { const int idx = i * 64 + lane, s = idx >> 3, cc = idx & 7; const float ws_ = wt[s];
            const v4u x = *(const v4u*)(CQK + (size_t)(row0 + s) * 2 * C_W + C_W + h * 64 + cc * 8); v4u y;
            y.x = cvtpk(__uint_as_float(x.x << 16) * ws_, __uint_as_float(x.x & 0xffff0000u) * ws_); y.y = cvtpk(__uint_as_float(x.y << 16) * ws_, __uint_as_float(x.y & 0xffff0000u) * ws_);
            y.z = cvtpk(__uint_as_float(x.z << 16) * ws_, __uint_as_float(x.z & 0xffff0000u) * ws_); y.w = cvtpk(__uint_as_float(x.w << 16) * ws_, __uint_as_float(x.w & 0xffff0000u) * ws_);
            *(LAS v4u*)(w + L_KW + ((cc >> 2) * 4 + (s >> 4)) * 1024 + (s & 15) * 64 + (cc & 3) * 16) = y; }
        asm volatile("s_waitcnt lgkmcnt(0)" ::: "memory");
        const size_t cn = (size_t)ch * NCH + n;
        bf16* co = cst(p) + cn * 4096;
        const v4u onesv = {0x3f803f80u, 0x3f803f80u, 0x3f803f80u, 0x3f803f80u}; const bf16x8 ones = __builtin_bit_cast(bf16x8, onesv);
        bf16x8 vfr1[2][4];
#pragma unroll
        for (int ks = 0; ks < 4; ++ks) { vfr1[0][ks] = vfrag(trb + gla::L_V, 0, ks); vfr1[1][ks] = vfrag(trb + gla::L_V, 1, ks); }
#pragma unroll
        for (int kh = 0; kh < 2; ++kh) { f32x16 a0, a1, an; bf16x8 kb[4];
#pragma unroll
            for (int ks = 0; ks < 4; ++ks) kb[ks] = vfrag(trb + L_KW, kh, ks);
#pragma unroll
            for (int r = 0; r < 16; ++r) { a0[r] = 0.f; a1[r] = 0.f; an[r] = 0.f; }
#pragma unroll
            for (int ks = 0; ks < 4; ++ks) {
                a0 = __builtin_amdgcn_mfma_f32_32x32x16_bf16(vfr1[0][ks], kb[ks], a0, 0, 0, 0);
                a1 = __builtin_amdgcn_mfma_f32_32x32x16_bf16(vfr1[1][ks], kb[ks], a1, 0, 0, 0);
                an = __builtin_amdgcn_mfma_f32_32x32x16_bf16(ones, kb[ks], an, 0, 0, 0); }
#pragma unroll
            for (int r = 0; r < 16; ++r) { co[(crow(r, hi)) * 64 + 32 * kh + r32] = f2bfh(a0[r]); co[(32 + crow(r, hi)) * 64 + 32 * kh + r32] = f2bfh(a1[r]); }
            if (hi == 0) nst(p)[cn * 64 + 32 * kh + r32] = an[0]; }
        if (lane == 0) { sst(p, 0)[cn] = blast + cmax; sst(p, 1)[cn] = blast; }
        asm volatile("s_waitcnt lgkmcnt(0)" ::: "memory");
    }
}
__device__ __forceinline__ void pass1(const P& p, LAS unsigned char* lds, int l, int gw, int ngw, int wave, int lane) {
    for (int u = gw; u < NCHAIN * NCH; u += ngw) unit1(p, lds, l, u, wave, lane);
}
__device__ __forceinline__ void pass2(const P& p, int gtid, int nth) {
    bf16* C = cst(p); float* N = nst(p); const float* ML_ = sst(p, 0); const float* F = sst(p, 1); float* MP = sst(p, 2);
    for (int it = gtid; it < NCHAIN * 4096; it += nth) { const int e = it % 4096, ch = it / 4096; const bool hn = e < 64;
        float st = 0.f, sn = 0.f, mst = 0.f;
        for (int n0 = 0; n0 < NCH; n0 += gla::PB) { float loc[gla::PB], locn[gla::PB], ml[gla::PB], fl[gla::PB];
#pragma unroll
            for (int j = 0; j < gla::PB; ++j) { const size_t cn = (size_t)ch * NCH + n0 + j; ml[j] = ML_[cn]; fl[j] = F[cn]; loc[j] = bf2f(C[cn * 4096 + e]); locn[j] = hn ? N[cn * 64 + e] : 0.f; }
#pragma unroll
            for (int j = 0; j < gla::PB; ++j) { const size_t cn = (size_t)ch * NCH + n0 + j;
                const float mn = fmaxf(fl[j] + mst, ml[j]), a = __expf(fl[j] + mst - mn), ee = __expf(ml[j] - mn);
                C[cn * 4096 + e] = f2bfh(st); if (hn) N[cn * 64 + e] = sn;
                st = a * st + ee * loc[j]; sn = a * sn + ee * locn[j]; if (e == 0) MP[cn] = mst; mst = mn; } } }
}
__device__ __forceinline__ void unit3(const P& p, LAS unsigned char* lds, int l, bool ctxo, int u, int wave, int lane) {
    LAS unsigned char* w = lds + wave * WREG; const int r32 = lane & 31, hi = lane >> 5;
    const LAS unsigned char* trb = w + ((lane >> 4) & 1) * 32 + (lane & 3) * 8 + (4 * hi + ((lane & 15) >> 2)) * 64;
    LAS float* tb = (LAS float*)(w + L_KW);
    const bf16* Z = wsb(p, WS_ACT); const bf16* CQK = wsb(p, WS_CQK); bf16* Y = wsb(p, WS_U);
    {
        const int tt = u & 1, tc = (u >> 1) % NCH, h = ((u >> 1) / NCH) % CH, b = (u >> 1) / (NCH * CH);
        if (!ctxo && tc < NCC) return;
        const int row0 = gla::nat_row0(b, tc);
        load_v(Z, row0, ZCV + h * 64, w, lane);
#pragma unroll
        for (int dir = 0; dir < 2; ++dir) { const size_t cn = (size_t)((b * CH + h) * 2 + dir) * NCH + gla::chain_index(tc, dir);
            const float mprev = sst(p, 2)[cn];
            int t; float c, pm, bc; gates(p, l, row0, h, dir, lane, t, c, pm, bc);
            const float Mt = fmaxf(mprev, pm);
            tb[dir * 256 + t] = c; tb[dir * 256 + 64 + t] = Mt; tb[dir * 256 + 128 + t] = __expf(mprev - Mt); tb[dir * 256 + 192 + t] = bc + Mt; }
        asm volatile("s_waitcnt lgkmcnt(0)" ::: "memory");
        {
            f32x16 tot[2];
#pragma unroll
            for (int vh = 0; vh < 2; ++vh)
#pragma unroll
                for (int r = 0; r < 16; ++r) tot[vh][r] = 0.f;
            const int tl = 32 * tt + r32;
#pragma unroll 1
            for (int dir = 0; dir < 2; ++dir) {
                const float Mt = tb[dir * 256 + 64 + tl], at = tb[dir * 256 + 128 + tl], mt = tb[dir * 256 + 192 + tl];
                bf16x8 qf[4];
#pragma unroll
                for (int d0 = 0; d0 < 4; ++d0) qf[d0] = *(const bf16x8*)(CQK + (size_t)(row0 + tl) * 2 * C_W + h * 64 + 16 * d0 + 8 * hi);
                const size_t cn = (size_t)((b * CH + h) * 2 + dir) * NCH + gla::chain_index(tc, dir);
                const bf16* cp = cst(p) + cn * 4096; const float* np = nst(p) + cn * 64;
                f32x16 num[2]; float den = 0.f;
#pragma unroll
                for (int vh = 0; vh < 2; ++vh) {
#pragma unroll
                    for (int r = 0; r < 16; ++r) num[vh][r] = 0.f;
#pragma unroll
                    for (int d0 = 0; d0 < 4; ++d0) { const bf16x8 cf = *(const bf16x8*)(cp + (r32 + 32 * vh) * 64 + 16 * d0 + 8 * hi); num[vh] = __builtin_amdgcn_mfma_f32_32x32x16_bf16(cf, qf[d0], num[vh], 0, 0, 0); } }
#pragma unroll
                for (int d0 = 0; d0 < 4; ++d0) { const v4u qu = __builtin_bit_cast(v4u, qf[d0]); const f32x4 n0 = *(const f32x4*)(np + 16 * d0 + 8 * hi), n1 = *(const f32x4*)(np + 16 * d0 + 8 * hi + 4);
                    den += __uint_as_float(qu.x << 16) * n0.x + __uint_as_float(qu.x & 0xffff0000u) * n0.y + __uint_as_float(qu.y << 16) * n0.z + __uint_as_float(qu.y & 0xffff0000u) * n0.w
                         + __uint_as_float(qu.z << 16) * n1.x + __uint_as_float(qu.z & 0xffff0000u) * n1.y + __uint_as_float(qu.w << 16) * n1.z + __uint_as_float(qu.w & 0xffff0000u) * n1.w; }
                den *= at;
#pragma unroll
                for (int vh = 0; vh < 2; ++vh)
#pragma unroll
                    for (int r = 0; r < 16; ++r) num[vh][r] *= at;
#pragma unroll
                for (int sh = 0; sh < 2; ++sh) {
                    if (dir == 0 ? (sh > tt) : (sh < tt)) continue;
                    f32x16 st;
#pragma unroll
                    for (int r = 0; r < 16; ++r) st[r] = 0.f;
#pragma unroll
                    for (int d0 = 0; d0 < 4; ++d0) { const bf16x8 kf = *(const bf16x8*)(CQK + (size_t)(row0 + 32 * sh + r32) * 2 * C_W + C_W + h * 64 + 16 * d0 + 8 * hi); st = __builtin_amdgcn_mfma_f32_32x32x16_bf16(kf, qf[d0], st, 0, 0, 0); }
#pragma unroll
                    for (int rg = 0; rg < 4; ++rg) { const f32x4 cs = *(const LAS f32x4*)(tb + dir * 256 + 32 * sh + 8 * rg + 4 * hi);
#pragma unroll
                        for (int i = 0; i < 4; ++i) { const int r = 4 * rg + i; const int s = crow(r, hi);
                            float wgt = __expf(cs[i] - Mt) * 0.125f;
                            if (sh == tt && (dir == 0 ? (s > r32) : (s < r32))) wgt = 0.f;
                            st[r] *= wgt; den += st[r]; } }
#pragma unroll
                    for (int k2 = 0; k2 < 2; ++k2) { v4u wv;
                        wv.x = cvtpk(st[8 * k2], st[8 * k2 + 1]); wv.y = cvtpk(st[8 * k2 + 2], st[8 * k2 + 3]); wv.z = cvtpk(st[8 * k2 + 4], st[8 * k2 + 5]); wv.w = cvtpk(st[8 * k2 + 6], st[8 * k2 + 7]);
                        const bf16x8 pf = __builtin_bit_cast(bf16x8, wv);
#pragma unroll
                        for (int vh = 0; vh < 2; ++vh) num[vh] = __builtin_amdgcn_mfma_f32_32x32x16_bf16(vfrag(trb + gla::L_V, vh, 2 * sh + k2), pf, num[vh], 0, 0, 0); }
                }
                den = att::sum32(den);
                const float inv = __builtin_amdgcn_rcpf(fmaxf(fabsf(den), __expf(-mt)));
#pragma unroll
                for (int vh = 0; vh < 2; ++vh)
#pragma unroll
                    for (int r = 0; r < 16; ++r) tot[vh][r] += num[vh][r] * inv;
            }
            const float* gn = prm(p, PRM_MNORM) + l * C_W + h * 64;
            float s1 = 0.f;
#pragma unroll
            for (int vh = 0; vh < 2; ++vh)
#pragma unroll
                for (int r = 0; r < 16; ++r) s1 += tot[vh][r];
            s1 = att::sum32(s1); const float mu = s1 * (1.f / 64.f); float s2 = 0.f;
#pragma unroll
            for (int vh = 0; vh < 2; ++vh)
#pragma unroll
                for (int r = 0; r < 16; ++r) { const float x = tot[vh][r] - mu; s2 += x * x; }
            s2 = att::sum32(s2); const float rs = __builtin_amdgcn_rsqf(s2 * (1.f / 64.f) + EPS);
            const int row = row0 + tl;
            const bf16* zg = Z + (size_t)row * ZP + ZCO + h * 64 + 4 * hi; bf16* yp = Y + (size_t)row * DM + A_OUT + B_VW + h * 64 + 4 * hi;
#pragma unroll
            for (int vh = 0; vh < 2; ++vh)
#pragma unroll
                for (int rg = 0; rg < 4; ++rg) { const int vo = 32 * vh + 8 * rg; const v2u gz = *(const v2u*)(zg + vo); const f32x4 gg = *(const f32x4*)(gn + vo + 4 * hi);
                    const float g0 = __uint_as_float(gz.x << 16), g1 = __uint_as_float(gz.x & 0xffff0000u), g2 = __uint_as_float(gz.y << 16), g3 = __uint_as_float(gz.y & 0xffff0000u);
                    v2u wv; wv.x = cvtpk(sigmf(g0) * (tot[vh][4 * rg] - mu) * rs * gg.x, sigmf(g1) * (tot[vh][4 * rg + 1] - mu) * rs * gg.y);
                    wv.y = cvtpk(sigmf(g2) * (tot[vh][4 * rg + 2] - mu) * rs * gg.z, sigmf(g3) * (tot[vh][4 * rg + 3] - mu) * rs * gg.w);
                    *(v2u*)(yp + vo) = wv; }
        }
        asm volatile("s_waitcnt lgkmcnt(0)" ::: "memory");
    }
}
__device__ __forceinline__ void pass3(const P& p, LAS unsigned char* lds, int l, bool ctxo, int gw, int ngw, int wave, int lane) {
    for (int u = gw; u < NB * CH * NCH * 2; u += ngw) unit3(p, lds, l, ctxo, u, wave, lane);
}
}


__device__ __forceinline__ int wg_next(LAS unsigned* ctr, int lane) { unsigned k = 0u; if (lane == 0) k = __hip_atomic_fetch_add(ctr, 1u, __ATOMIC_RELAXED, __HIP_MEMORY_SCOPE_WORKGROUP); return (int)__builtin_amdgcn_readfirstlane(k); }
__device__ __forceinline__ void mixer_p1_items(const P& p, LAS unsigned char* lds, int l, int tid, int wave, int lane) {
    LAS unsigned* ctr = (LAS unsigned*)(lds + MISC_OFF + 128);
    __syncthreads(); if (tid == 0) *ctr = 0u; __syncthreads();
    const int c = blockIdx.x, G = gridDim.x; constexpr int NU = NCHAIN * gla::NCH; const int n = c < NU ? (NU - c + G - 1) / G : 0;
    for (;;) { const int k = wg_next(ctr, lane); if (k >= 2 * n) break;
        if (k < n) mls::unit1(p, lds, l, c + G * k, wave, lane); else gla::unit1(p, lds, c + G * (k - n), wave, lane); }
}
__device__ __forceinline__ void mixer_p3_items(const P& p, LAS unsigned char* lds, int l, bool ctxo, int tid, int wave, int lane) {
    LAS unsigned* ctr = (LAS unsigned*)(lds + MISC_OFF + 128);
    __syncthreads(); if (tid == 0) *ctr = 0u; __syncthreads();
    const int c = blockIdx.x, G = gridDim.x; constexpr int NG3 = NB * BH * gla::NCH, NM3 = NB * CH * gla::NCH * 2;
    const int ng = c < NG3 ? (NG3 - c + G - 1) / G : 0, nm = c < NM3 ? (NM3 - c + G - 1) / G : 0;
    for (;;) { const int k = wg_next(ctr, lane); if (k >= ng + nm) break;
        if (k < ng) gla::unit3(p, lds, l, ctxo, c + G * k, wave, lane); else mls::unit3(p, lds, l, ctxo, c + G * (k - ng), wave, lane); }
}
#define PROJ_THIN(A_, WT_, KK_, CTX_, THIN_LAT_, THIN_CTX_, EXTRA_, SUBI_) do { \
    { pg8::Gemm g_{(A_), (WT_), ML, DM, (KK_)}; pg8::StaticOrder S_; S_.init(ML, DM, G, (int)blockIdx.x); pg8::EpiPlain E_{wsb(p, WS_Y), DM, nullptr}; \
      pg8::gemm_phase<pg8::EpiPlain, pg8::StaticOrder, true, true>(lds, g_, S_, E_); } \
    SEAM(); \
    if (CTX_) { \
        if (blockIdx.x < NSUBWG) { const int ks_ = (int)blockIdx.x >> 5, kh_ = (KK_) / 2; \
            pg8::Gemm g_{(A_) + (size_t)ML * (KK_) + ks_ * kh_, (WT_) + ks_ * kh_, MC, DM, kh_, (KK_)}; pg8::StaticOrder S_; S_.init(MC, DM, 32, (int)blockIdx.x & 31); \
            pg8::EpiPlain E_{ks_ ? wsb(p, WS_HC) : wsb(p, WS_Y) + (size_t)ML * DM, DM, nullptr}; \
            pg8::gemm_phase<pg8::EpiPlain, pg8::StaticOrder, true, true>(lds, g_, S_, E_); \
            sub_barrier(ctl + CW_SUB + 64 * (SUBI_), NSUBWG); \
            { const int gw_ = gw, ngw_ = NSUBWG * NWAVES; EXTRA_; THIN_CTX_; } } \
        else { const int gw_ = gw - NSUBWG * NWAVES, ngw_ = ngw - NSUBWG * NWAVES; THIN_LAT_; } \
        SEAM(); \
    } else { const int gw_ = gw, ngw_ = ngw; EXTRA_; THIN_LAT_; SEAM(); } \
} while (0)
__global__ void __launch_bounds__(NTHREADS, 2) fwd(P p) {
    extern __shared__ __attribute__((aligned(16))) unsigned char lds_raw[];
    LAS unsigned char* lds = (LAS unsigned char*)lds_raw;
    const int tid = threadIdx.x, lane = tid & 63, wave = __builtin_amdgcn_readfirstlane(tid >> 6);
    const int G = gridDim.x, gtid = blockIdx.x * NTHREADS + tid, nth = G * NTHREADS, gw = blockIdx.x * NWAVES + wave, ngw = G * NWAVES;
    volatile LAS unsigned* MISC = (volatile LAS unsigned*)(lds + MISC_OFF);
    for (int u = tid; u < (LDS_BYTES - RING_BYTES) / 4; u += NTHREADS) ((LAS unsigned*)(lds + RING_BYTES))[u] = 0u;
    __syncthreads();
    unsigned* ctl = (unsigned*)(p.ws + WS_CTL);
    XcdBarrier bar; bar.bar = ctl + CW_BAR; bar.x = 0; bar.st = nullptr;
    if (p.one) bar = xcd_barrier_post(ctl + CW_BAR, MISC + 8);
#define SEAM() do { if (p.one) xcd_barrier(bar); } while (0)
    const int lo = p.ph_lo, hi = p.ph_hi;
#define IN(k) (lo <= (k) && (k) < hi)
    if (p.layer < 0 || p.one) {
        if (IN(0)) { ph_modpart_gpu(p, lds, tid, gtid, nth); ph_wconv(p, 0, lds, gw, ngw, wave, lane); ph_init(p, gtid, nth); SEAM(); }
        if (IN(1)) { ph_vec(p, gtid, nth); SEAM(); }
        if (IN(2)) { ph_thin<false, true>(p, 0, 0, 0, 0, gw, ngw, lane); SEAM(); }
    }
    const int l0 = p.one ? 0 : p.layer, l1 = p.one ? DEPTH : p.layer + 1;
    for (int l = (l0 < 0 ? DEPTH : l0); l < l1; ++l) {
        int tid_l = tid; asm volatile("" : "+v"(tid_l));
        const int lane = tid_l & 63, gtid = blockIdx.x * NTHREADS + tid_l, gw = blockIdx.x * NWAVES + __builtin_amdgcn_readfirstlane(tid_l >> 6);
        if (IN(3)) { pg8::Gemm g{wsb(p, WS_U), wl(p, l, WL_GU1), M, 2 * DFF, DM}; pg8::StaticOrder S; S.init(M, 2 * DFF, G, (int)blockIdx.x);
            pg8::EpiSwiglu E{wsb(p, WS_ACT), DFF}; pg8::gemm_phase<pg8::EpiSwiglu, pg8::StaticOrder, true, true>(lds, g, S, E);
            { const int t0 = ((M / 256) * (2 * DFF / 256)) % G;
              if (l + 1 < DEPTH && (int)blockIdx.x >= t0) ph_wconv(p, l + 1, lds, gw - t0 * NWAVES, (G - t0) * NWAVES, gw & 7, lane, 0, 2 * WCONV_ITEMS / 5); }
            SEAM(); }
        if (IN(4)) { PROJ_THIN(wsb(p, WS_ACT), wl(p, l, WL_D1), DFF, true, (ph_thin<true, true>(p, l, 0, l, 1, gw_, ngw_, lane, ML, 0)), (ph_thin<true, true, true>(p, l, 0, l, 1, gw_, ngw_, lane, M, ML)), (void)0, 3 * l); }
        if (IN(6)) { pg8::Gemm g{wsb(p, WS_U), wl(p, l, WL_IN), M, ZP, DM}; pg8::StaticOrder S; S.init(M, ZP, G, (int)blockIdx.x);
            pg8::EpiPlain E{wsb(p, WS_ACT), ZP, wsf(p, WS_BINP) + (size_t)l * ZP}; pg8::gemm_phase<pg8::EpiPlain, pg8::StaticOrder, true, true>(lds, g, S, E);
            { const int t0 = ((M / 256) * (ZP / 256)) % G;
              if (l + 1 < DEPTH && (int)blockIdx.x >= t0) ph_wconv(p, l + 1, lds, gw - t0 * NWAVES, (G - t0) * NWAVES, gw & 7, lane, 2 * WCONV_ITEMS / 5, 3 * WCONV_ITEMS / 5); }
            SEAM(); }
        if (IN(7)) { ph_zpost(p, l, gtid, nth); SEAM(); }
        if (IN(8)) { att::phase(p, lds, l, l + 1 < DEPTH, tid_l); mixer_p1_items(p, lds, l, tid_l, gw & 7, lane); SEAM();
#ifdef DBG_GLA
            if (l == DBG_GLA - 1) { const bf16* sg = wsb(p, WS_SG); int bad = 0; for (long i = gtid; i < (long)NCHAIN * gla::NCH * 2048; i += nth) if (!(fabsf(bf2f(sg[i])) < 1e30f)) bad = 1;
                const float* dd = wsf(p, WS_GST); for (long i = gtid; i < (long)NCHAIN * gla::NCH * 32; i += nth) if (!(fabsf(dd[i]) < 1e30f)) bad = 1;
                if (__any(bad) && (tid_l & 63) == 0) atomicAdd(ctl + 19, 1u); SEAM(); }
#endif
        }
        if (IN(9)) { gla::pass2(p, gtid, nth); mls::pass2(p, gtid, nth); SEAM();
#ifdef DBG_GLA
            if (l == DBG_GLA - 1) { const bf16* sg = wsb(p, WS_SG); int bad = 0; for (long i = gtid; i < (long)NCHAIN * gla::NCH * 2048; i += nth) if (!(fabsf(bf2f(sg[i])) < 1e30f)) bad = 1;
                if (__any(bad) && (tid_l & 63) == 0) atomicAdd(ctl + 20, 1u); SEAM(); }
#endif
        }
#ifndef DBG_GLA
        if (IN(10)) { mixer_p3_items(p, lds, l, l + 1 < DEPTH, tid_l, gw & 7, lane); SEAM(); }
#else
        if (IN(10)) { gla::pass3(p, lds, l, true, gw, ngw, gw & 7, lane); ph_ml3(p, l, gtid, nth); SEAM();
            { bf16* sv = wsb(p, WS_SG); const bf16* Y = wsb(p, WS_U); for (long i = gtid; i < (long)M * B_VW; i += nth) { const int r = (int)(i / B_VW), c = (int)(i % B_VW); sv[i] = Y[(size_t)r * DM + A_OUT + c]; } }
            SEAM(); ph_gla1(p, gtid, nth); SEAM(); ph_gla2(p, gtid, nth); SEAM(); ph_gla3(p, gtid, nth); SEAM(); }
        if (IN(11)) { ph_headln(p, l, gtid, nth, 0); SEAM();
            if (l == DBG_GLA - 1) { const bf16* sv = wsb(p, WS_SG); const bf16* Y = wsb(p, WS_U); float num = 0.f, den = 0.f; int bad = 0;
                for (long i = gtid; i < (long)M * B_VW; i += nth) { const int r = (int)(i / B_VW), c = (int)(i % B_VW); const float a = bf2f(sv[i]), b = bf2f(Y[(size_t)r * DM + A_OUT + c]);
                    if (!(fabsf(a) < 1e30f)) { bad = 1; } else { num += (a - b) * (a - b); } den += b * b; }
                num = wave_sum(num); den = wave_sum(den); bad = __any(bad) ? 1 : 0;
                if ((tid_l & 63) == 0) { atomicAdd((float*)(ctl + 16), num); atomicAdd((float*)(ctl + 17), den); if (bad) atomicAdd(ctl + 18, 1u); } }
            SEAM(); }
#endif
        const int mr = (l + 1 < DEPTH) ? M : ML;
        if (IN(12) && l + 1 == DEPTH && G == 256 && DM == 1024) {
            pg8::Gemm g{wsb(p, WS_U), wl(p, l, WL_OUT), ML, DM, DM};
            { pg8::RoundOrder S; S.init(ML, DM, G, (int)blockIdx.x); S.rnd = 0;
              pg8::EpiMid E{wsb(p, WS_HB), wsb(p, WS_U), vecp(p, l, 1, 2, 0), vecp(p, l, 2, 0, 0), vecp(p, l, 2, 1, 0), SEQ, EPS, pg8::PanelSS{wsf(p, WS_XS) + (size_t)ML * 4, ctl + CW_PAN + 8192}, pg8::PanelSS{wsf(p, WS_XS) + (size_t)2 * ML * 4, ctl + CW_PAN + 16384}};
              pg8::gemm_phase<pg8::EpiMid, pg8::RoundOrder, true, true>(lds, g, S, E); }
            __syncthreads();
            { pg8::RoundOrder S; S.init(ML, DM, G, (int)blockIdx.x); S.rnd = 1;
              pg8::EpiMid E{wsb(p, WS_HB), wsb(p, WS_U), vecp(p, l, 1, 2, 0), vecp(p, l, 2, 0, 0), vecp(p, l, 2, 1, 0), SEQ, EPS, pg8::PanelSS{wsf(p, WS_XS) + (size_t)ML * 4, ctl + CW_PAN + 8192}, pg8::PanelSS{wsf(p, WS_XS) + (size_t)2 * ML * 4, ctl + CW_PAN + 16384}};
              pg8::gemm_phase<pg8::EpiMid, pg8::RoundOrder, true, true>(lds, g, S, E); }
            SEAM(); }
        else if (IN(12)) { PROJ_THIN(wsb(p, WS_U), wl(p, l, WL_OUT), DM, l + 1 < DEPTH, (ph_thin<true, true>(p, l, 1, l, 2, gw_, ngw_, lane, ML, 0)), (ph_thin<true, true, true>(p, l, 1, l, 2, gw_, ngw_, lane, M, ML)), (void)0, 3 * l + 1); }
        if (IN(14)) { pg8::Gemm g{wsb(p, WS_U), wl(p, l, WL_GU2), mr, 2 * DFF, DM}; pg8::StaticOrder S; S.init(mr, 2 * DFF, G, (int)blockIdx.x);
            pg8::EpiSwiglu E{wsb(p, WS_ACT), DFF}; pg8::gemm_phase<pg8::EpiSwiglu, pg8::StaticOrder, true, true>(lds, g, S, E);
            { const int t0 = ((M / 256) * (2 * DFF / 256)) % G;
              if (l + 1 < DEPTH && (int)blockIdx.x >= t0) ph_wconv(p, l + 1, lds, gw - t0 * NWAVES, (G - t0) * NWAVES, gw & 7, lane, 3 * WCONV_ITEMS / 5, WCONV_ITEMS); }
            SEAM(); }
        if (IN(15)) { if (l + 1 < DEPTH) { PROJ_THIN(wsb(p, WS_ACT), wl(p, l, WL_D2), DFF, true, (ph_thin<true, true>(p, l, 2, l + 1, 0, gw_, ngw_, lane, ML, 0)), (ph_thin<true, true, true>(p, l, 2, l + 1, 0, gw_, ngw_, lane, M, ML)), (void)0, 3 * l + 2); }
            else if (G == 256 && DM == 1024) {
                pg8::Gemm g{wsb(p, WS_ACT), wl(p, l, WL_D2), ML, DM, DFF};
                { pg8::RoundOrder S; S.init(ML, DM, G, (int)blockIdx.x); S.rnd = 0;
                  pg8::EpiFinal E{wsb(p, WS_HB), p.out, vecp(p, l, 2, 2, 0), SEQ, EPS, pg8::PanelSS{wsf(p, WS_XS), ctl + CW_PAN}}; pg8::gemm_phase<pg8::EpiFinal, pg8::RoundOrder, true, true>(lds, g, S, E); }
                __syncthreads();
                { pg8::RoundOrder S; S.init(ML, DM, G, (int)blockIdx.x); S.rnd = 1;
                  pg8::EpiFinal E{wsb(p, WS_HB), p.out, vecp(p, l, 2, 2, 0), SEQ, EPS, pg8::PanelSS{wsf(p, WS_XS), ctl + CW_PAN}}; pg8::gemm_phase<pg8::EpiFinal, pg8::RoundOrder, true, true>(lds, g, S, E); }
            }
            else { PROJ_THIN(wsb(p, WS_ACT), wl(p, l, WL_D2), DFF, false, (ph_thin<true, false>(p, l, 2, l, 2, gw_, ngw_, lane, ML, 0)), (void)0, (void)0, 0);
#ifdef DBG_GLA
            SEAM(); { const float num = __hip_atomic_load((float*)(ctl + 16), __ATOMIC_RELAXED, __HIP_MEMORY_SCOPE_AGENT), den = __hip_atomic_load((float*)(ctl + 17), __ATOMIC_RELAXED, __HIP_MEMORY_SCOPE_AGENT);
                const unsigned bad = __hip_atomic_load(ctl + 18, __ATOMIC_RELAXED, __HIP_MEMORY_SCOPE_AGENT);
                float code = num / fmaxf(den, 1e-20f); if (!(code < 0.8f)) code = 0.8f; if (bad) code = 0.95f;
                if (__hip_atomic_load(ctl + 20, __ATOMIC_RELAXED, __HIP_MEMORY_SCOPE_AGENT)) code = 0.5f; if (__hip_atomic_load(ctl + 19, __ATOMIC_RELAXED, __HIP_MEMORY_SCOPE_AGENT)) code = 0.3f;
                const float sc = 1.f + sqrtf(code); for (long i = gtid; i < (long)ML * DM; i += nth) p.out[i] *= sc; }
#endif
        } }
    }
#undef IN
#undef SEAM
}

#ifndef ONE_LAUNCH
#define ONE_LAUNCH 1
#endif
extern "C" void kernel_launch(void* const* d_in, const int* in_sizes, int n_in, void* d_out, int out_size, void* d_ws, size_t ws_size, hipStream_t stream) {
    static int grid = 0;
    if (grid == 0) {
        if (n_in != N_IN || in_sizes[0] != ML * DM || out_size != ML * DM || ws_size < WS_END) {
            fprintf(stderr, "kernel_launch: unexpected shapes (n_in %d, in0 %d, out %d, ws %zu < %zu); nothing launched\n", n_in, n_in > 0 ? in_sizes[0] : -1, out_size, ws_size, (size_t)WS_END); grid = -1; return; }
        int dev = 0, cus = 0, per_cu = 0;
        if (hipGetDevice(&dev) != hipSuccess || hipDeviceGetAttribute(&cus, hipDeviceAttributeMultiprocessorCount, dev) != hipSuccess) { grid = -1; return; }
        if (hipFuncSetAttribute((const void*)fwd, hipFuncAttributeMaxDynamicSharedMemorySize, LDS_BYTES) != hipSuccess) { fprintf(stderr, "kernel_launch: hipFuncSetAttribute failed\n"); grid = -1; return; }
        if (hipOccupancyMaxActiveBlocksPerMultiprocessor(&per_cu, (const void*)fwd, NTHREADS, LDS_BYTES) != hipSuccess || per_cu < 1) fprintf(stderr, "kernel_launch: occupancy query says %d\n", per_cu);
        (void)hipGetLastError();
        grid = cus;
    }
    if (grid < 0) return;
    (void)hipMemsetAsync((char*)d_ws + WS_CTL, 0, CTL_BYTES, stream);
    P a{};
    for (int i = 0; i < N_IN; ++i) a.in[i] = (const float*)d_in[i];
    a.out = (float*)d_out; a.ws = (unsigned char*)d_ws;
#if ONE_LAUNCH
    a.layer = 0; a.ph_lo = 0; a.ph_hi = 17; a.one = 1;
    hipLaunchKernelGGL(fwd, dim3(grid), dim3(NTHREADS), LDS_BYTES, stream, a);
#else
    a.one = 0;
    for (int k = 0; k < 3; ++k) { a.layer = -1; a.ph_lo = k; a.ph_hi = k + 1; hipLaunchKernelGGL(fwd, dim3(grid), dim3(NTHREADS), LDS_BYTES, stream, a); }
    for (int l = 0; l < DEPTH; ++l) for (int k = 3; k < 17; ++k) { a.layer = l; a.ph_lo = k; a.ph_hi = k + 1; hipLaunchKernelGGL(fwd, dim3(grid), dim3(NTHREADS), LDS_BYTES, stream, a); }
#endif
}
#endif
```

```cpp
#ifndef CPU_EMU
#include <hip/hip_runtime.h>
#include <cstdio>
#include <cstdint>
#define DEV __device__ __forceinline__
#else
#include <cstdio>
#include <cstdint>
#include <cmath>
#include <cstring>
#define DEV static inline
#define __host__
#define __device__
#define __forceinline__ inline
struct EmuIdx { int x; };
static thread_local EmuIdx threadIdx, blockIdx, gridDim;
struct float4 { float x, y, z, w; };
#define __expf expf
#endif

#ifndef CFG_DM
#define CFG_DM 1024
#define CFG_NB 8
#define CFG_SEQ 4096
#define CFG_DEPTH 4
#define CFG_GRIDW 64
#define CFG_CTXL 256
#define CFG_DFF 2816
#define CFG_SC 256
#endif
constexpr int DM = CFG_DM, NB = CFG_NB, SEQ = CFG_SEQ, DEPTH = CFG_DEPTH, GRIDW = CFG_GRIDW, CTXL = CFG_CTXL, DFF = CFG_DFF, SC = CFG_SC;
constexpr int AH = DM / 128, AKV = AH / 4, AGRP = AH / AKV, WIN = 128;
constexpr int BH = DM / 256, CH = DM / 256, RANK = 16;
constexpr int A_OUT = AH * 64, A_KVW = AKV * 64, B_KW = BH * 32, B_VW = BH * 64, C_W = CH * 64;
constexpr int INW = A_OUT + 2 * A_KVW + 2 * B_KW + 2 * B_VW + 2 * RANK + 4 * C_W + 4 * CH;
constexpr int ZQ = 0, ZK = A_OUT, ZV = ZK + A_KVW, ZBQ = ZV + A_KVW, ZBK = ZBQ + B_KW, ZBV = ZBK + B_KW, ZBG = ZBV + B_VW, ZAF = ZBG + B_VW, ZAB = ZAF + RANK,
              ZCQ = ZAB + RANK, ZCK = ZCQ + C_W, ZCV = ZCK + C_W, ZCG = ZCV + C_W, ZCO = ZCG + 4 * CH;
static_assert(ZCO + C_W == INW, "in-proj split");
constexpr int ZP = (INW + 255) / 256 * 256;
constexpr int ML = NB * SEQ, MC = NB * CTXL, M = ML + MC;
constexpr int NMOD = NB + 1;
constexpr int NSCC = CTXL / SC, NSCL = SEQ / SC, NSC = NSCC + NSCL;
constexpr int NCHAIN = NB * BH * 2;
constexpr int OW = B_VW + C_W;
static_assert(BH == CH && M % 256 == 0 && (2 * DFF) % 256 == 0 && DFF % 128 == 0 && DM % 256 == 0 && CTXL % SC == 0 && SEQ % SC == 0, "shape assumptions");
constexpr float EPS = 1e-6f;
constexpr int KSPLIT = 8;
constexpr int NPOS = (SEQ / GRIDW > GRIDW) ? SEQ / GRIDW : GRIDW;

typedef unsigned short bf16;
#ifndef CPU_EMU
typedef float f32x4g __attribute__((ext_vector_type(4)));
#endif
DEV float bf2f(bf16 h) { unsigned u = (unsigned)h << 16; float f; __builtin_memcpy(&f, &u, 4); return f; }
DEV bf16 f2bf(float f) { unsigned u; __builtin_memcpy(&u, &f, 4); return (bf16)((u + 0x7fffu + ((u >> 16) & 1u)) >> 16); }
#ifndef CPU_EMU
typedef float f32x2g __attribute__((ext_vector_type(2))); typedef __bf16 bf16x2g __attribute__((ext_vector_type(2)));
DEV unsigned pkbf(float lo, float hi) { const f32x2g v = {lo, hi}; return __builtin_bit_cast(unsigned, __builtin_convertvector(v, bf16x2g)); }
#else
DEV unsigned pkbf(float lo, float hi) { return (unsigned)f2bf(lo) | ((unsigned)f2bf(hi) << 16); }
#endif
DEV bf16 f2bfh(float f) { return (bf16)pkbf(f, 0.f); }
DEV void ld8(const bf16* p, float* f) {
#ifndef CPU_EMU
    const uint4 v = *(const uint4*)p;
    f[0] = __uint_as_float(v.x << 16); f[1] = __uint_as_float(v.x & 0xffff0000u); f[2] = __uint_as_float(v.y << 16); f[3] = __uint_as_float(v.y & 0xffff0000u);
    f[4] = __uint_as_float(v.z << 16); f[5] = __uint_as_float(v.z & 0xffff0000u); f[6] = __uint_as_float(v.w << 16); f[7] = __uint_as_float(v.w & 0xffff0000u);
#else
    for (int i = 0; i < 8; ++i) f[i] = bf2f(p[i]);
#endif
}
#ifndef CPU_EMU
DEV float siluf(float x) { return x * __builtin_amdgcn_rcpf(1.f + __expf(-x)); }
DEV float sigmf(float x) { return __builtin_amdgcn_rcpf(1.f + __expf(-x)); }
DEV float logsigf(float x) { return fminf(x, 0.f) - __logf(1.f + __expf(-fabsf(x))); }
DEV void ldf8(const float* p, float* f) { const f32x4g a = *(const f32x4g*)p, b = *(const f32x4g*)(p + 4); f[0] = a.x; f[1] = a.y; f[2] = a.z; f[3] = a.w; f[4] = b.x; f[5] = b.y; f[6] = b.z; f[7] = b.w; }
#else
DEV float siluf(float x) { return x / (1.f + __expf(-x)); }
DEV float sigmf(float x) { return 1.f / (1.f + __expf(-x)); }
DEV float logsigf(float x) { return fminf(x, 0.f) - log1pf(__expf(-fabsf(x))); }
DEV void ldf8(const float* p, float* f) { for (int i = 0; i < 8; ++i) f[i] = p[i]; }
#endif

enum { I_X = 0, I_C, I_CTX, I_CCTX, I_ADAW, I_ADAB, I_NORMG, I_F1G, I_F1U, I_F1D, I_F2G, I_F2U, I_F2D, I_WIN, I_BIN, I_WOUT, I_SINK, I_GWA, I_GBA, I_GNORM, I_CONV, I_FBIAS, I_MNORM, N_IN };

constexpr size_t al256(size_t x) { return (x + 255) / 256 * 256; }
constexpr size_t WS_CTL = 0, CTL_BYTES = 1u << 20;
constexpr size_t W_GU = (size_t)2 * DFF * DM, W_D = (size_t)DM * DFF, W_IN = (size_t)ZP * DM, W_OUT = (size_t)DM * DM;
constexpr size_t WL_GU1 = 0, WL_D1 = WL_GU1 + W_GU, WL_IN = WL_D1 + W_D, WL_OUT = WL_IN + W_IN, WL_GU2 = WL_OUT + W_OUT, WL_D2 = WL_GU2 + W_GU, WL_ELEMS = WL_D2 + W_D;
constexpr size_t WS_W = WS_CTL + CTL_BYTES;
constexpr size_t WS_MODP = al256(WS_W + (size_t)WL_ELEMS * 2 * 2);
constexpr size_t WS_VEC = al256(WS_MODP + (size_t)KSPLIT * DEPTH * NMOD * 9 * DM * 4);
constexpr size_t WS_BINP = al256(WS_VEC + (size_t)DEPTH * 9 * NMOD * DM * 4);
constexpr size_t WS_ROPE = al256(WS_BINP + (size_t)DEPTH * ZP * 4);
constexpr size_t PRM_SINK = 0, PRM_GWA = PRM_SINK + (size_t)DEPTH * AH, PRM_GBA = PRM_GWA + (size_t)DEPTH * 2 * RANK * B_KW, PRM_GNORM = PRM_GBA + (size_t)DEPTH * 2 * B_KW,
                 PRM_CONV = PRM_GNORM + (size_t)DEPTH * B_VW, PRM_FBIAS = PRM_CONV + (size_t)DEPTH * 3 * 2 * C_W, PRM_MNORM = PRM_FBIAS + (size_t)DEPTH * 2 * CH, PRM_END = PRM_MNORM + (size_t)DEPTH * C_W;
constexpr size_t WS_PRM = al256(WS_ROPE + (size_t)NPOS * 32 * 4);
constexpr size_t WS_HC = al256(WS_PRM + PRM_END * 4);
constexpr size_t WS_U = al256(WS_HC + (size_t)MC * DM * 4);
constexpr size_t ACTW = (DFF > ZP ? DFF : ZP);
constexpr size_t WS_ACT = al256(WS_U + (size_t)M * DM * 2);
constexpr size_t WS_Y = al256(WS_ACT + (size_t)M * ACTW * 2);
constexpr size_t YBYTES = ((size_t)M * DM * 2 > (size_t)M * OW * 4) ? (size_t)M * DM * 2 : (size_t)M * OW * 4;
constexpr size_t WS_GST = al256(WS_Y + YBYTES);
constexpr size_t GST_S = (size_t)NCHAIN * NSC * 32 * 64, GST_D = (size_t)NCHAIN * NSC * 32;
constexpr size_t WS_MST = al256(WS_GST + (GST_S + GST_D) * 4);
constexpr size_t MST_C = (size_t)NCHAIN * NSC * 64 * 64, MST_N = (size_t)NCHAIN * NSC * 64, MST_M = (size_t)NCHAIN * NSC;
constexpr size_t WS_GA = al256(WS_MST + (MST_C + MST_N + 3 * MST_M) * 4);
constexpr size_t WS_CQK = al256(WS_GA + (size_t)2 * M * B_KW * 2);
constexpr size_t WS_SG = al256(WS_CQK + (size_t)M * 2 * C_W * 2);
constexpr size_t WS_HB = al256(WS_SG + (size_t)NCHAIN * ((CTXL + SEQ) / 64) * 2048 * 2);
constexpr size_t WS_XS = al256(WS_HB + (size_t)M * DM * 2);
constexpr size_t WS_END = al256(WS_XS + (size_t)3 * ML * 4 * 4);

struct P {
    const float* in[N_IN]; float* out; unsigned char* ws;
    int layer, ph_lo, ph_hi, one;
};

DEV bf16* wsb(const P& p, size_t off) { return (bf16*)(p.ws + off); }
DEV float* wsf(const P& p, size_t off) { return (float*)(p.ws + off); }
DEV float* hrow(const P& p, int r) { return r < ML ? p.out + (size_t)r * DM : wsf(p, WS_HC) + (size_t)(r - ML) * DM; }
DEV int modidx(int r) { return r < ML ? r / SEQ : NB; }
DEV float* vecp(const P& p, int l, int s, int kind, int bi) { return wsf(p, WS_VEC) + ((((size_t)l * 3 + s) * 3 + kind) * NMOD + bi) * DM; }
DEV const float* prm(const P& p, size_t off) { return (const float*)(p.ws + WS_PRM) + off; }
DEV bf16* wl(const P& p, int l, size_t off) { return wsb(p, WS_W) + (size_t)(l & 1) * WL_ELEMS + off; }
DEV void sc_rows(int b, int dir, int n, int& row0, int& step) {
    if (n < NSCC) { const int c = dir ? (NSCC - 1 - n) : n; const int base = ML + b * CTXL + c * SC; row0 = dir ? base + SC - 1 : base; }
    else { const int c = dir ? (NSCL - 1 - (n - NSCC)) : (n - NSCC); const int base = b * SEQ + c * SC; row0 = dir ? base + SC - 1 : base; }
    step = dir ? -1 : 1;
}
DEV int sc_chain_index(int t, int dir) { if (!dir) return t; return t < NSCC ? (NSCC - 1 - t) : NSCC + (NSCL - 1 - (t - NSCC)); }
DEV int sc_first_row(int b, int t) { return t < NSCC ? ML + b * CTXL + t * SC : b * SEQ + (t - NSCC) * SC; }

DEV void ph_modpart(const P& p, int gtid, int nth) {
    const float* c = p.in[I_C]; const float* cc = p.in[I_CCTX];
    constexpr int KS = DM / KSPLIT;
    for (long it = gtid; it < (long)KSPLIT * DEPTH * 9 * DM; it += nth) {
        const int col = (int)(it % (9 * DM)); const int l = (int)((it / (9 * DM)) % DEPTH); const int ks = (int)(it / ((long)9 * DM * DEPTH));
        const float* w = p.in[I_ADAW] + (size_t)l * DM * 9 * DM + col;
        float acc[NMOD];
#pragma unroll
        for (int b = 0; b < NMOD; ++b) acc[b] = 0.f;
        for (int k = ks * KS; k < (ks + 1) * KS; ++k) {
            const float wv = w[(size_t)k * 9 * DM];
#pragma unroll
            for (int b = 0; b < NMOD; ++b) { const float cv = b < NB ? c[b * DM + k] : cc[k]; acc[b] += siluf(cv) * wv; }
        }
#pragma unroll
        for (int b = 0; b < NMOD; ++b) wsf(p, WS_MODP)[(((size_t)ks * DEPTH + l) * NMOD + b) * 9 * DM + col] = acc[b];
    }
}
DEV void ph_init(const P& p, int gtid, int nth) {
#ifdef CPU_EMU
    const float4* x4 = (const float4*)p.in[I_X]; float4* o4 = (float4*)p.out;
    for (long i = gtid; i < (long)ML * DM / 4; i += nth) o4[i] = x4[i];
    const float4* c4 = (const float4*)p.in[I_CTX]; float4* h4 = (float4*)wsf(p, WS_HC);
    for (long i = gtid; i < (long)MC * DM / 4; i += nth) h4[i] = c4[i];
#else
    { const f32x4g* x4 = (const f32x4g*)p.in[I_X]; const f32x4g* c4 = (const f32x4g*)p.in[I_CTX]; uint2* hb = (uint2*)wsb(p, WS_HB);
      const long NV4 = (long)M * DM / 4, NL4 = (long)ML * DM / 4;
      for (long i0 = gtid; i0 < NV4; i0 += 4L * nth) { f32x4g v[4];
#pragma unroll
          for (int q = 0; q < 4; ++q) { const long i = i0 + (long)q * nth; if (i < NV4) v[q] = i < NL4 ? x4[i] : c4[i - NL4]; }
#pragma unroll
          for (int q = 0; q < 4; ++q) { const long i = i0 + (long)q * nth; if (i < NV4) { uint2 o; o.x = pkbf(v[q].x, v[q].y); o.y = pkbf(v[q].z, v[q].w); hb[i] = o; } } } }
#endif
    for (int i = gtid; i < NPOS * 16; i += nth) { const int pos = i / 16, f = i % 16; const float inv = powf(10000.f, -(float)f / 16.f); const float a = (float)pos * inv;
        wsf(p, WS_ROPE)[2 * i] = cosf(a); wsf(p, WS_ROPE)[2 * i + 1] = sinf(a); }
    { float* pr = wsf(p, WS_PRM);
      for (int i = gtid; i < DEPTH * AH; i += nth) pr[PRM_SINK + i] = p.in[I_SINK][i];
      for (int i = gtid; i < DEPTH * 2 * RANK * B_KW; i += nth) pr[PRM_GWA + i] = p.in[I_GWA][i];
      for (int i = gtid; i < DEPTH * 2 * B_KW; i += nth) pr[PRM_GBA + i] = p.in[I_GBA][i];
      for (int i = gtid; i < DEPTH * B_VW; i += nth) pr[PRM_GNORM + i] = p.in[I_GNORM][i];
      for (int i = gtid; i < DEPTH * 3 * 2 * C_W; i += nth) pr[PRM_CONV + i] = p.in[I_CONV][i];
      for (int i = gtid; i < DEPTH * 2 * CH; i += nth) pr[PRM_FBIAS + i] = p.in[I_FBIAS][i];
      for (int i = gtid; i < DEPTH * C_W; i += nth) pr[PRM_MNORM + i] = p.in[I_MNORM][i]; }
    for (int i = gtid; i < DEPTH * ZP; i += nth) { const int l = i / ZP, c = i % ZP; wsf(p, WS_BINP)[i] = c < INW ? p.in[I_BIN][l * INW + c] : 0.f; }
}
DEV void ph_vec(const P& p, int gtid, int nth) {
    for (long it = gtid; it < (long)DEPTH * 3 * NMOD * DM; it += nth) {
        const int col = (int)(it % DM); const int bi = (int)((it / DM) % NMOD); const int s = (int)((it / ((long)DM * NMOD)) % 3); const int l = (int)(it / ((long)DM * NMOD * 3));
        float m3[3];
#pragma unroll
        for (int j = 0; j < 3; ++j) { const int c9 = (3 * s + j) * DM + col; float a = p.in[I_ADAB][l * 9 * DM + c9];
            for (int ks = 0; ks < KSPLIT; ++ks) a += wsf(p, WS_MODP)[(((size_t)ks * DEPTH + l) * NMOD + bi) * 9 * DM + c9];
            m3[j] = a; }
        const float gpre = p.in[I_NORMG][(l * 6 + 2 * s) * DM + col], gpost = p.in[I_NORMG][(l * 6 + 2 * s + 1) * DM + col];
        vecp(p, l, s, 0, bi)[col] = gpre * (1.f + m3[1]);
        vecp(p, l, s, 1, bi)[col] = m3[0];
        vecp(p, l, s, 2, bi)[col] = (s == 1 ? 1.f : 0.5f) * m3[2] * gpost;
    }
}
DEV void st8(bf16* p, const float* f) {
#ifndef CPU_EMU
    uint4 v; v.x = pkbf(f[0], f[1]); v.y = pkbf(f[2], f[3]); v.z = pkbf(f[4], f[5]); v.w = pkbf(f[6], f[7]);
    *(uint4*)p = v;
#else
    for (int i = 0; i < 8; ++i) p[i] = f2bf(f[i]);
#endif
}
DEV void ph_zpost(const P& p, int l, int gtid, int nth) {
    bf16* Z = wsb(p, WS_ACT);
    const float* rt = wsf(p, WS_ROPE);
#ifdef CPU_EMU
    constexpr int RH0 = 0, RHN = AH + AKV;
#else
    constexpr int RH0 = AH, RHN = AKV;
#endif
    for (long it = gtid; it < (long)ML * RHN * 2; it += nth) {
        const int hf = (int)(it % 2); const int hs = RH0 + (int)((it / 2) % RHN); const int r = (int)(it / (2 * RHN));
        const int t = r % SEQ; const int pos = hf == 0 ? t / GRIDW : t % GRIDW;
        bf16* z = Z + (size_t)r * ZP + (hs < AH ? ZQ + hs * 64 : ZK + (hs - AH) * 64) + hf * 32;
        float x1[16], x2[16], y1[16], y2[16];
        ld8(z, x1); ld8(z + 8, x1 + 8); ld8(z + 16, x2); ld8(z + 24, x2 + 8);
        float cs_[32];
#ifndef CPU_EMU
#pragma unroll
        for (int i = 0; i < 8; ++i) { const f32x4g v = ((const f32x4g*)(rt + 32 * pos))[i]; cs_[4 * i] = v.x; cs_[4 * i + 1] = v.y; cs_[4 * i + 2] = v.z; cs_[4 * i + 3] = v.w; }
#else
        for (int i = 0; i < 32; ++i) cs_[i] = rt[32 * pos + i];
#endif
#pragma unroll
        for (int i = 0; i < 16; ++i) { const float cs = cs_[2 * i], sn = cs_[2 * i + 1]; y1[i] = x1[i] * cs - x2[i] * sn; y2[i] = x1[i] * sn + x2[i] * cs; }
        st8(z, y1); st8(z + 8, y1 + 8); st8(z + 16, y2); st8(z + 24, y2 + 8);
    }
    const float* wa = prm(p, PRM_GWA) + (size_t)l * 2 * RANK * B_KW; const float* ba = prm(p, PRM_GBA) + (size_t)l * 2 * B_KW;
    bf16* GA = wsb(p, WS_GA);
    { const long NI = (long)2 * M * (B_KW / 8);
      for (long it0 = gtid; it0 < NI; it0 += 2L * nth) {
        float zl[2][16], a[2][8]; int c8v[2], rv[2], dv[2]; bool ok[2];
#pragma unroll
        for (int q = 0; q < 2; ++q) { long it = it0 + (long)q * nth; ok[q] = it < NI; if (!ok[q]) it = it0;
            c8v[q] = (int)(it % (B_KW / 8)) * 8; rv[q] = (int)((it / (B_KW / 8)) % M); dv[q] = (int)(it / ((long)(B_KW / 8) * M));
            const bf16* zp = Z + (size_t)rv[q] * ZP + (dv[q] ? ZAB : ZAF); ld8(zp, zl[q]); ld8(zp + 8, zl[q] + 8); }
#pragma unroll
        for (int q = 0; q < 2; ++q) {
            ldf8(ba + dv[q] * B_KW + c8v[q], a[q]);
#pragma unroll
            for (int k = 0; k < RANK; ++k) { float w8[8]; ldf8(wa + (dv[q] * RANK + k) * B_KW + c8v[q], w8);
#pragma unroll
                for (int j = 0; j < 8; ++j) a[q][j] += zl[q][k] * w8[j]; }
#pragma unroll
            for (int j = 0; j < 8; ++j) a[q][j] = logsigf(a[q][j]) * (1.f / 16.f);
            if (ok[q]) st8(GA + ((size_t)dv[q] * M + rv[q]) * B_KW + c8v[q], a[q]); } } }
    const float* cw = prm(p, PRM_CONV) + (size_t)l * 3 * 2 * C_W;
    bf16* CQK = wsb(p, WS_CQK);
    { const long NI = (long)M * (2 * C_W / 8);
      for (long it0 = gtid; it0 < NI; it0 += 4L * nth) {
        float x0[4][8], xm[4][8], xp[4][8]; int chv[4], rv[4]; bool ok[4];
#pragma unroll
        for (int q = 0; q < 4; ++q) { long it = it0 + (long)q * nth; ok[q] = it < NI; if (!ok[q]) it = it0;
            const int ch = (int)(it % (2 * C_W / 8)) * 8; const int r = (int)(it / (2 * C_W / 8)); chv[q] = ch; rv[q] = r;
            int t, len; if (r < ML) { t = r % SEQ; len = SEQ; } else { t = (r - ML) % CTXL; len = CTXL; }
            const bf16* z = Z + (size_t)r * ZP + (ch < C_W ? ZCQ + ch : ZCK + (ch - C_W));
            ld8(z, x0[q]);
            if (t > 0) ld8(z - (long)ZP, xm[q]); else { for (int j = 0; j < 8; ++j) xm[q][j] = 0.f; }
            if (t < len - 1) ld8(z + ZP, xp[q]); else { for (int j = 0; j < 8; ++j) xp[q][j] = 0.f; } }
#pragma unroll
        for (int q = 0; q < 4; ++q) { float o[8], w0[8], w1[8], w2[8]; const int ch = chv[q];
            ldf8(cw + 0 * 2 * C_W + ch, w0); ldf8(cw + 1 * 2 * C_W + ch, w1); ldf8(cw + 2 * 2 * C_W + ch, w2);
#pragma unroll
            for (int j = 0; j < 8; ++j) o[j] = siluf(xm[q][j] * w0[j] + x0[q][j] * w1[j] + xp[q][j] * w2[j]);
            if (ok[q]) st8(CQK + (size_t)rv[q] * 2 * C_W + ch, o); } } }
}
DEV void ph_attn_naive(const P& p, int l, int gtid, int nth) {
    const bf16* Z = wsb(p, WS_ACT); bf16* Y = wsb(p, WS_U);
    const float* sink = prm(p, PRM_SINK) + l * AH;
    for (long it = gtid; it < (long)M * AH; it += nth) {
        const int r = (int)(it % M); const int hq = (int)(it / M); const int g = hq / AGRP;
        float q[64], o[64];
        const bf16* zq = Z + (size_t)r * ZP + ZQ + hq * 64;
#pragma unroll
        for (int d = 0; d < 64; d += 8) ld8(zq + d, q + d);
#pragma unroll
        for (int d = 0; d < 64; ++d) { q[d] *= 0.125f; o[d] = 0.f; }
        float m = sink[hq], lsum = 1.f;
        int b, j0, j1, crow0;
        if (r < ML) { b = r / SEQ; const int t = r % SEQ; j0 = t - WIN < 0 ? 0 : t - WIN; j1 = t + WIN > SEQ - 1 ? SEQ - 1 : t + WIN; }
        else { b = (r - ML) / CTXL; j0 = 0; j1 = -1; }
        crow0 = ML + b * CTXL;
        const int nwin = j1 - j0 + 1;
        for (int jj = 0; jj < nwin + CTXL; ++jj) {
            const int kr = jj < nwin ? b * SEQ + j0 + jj : crow0 + (jj - nwin);
            const bf16* zk = Z + (size_t)kr * ZP + ZK + g * 64; const bf16* zv = Z + (size_t)kr * ZP + ZV + g * 64;
            float s = 0.f;
#pragma unroll
            for (int d = 0; d < 64; d += 8) { float kk[8]; ld8(zk + d, kk);
#pragma unroll
                for (int e = 0; e < 8; ++e) s += q[d + e] * kk[e]; }
            const float mn = fmaxf(m, s); const float f = __expf(m - mn), e = __expf(s - mn);
            lsum = lsum * f + e; m = mn;
#pragma unroll
            for (int d = 0; d < 64; d += 8) { float vv[8]; ld8(zv + d, vv);
#pragma unroll
                for (int e2 = 0; e2 < 8; ++e2) o[d + e2] = o[d + e2] * f + e * vv[e2]; }
        }
        const float inv = 1.f / lsum;
        bf16* y = Y + (size_t)r * DM + hq * 64;
#pragma unroll
        for (int d = 0; d < 64; ++d) y[d] = f2bf(o[d] * inv);
    }
}
DEV void gla_tok(const P& p, int r, int h, int dir, float (&a)[32], float (&k)[32], float& v, int vc) {
    const bf16* Z = wsb(p, WS_ACT); const bf16* ga = wsb(p, WS_GA) + ((size_t)dir * M + r) * B_KW + h * 32;
    const bf16* zk = Z + (size_t)r * ZP + ZBK + h * 32;
#pragma unroll
    for (int d = 0; d < 32; d += 8) { ld8(ga + d, a + d); ld8(zk + d, k + d); }
#pragma unroll
    for (int d = 0; d < 32; ++d) a[d] = __expf(a[d]);
    v = bf2f(Z[(size_t)r * ZP + ZBV + h * 64 + vc]);
}
DEV void ph_gla1(const P& p, int gtid, int nth) {
    float* S = wsf(p, WS_GST); float* D = S + GST_S;
    for (long it = gtid; it < (long)NCHAIN * NSC * 64; it += nth) {
        const int vc = (int)(it % 64); const int n = (int)((it / 64) % NSC); const int ch = (int)(it / (64 * NSC));
        const int dir = ch & 1, h = (ch >> 1) % BH, b = ch / (2 * BH);
        int row0, step; sc_rows(b, dir, n, row0, step);
        float s[32], pd[32];
#pragma unroll
        for (int d = 0; d < 32; ++d) { s[d] = 0.f; pd[d] = 1.f; }
        for (int i = 0; i < SC; ++i) {
            float a[32], k[32], v; gla_tok(p, row0 + i * step, h, dir, a, k, v, vc);
#pragma unroll
            for (int d = 0; d < 32; ++d) { s[d] = a[d] * s[d] + k[d] * v; pd[d] *= a[d]; }
        }
        float* so = S + ((size_t)ch * NSC + n) * 32 * 64;
#pragma unroll
        for (int d = 0; d < 32; ++d) so[d * 64 + vc] = s[d];
        if (vc == 0) {
#pragma unroll
            for (int d = 0; d < 32; ++d) D[((size_t)ch * NSC + n) * 32 + d] = pd[d]; }
    }
}
DEV void ph_gla2(const P& p, int gtid, int nth) {
    float* S = wsf(p, WS_GST); const float* D = S + GST_S;
    for (long it = gtid; it < (long)NCHAIN * 32 * 64; it += nth) {
        const int e = (int)(it % (32 * 64)); const int ch = (int)(it / (32 * 64)); const int d = e / 64;
        float st = 0.f;
        for (int n = 0; n < NSC; ++n) { float* x = S + ((size_t)ch * NSC + n) * 32 * 64 + e; const float loc = *x; *x = st; st = D[((size_t)ch * NSC + n) * 32 + d] * st + loc; }
    }
}
DEV void ph_gla3(const P& p, int gtid, int nth) {
    const float* S = wsf(p, WS_GST); const bf16* Z = wsb(p, WS_ACT); float* O = wsf(p, WS_Y);
    for (long it = gtid; it < (long)NB * BH * NSC * 64; it += nth) {
        const int vc = (int)(it % 64); const int t = (int)((it / 64) % NSC); const int h = (int)((it / (64 * NSC)) % BH); const int b = (int)(it / ((long)64 * NSC * BH));
        for (int dir = 0; dir < 2; ++dir) {
            const int ch = (b * BH + h) * 2 + dir; const int n = sc_chain_index(t, dir);
            int row0, step; sc_rows(b, dir, n, row0, step);
            float s[32];
            const float* sp = S + ((size_t)ch * NSC + n) * 32 * 64;
#pragma unroll
            for (int d = 0; d < 32; ++d) s[d] = sp[d * 64 + vc];
            for (int i = 0; i < SC; ++i) {
                const int r = row0 + i * step;
                float a[32], k[32], v; gla_tok(p, r, h, dir, a, k, v, vc);
                const bf16* zq = Z + (size_t)r * ZP + ZBQ + h * 32;
                float o = 0.f, qq[32];
#pragma unroll
                for (int d = 0; d < 32; d += 8) ld8(zq + d, qq + d);
#pragma unroll
                for (int d = 0; d < 32; ++d) { s[d] = a[d] * s[d] + k[d] * v; o += qq[d] * s[d]; }
                o *= 0.17677669529663687f;
                float* op = O + (size_t)r * OW + h * 64 + vc;
                if (dir == 0) *op = o; else *op += o;
            }
        }
    }
}
DEV void ml_tok(const P& p, int l, int r, int h, int dir, const bf16*& ck, float& v, float& li, float& lf, int vc) {
    const bf16* Z = wsb(p, WS_ACT); ck = wsb(p, WS_CQK) + (size_t)r * 2 * C_W + C_W + h * 64;
    v = bf2f(Z[(size_t)r * ZP + ZCV + h * 64 + vc]);
    li = bf2f(Z[(size_t)r * ZP + ZCG + (2 * dir) * CH + h]);
    lf = logsigf(bf2f(Z[(size_t)r * ZP + ZCG + (2 * dir + 1) * CH + h]) + prm(p, PRM_FBIAS)[(l * 2 + dir) * CH + h]);
}
DEV void ph_ml1(const P& p, int l, int gtid, int nth) {
    float* C = wsf(p, WS_MST); float* N = C + MST_C; float* Mm = N + MST_N; float* F = Mm + MST_M;
    for (long it = gtid; it < (long)NCHAIN * NSC * 64; it += nth) {
        const int vc = (int)(it % 64); const int n = (int)((it / 64) % NSC); const int ch = (int)(it / (64 * NSC));
        const int dir = ch & 1, h = (ch >> 1) % CH, b = ch / (2 * CH);
        int row0, step; sc_rows(b, dir, n, row0, step);
        float c[64], nn[64]; float m = -1e30f, fs = 0.f;
#pragma unroll
        for (int d = 0; d < 64; ++d) { c[d] = 0.f; nn[d] = 0.f; }
        for (int i = 0; i < SC; ++i) {
            const bf16* ck; float v, li, lf; ml_tok(p, l, row0 + i * step, h, dir, ck, v, li, lf, vc);
            const float mn = fmaxf(lf + m, li); const float fp = __expf(lf + m - mn), ip = __expf(li - mn) * 0.125f; m = mn; fs += lf;
#pragma unroll
            for (int d0 = 0; d0 < 64; d0 += 8) { float k8[8]; ld8(ck + d0, k8);
#pragma unroll
                for (int e = 0; e < 8; ++e) { const int d = d0 + e; c[d] = fp * c[d] + ip * v * k8[e]; nn[d] = fp * nn[d] + ip * k8[e]; } }
        }
        float* co = C + (((size_t)ch * NSC + n) * 64 + vc) * 64;
#pragma unroll
        for (int d = 0; d < 64; ++d) co[d] = c[d];
        if (vc == 0) {
#pragma unroll
            for (int d = 0; d < 64; ++d) N[((size_t)ch * NSC + n) * 64 + d] = nn[d];
            Mm[(size_t)ch * NSC + n] = m; F[(size_t)ch * NSC + n] = fs; }
    }
}
DEV void ph_ml2(const P& p, int gtid, int nth) {
    float* C = wsf(p, WS_MST); float* N = C + MST_C; float* Mm = N + MST_N; const float* F = Mm + MST_M; float* MP = Mm + 2 * MST_M;
    for (long it = gtid; it < (long)NCHAIN * 65 * 64; it += nth) {
        const int e = (int)(it % (65 * 64)); const int ch = (int)(it / (65 * 64));
        float st = 0.f, mst = 0.f;
        for (int n = 0; n < NSC; ++n) {
            const size_t cn = (size_t)ch * NSC + n;
            const float ml = Mm[cn], fl = F[cn];
            const float mn = fmaxf(fl + mst, ml); const float a = __expf(fl + mst - mn), ee = __expf(ml - mn);
            float* x = e < 64 * 64 ? C + cn * 64 * 64 + e : N + cn * 64 + (e - 64 * 64);
            const float loc = *x; *x = st; st = a * st + ee * loc;
            if (e == 0) MP[cn] = mst;
            mst = mn;
        }
    }
}
DEV void ph_ml3(const P& p, int l, int gtid, int nth) {
    const float* C = wsf(p, WS_MST); const float* N = C + MST_C; const float* MP = N + MST_N + 2 * MST_M; float* O = wsf(p, WS_Y);
    for (long it = gtid; it < (long)NB * CH * NSC * 64; it += nth) {
        const int vc = (int)(it % 64); const int t = (int)((it / 64) % NSC); const int h = (int)((it / (64 * NSC)) % CH); const int b = (int)(it / ((long)64 * NSC * CH));
        for (int dir = 0; dir < 2; ++dir) {
            const int ch = (b * CH + h) * 2 + dir; const int n = sc_chain_index(t, dir);
            int row0, step; sc_rows(b, dir, n, row0, step);
            const size_t cn = (size_t)ch * NSC + n;
            float c[64], nn[64]; float m = MP[cn];
#pragma unroll
            for (int d = 0; d < 64; ++d) { c[d] = C[(cn * 64 + vc) * 64 + d]; nn[d] = N[cn * 64 + d]; }
            for (int i = 0; i < SC; ++i) {
                const int r = row0 + i * step;
                const bf16* ck; float v, li, lf; ml_tok(p, l, r, h, dir, ck, v, li, lf, vc);
                const float mn = fmaxf(lf + m, li); const float fp = __expf(lf + m - mn), ip = __expf(li - mn) * 0.125f; m = mn;
                const bf16* cq = wsb(p, WS_CQK) + (size_t)r * 2 * C_W + h * 64;
                float num = 0.f, den = 0.f;
#pragma unroll
                for (int d0 = 0; d0 < 64; d0 += 8) { float qq[8], k8[8]; ld8(cq + d0, qq); ld8(ck + d0, k8);
#pragma unroll
                    for (int e = 0; e < 8; ++e) { const int d = d0 + e; c[d] = fp * c[d] + ip * v * k8[e]; nn[d] = fp * nn[d] + ip * k8[e]; num += c[d] * qq[e]; den += nn[d] * qq[e]; } }
                const float hv = num / fmaxf(fabsf(den), __expf(-m));
                float* op = O + (size_t)r * OW + B_VW + h * 64 + vc;
                if (dir == 0) *op = hv; else *op += hv;
            }
        }
    }
}
DEV void ph_headln(const P& p, int l, int gtid, int nth, int h0 = 0) {
    const float* O = wsf(p, WS_Y); const bf16* Z = wsb(p, WS_ACT); bf16* Y = wsb(p, WS_U);
    for (long it = gtid; it < (long)M * (BH + CH - h0); it += nth) {
        const int r = (int)(it % M); const int hh = h0 + (int)(it / M);
        const float* o = O + (size_t)r * OW + hh * 64;
        float mu = 0.f;
#pragma unroll
        for (int d = 0; d < 64; ++d) mu += o[d];
        mu *= (1.f / 64.f); float var = 0.f;
#pragma unroll
        for (int d = 0; d < 64; ++d) { const float x = o[d] - mu; var += x * x; }
        const float rs = 1.f / sqrtf(var * (1.f / 64.f) + EPS);
        const bool isb = hh < BH; const int h = isb ? hh : hh - BH;
        const float* g = isb ? prm(p, PRM_GNORM) + l * B_VW + h * 64 : prm(p, PRM_MNORM) + l * C_W + h * 64;
        const bf16* zg = Z + (size_t)r * ZP + (isb ? ZBG : ZCO) + h * 64;
        bf16* y = Y + (size_t)r * DM + A_OUT + hh * 64;
#pragma unroll
        for (int d = 0; d < 64; ++d) { const float gz = bf2f(zg[d]); const float gate = isb ? siluf(gz) : sigmf(gz); y[d] = f2bf(gate * (o[d] - mu) * rs * g[d]); }
    }
}

#ifndef CPU_EMU
namespace pg8 {
#define PG8_LAS __attribute__((address_space(3)))
typedef unsigned short bf16_t;
typedef short bf16x8 __attribute__((ext_vector_type(8)));
typedef float f32x4 __attribute__((ext_vector_type(4)));
typedef unsigned u32x4 __attribute__((ext_vector_type(4)));
constexpr int BM = 256, BK = 64, HALF = 128, HTB = HALF * BK * 2  , STAGE_BYTES = 8 * HTB, NXCD = 8, WGM = 8;

__host__ __device__ __forceinline__ int lds_byte(int r, int c) { const int st = (r >> 4) * 2 + (c >> 5), rr = r & 15, cc = c & 31, ob = rr * 64 + cc * 2; return st * 1024 + (ob ^ (((ob >> 9) & 1) << 5)); }
__host__ __device__ __forceinline__ void stage_rc(int b, int& R, int& C) { const int st = b / 1024, sb = b % 1024, swz = sb ^ (((sb >> 9) & 1) << 5); R = (st >> 1) * 16 + swz / 64; C = (st & 1) * 32 + (swz % 64) / 2; }
__host__ __device__ __forceinline__ int perm32(int rho) { const int n = rho >> 4, i = rho & 15; return 8 * (i >> 2) + 4 * n + (i & 3); }

struct Unit { int pm, pn; };
struct Gemm { const bf16_t* A; const bf16_t* Bt; int M, N, K; int ld = 0; };

struct StaticOrder {
    int nM, nN, nwg, G, c;
    __host__ __device__ void init(int M, int N, int G_, int c_) { nM = M / BM; nN = N / BM; nwg = nM * nN; G = G_; c = c_; }
    __host__ __device__ bool next(int i, Unit& u) const {
        const long L = (long)i * G + c; if (L >= nwg) return false;
        int wgid = (int)L; { const int q = nwg / NXCD, r = nwg % NXCD, xcd = wgid % NXCD, off = wgid / NXCD; wgid = (xcd < r ? xcd * (q + 1) : r * (q + 1) + (xcd - r) * q) + off; }
        const int nig = WGM * nN, gid = wgid / nig, fm = gid * WGM, gsz = (nM - fm) < WGM ? (nM - fm) : WGM;
        u.pm = fm + ((wgid % nig) % gsz); u.pn = (wgid % nig) / gsz; return true;
    }
    __device__ __forceinline__ void a_ready(const Unit&) const {}
    __device__ __forceinline__ void done(const Unit&) const {}
};

__device__ __forceinline__ unsigned cvt_pk_bf16(float lo, float hi) { unsigned r; asm volatile("v_cvt_pk_bf16_f32 %0, %1, %2" : "=v"(r) : "v"(lo), "v"(hi)); return r; }
typedef float f32x2 __attribute__((ext_vector_type(2)));

struct EpiPlain {
    static constexpr bool PERM = true, AFTER_DRAIN = false;
    bf16_t* O; int ldc; const float* bias;
    __device__ __forceinline__ void operator()(const f32x4 (&acc)[2][2][4][2], const Unit& u, int wr, int wc, int fr, int fq) const {
        const int row0 = u.pm * BM + wr * 64 + fr; const int col0 = u.pn * BM + wc * 32 + 8 * fq;
        f32x4 bv[2][2];
#pragma unroll
        for (int bj = 0; bj < 2; ++bj)
#pragma unroll
            for (int n = 0; n < 2; ++n) bv[bj][n] = bias ? *(const f32x4*)(bias + col0 + bj * HALF + 4 * n) : (f32x4){0.f, 0.f, 0.f, 0.f};
#pragma unroll
        for (int ai = 0; ai < 2; ++ai)
#pragma unroll
            for (int m = 0; m < 4; ++m) { bf16_t* rowp = O + (size_t)(row0 + ai * HALF + m * 16) * ldc + col0;
#pragma unroll
                for (int bj = 0; bj < 2; ++bj) { const f32x4 v0 = acc[ai][bj][m][0] + bv[bj][0], v1 = acc[ai][bj][m][1] + bv[bj][1];
                    u32x4 w; w.x = cvt_pk_bf16(v0[0], v0[1]); w.y = cvt_pk_bf16(v0[2], v0[3]); w.z = cvt_pk_bf16(v1[0], v1[1]); w.w = cvt_pk_bf16(v1[2], v1[3]);
                    *(u32x4*)(rowp + bj * HALF) = w; } }
    }
};
struct RoundOrder : StaticOrder { int rnd;
    __host__ __device__ bool next(int i, Unit& u) const { return i == 0 && StaticOrder::next(rnd, u); } };
struct PanelSS {
    float* xbuf; unsigned* cnt;
    __device__ __forceinline__ void run(const f32x4 (&v)[2][2][4][2], const Unit& u, int wr, int wc, int fr, int fq, PG8_LAS unsigned char* lds, int wid, int lane) const {
        PG8_LAS float* Pt = (PG8_LAS float*)lds;
        PG8_LAS float* S = (PG8_LAS float*)(lds + 8192);
#pragma unroll
        for (int ai = 0; ai < 2; ++ai)
#pragma unroll
            for (int m = 0; m < 4; ++m) { float s = 0.f;
#pragma unroll
                for (int bj = 0; bj < 2; ++bj)
#pragma unroll
                    for (int n = 0; n < 2; ++n) { const f32x4 x = v[ai][bj][m][n]; s += (x[0] * x[0] + x[1] * x[1]) + (x[2] * x[2] + x[3] * x[3]); }
                s += __shfl_xor(s, 16); s += __shfl_xor(s, 32);
                if (fq == 0) Pt[(ai * HALF + wr * 64 + m * 16 + fr) * 4 + wc] = s; }
        asm volatile("s_waitcnt lgkmcnt(0)" ::: "memory"); __builtin_amdgcn_s_barrier(); asm volatile("" ::: "memory");
        const int row = wid * 32 + (lane & 31);
        if (lane < 32) { const float t = (Pt[row * 4 + 0] + Pt[row * 4 + 1]) + (Pt[row * 4 + 2] + Pt[row * 4 + 3]);
            __hip_atomic_store((unsigned*)xbuf + ((size_t)(u.pm * BM + row) * 4 + u.pn), __float_as_uint(t), __ATOMIC_RELAXED, __HIP_MEMORY_SCOPE_AGENT); }
        asm volatile("s_waitcnt vmcnt(0)" ::: "memory");
        if (lane == 0) __hip_atomic_fetch_add(cnt + 64 * u.pm, 1u, __ATOMIC_RELAXED, __HIP_MEMORY_SCOPE_AGENT);
        if (wid == 0) { unsigned sp = 0;
            while ((unsigned)__builtin_amdgcn_readfirstlane(__hip_atomic_load(cnt + 64 * u.pm, __ATOMIC_RELAXED, __HIP_MEMORY_SCOPE_AGENT)) < 32u) { __builtin_amdgcn_s_sleep(2); if (++sp > (1u << 20)) break; }
            __builtin_amdgcn_fence(__ATOMIC_ACQUIRE, "agent"); }
        asm volatile("s_waitcnt vmcnt(0) lgkmcnt(0)" ::: "memory"); __builtin_amdgcn_s_barrier(); asm volatile("" ::: "memory");
        if (lane < 32) { const unsigned* slot = (const unsigned*)xbuf + (size_t)(u.pm * BM + row) * 4; float t = 0.f;
#pragma unroll
            for (int k = 0; k < 4; ++k) t += __uint_as_float(__hip_atomic_load(slot + k, __ATOMIC_RELAXED, __HIP_MEMORY_SCOPE_AGENT));
            S[row] = t; }
        asm volatile("s_waitcnt vmcnt(0) lgkmcnt(0)" ::: "memory"); __builtin_amdgcn_s_barrier(); asm volatile("" ::: "memory");
    }
};
struct EpiFinal {
    static constexpr bool PERM = false, AFTER_DRAIN = true;
    const bf16_t* hb; float* out; const float* pmv0; int seq; float eps; PanelSS st;
    __device__ __forceinline__ void fused(f32x4 (&acc)[2][2][4][2], const Unit& u, int wr, int wc, int fr, int fq, PG8_LAS unsigned char* lds, int wid, int lane) const {
        const PG8_LAS float* S = (const PG8_LAS float*)(lds + 8192);
        st.run(acc, u, wr, wc, fr, fq, lds, wid, lane);
        const int col0 = u.pn * BM + wc * 32 + 4 * fq; const float* pm = pmv0 + (size_t)((u.pm * BM) / seq) * 1024;
        f32x4 pv[2][2];
#pragma unroll
        for (int bj = 0; bj < 2; ++bj)
#pragma unroll
            for (int n = 0; n < 2; ++n) pv[bj][n] = *(const f32x4*)(pm + col0 + bj * HALF + n * 16);
#pragma unroll
        for (int ai = 0; ai < 2; ++ai)
#pragma unroll
            for (int m = 0; m < 4; ++m) { const int r = ai * HALF + wr * 64 + m * 16 + fr; const float rs = __builtin_amdgcn_rsqf(S[r] * (1.f / 1024.f) + eps); const size_t off = (size_t)(u.pm * BM + r) * 1024 + col0;
#pragma unroll
                for (int bj = 0; bj < 2; ++bj)
#pragma unroll
                    for (int n = 0; n < 2; ++n) { const f32x2 hw = *(const f32x2*)(hb + off + bj * HALF + n * 16); const unsigned h0 = __float_as_uint(hw.x), h1 = __float_as_uint(hw.y);
                        const f32x4 hv = {__uint_as_float(h0 << 16), __uint_as_float(h0 & 0xffff0000u), __uint_as_float(h1 << 16), __uint_as_float(h1 & 0xffff0000u)};
                        *(f32x4*)(out + off + bj * HALF + n * 16) = hv + pv[bj][n] * acc[ai][bj][m][n] * rs; }
                asm volatile("" ::: "memory"); }
    }
};
struct EpiMid {
    static constexpr bool PERM = true, AFTER_DRAIN = true;
    bf16_t* hb; bf16_t* uo; const float* pmv0; const float* av0; const float* bv0; int seq; float eps; PanelSS st1, st2;
    __device__ __forceinline__ void fused(f32x4 (&acc)[2][2][4][2], const Unit& u, int wr, int wc, int fr, int fq, PG8_LAS unsigned char* lds, int wid, int lane) const {
        const PG8_LAS float* S = (const PG8_LAS float*)(lds + 8192);
        st1.run(acc, u, wr, wc, fr, fq, lds, wid, lane);
        const int col0 = u.pn * BM + wc * 32 + 8 * fq; const size_t vo = (size_t)((u.pm * BM) / seq) * 1024;
        { f32x4 pv[2][2];
#pragma unroll
          for (int bj = 0; bj < 2; ++bj)
#pragma unroll
              for (int n = 0; n < 2; ++n) pv[bj][n] = *(const f32x4*)(pmv0 + vo + col0 + bj * HALF + 4 * n);
#pragma unroll
          for (int ai = 0; ai < 2; ++ai)
#pragma unroll
              for (int m = 0; m < 4; ++m) { const int r = ai * HALF + wr * 64 + m * 16 + fr; const float rs = __builtin_amdgcn_rsqf(S[r] * (1.f / 1024.f) + eps); const size_t off = (size_t)(u.pm * BM + r) * 1024 + col0;
#pragma unroll
                  for (int bj = 0; bj < 2; ++bj) { const u32x4 hw = *(const u32x4*)(hb + off + bj * HALF);
                      const f32x4 h0 = {__uint_as_float(hw.x << 16), __uint_as_float(hw.x & 0xffff0000u), __uint_as_float(hw.y << 16), __uint_as_float(hw.y & 0xffff0000u)};
                      const f32x4 h1 = {__uint_as_float(hw.z << 16), __uint_as_float(hw.z & 0xffff0000u), __uint_as_float(hw.w << 16), __uint_as_float(hw.w & 0xffff0000u)};
                      const f32x4 n0 = h0 + pv[bj][0] * acc[ai][bj][m][0] * rs, n1 = h1 + pv[bj][1] * acc[ai][bj][m][1] * rs;
                      u32x4 w; w.x = pkbf(n0[0], n0[1]); w.y = pkbf(n0[2], n0[3]); w.z = pkbf(n1[0], n1[1]); w.w = pkbf(n1[2], n1[3]);
                      *(u32x4*)(hb + off + bj * HALF) = w;
                      acc[ai][bj][m][0] = (f32x4){__uint_as_float(w.x << 16), __uint_as_float(w.x & 0xffff0000u), __uint_as_float(w.y << 16), __uint_as_float(w.y & 0xffff0000u)};
                      acc[ai][bj][m][1] = (f32x4){__uint_as_float(w.z << 16), __uint_as_float(w.z & 0xffff0000u), __uint_as_float(w.w << 16), __uint_as_float(w.w & 0xffff0000u)}; }
                  asm volatile("" ::: "memory"); } }
        st2.run(acc, u, wr, wc, fr, fq, lds, wid, lane);
        { f32x4 av[2][2], bv[2][2];
#pragma unroll
          for (int bj = 0; bj < 2; ++bj)
#pragma unroll
              for (int n = 0; n < 2; ++n) { av[bj][n] = *(const f32x4*)(av0 + vo + col0 + bj * HALF + 4 * n); bv[bj][n] = *(const f32x4*)(bv0 + vo + col0 + bj * HALF + 4 * n); }
#pragma unroll
          for (int ai = 0; ai < 2; ++ai)
#pragma unroll
              for (int m = 0; m < 4; ++m) { const int r = ai * HALF + wr * 64 + m * 16 + fr; const float rs = __builtin_amdgcn_rsqf(S[r] * (1.f / 1024.f) + eps); const size_t off = (size_t)(u.pm * BM + r) * 1024 + col0;
#pragma unroll
                  for (int bj = 0; bj < 2; ++bj) { const f32x4 o0 = acc[ai][bj][m][0] * rs * av[bj][0] + bv[bj][0], o1 = acc[ai][bj][m][1] * rs * av[bj][1] + bv[bj][1];
                      u32x4 w; w.x = pkbf(o0[0], o0[1]); w.y = pkbf(o0[2], o0[3]); w.z = pkbf(o1[0], o1[1]); w.w = pkbf(o1[2], o1[3]);
                      *(u32x4*)(uo + off + bj * HALF) = w; } } }
    }
};
__device__ __forceinline__ float silu_mul(float g, float u) { return g * __builtin_amdgcn_rcpf(1.f + __builtin_amdgcn_exp2f(-g)) * u; }
struct EpiSwiglu {
    static constexpr bool PERM = true, AFTER_DRAIN = false;
    bf16_t* O; int ldc;
    __device__ __forceinline__ void operator()(const f32x4 (&acc)[2][2][4][2], const Unit& u, int wr, int wc, int fr, int fq) const {
        const int row0 = u.pm * BM + wr * 64 + fr; const int col0 = u.pn * HALF + wc * 32 + 8 * fq;
#pragma unroll
        for (int ai = 0; ai < 2; ++ai)
#pragma unroll
            for (int m = 0; m < 4; ++m) { bf16_t* rowp = O + (size_t)(row0 + ai * HALF + m * 16) * ldc + col0;
                const f32x4 g0 = acc[ai][0][m][0], g1 = acc[ai][0][m][1], u0 = acc[ai][1][m][0], u1 = acc[ai][1][m][1];
                u32x4 w; w.x = cvt_pk_bf16(silu_mul(g0[0], u0[0]), silu_mul(g0[1], u0[1])); w.y = cvt_pk_bf16(silu_mul(g0[2], u0[2]), silu_mul(g0[3], u0[3]));
                w.z = cvt_pk_bf16(silu_mul(g1[0], u1[0]), silu_mul(g1[1], u1[1])); w.w = cvt_pk_bf16(silu_mul(g1[2], u1[2]), silu_mul(g1[3], u1[3]));
                *(u32x4*)rowp = w; }
    }
};
template <class Epi, class Sched, bool ALIGN_EPI = false, bool SP2 = false>
__device__ __forceinline__ void gemm_phase(PG8_LAS unsigned char* lds, const Gemm g, const Sched& S, const Epi& E) {
    int tid_ = threadIdx.x; asm volatile("" : "+v"(tid_));
    const int tid = tid_, wid = __builtin_amdgcn_readfirstlane(tid >> 6), lane = tid & 63, wr = wid >> 2, wc = wid & 3, fr = lane & 15, fq = lane >> 4;
    const int K = g.K, nt = K / BK, LD = g.ld ? g.ld : g.K;
    unsigned voffA[2], voffB[2];
#pragma unroll
    for (int i = 0; i < 2; ++i) { int R, C; stage_rc(tid * 16 + i * 8192, R, C); const int Rb = Epi::PERM ? ((R & ~31) + perm32(R & 31)) : R;
        voffA[i] = (unsigned)(R * LD + C) * 2u; voffB[i] = (unsigned)(Rb * LD + C) * 2u; }
    const size_t kstep = (size_t)(BK * 2);
    const size_t hstep = (size_t)HALF * LD * 2;
    const size_t tstep = 2 * hstep;
    const unsigned ldsw = (unsigned)wid * 1024u;
    const int aoff = lds_byte(wr * 64 + fr, fq * 8), boff = lds_byte(wc * 32 + fr, fq * 8);
#define PG8_SA(b, h) (((b) * 2 + (h)) * HTB)
#define PG8_SB(b, h) ((4 + (b) * 2 + (h)) * HTB)
#define PG8_STAGE(bufoff, gbase, voff) do { _Pragma("unroll") for (int _i = 0; _i < 2; ++_i) \
        __builtin_amdgcn_global_load_lds((const unsigned*)((const char*)(gbase) + (voff)[_i]), (PG8_LAS unsigned*)(lds + (bufoff) + ldsw + _i * 8192), 16, 0, 0); } while (0)
#define PG8_LDA(dst, b, h) do { _Pragma("unroll") for (int m = 0; m < 4; ++m) _Pragma("unroll") for (int k = 0; k < 2; ++k) dst[m][k] = *(const PG8_LAS bf16x8*)(lds + PG8_SA(b, h) + aoff + m * 2048 + k * 1024); } while (0)
#define PG8_LDB(dst, b, h) do { _Pragma("unroll") for (int n = 0; n < 2; ++n) _Pragma("unroll") for (int k = 0; k < 2; ++k) dst[n][k] = *(const PG8_LAS bf16x8*)(lds + PG8_SB(b, h) + boff + n * 2048 + k * 1024); } while (0)
#define PG8_MMA(ai, bj, At, Bt) do { __builtin_amdgcn_s_setprio(1); _Pragma("unroll") for (int m = 0; m < 4; ++m) _Pragma("unroll") for (int n = 0; n < 2; ++n) _Pragma("unroll") for (int k = 0; k < 2; ++k) \
        acc[ai][bj][m][n] = __builtin_amdgcn_mfma_f32_16x16x32_bf16(Bt[n][k], At[m][k], acc[ai][bj][m][n], 0, 0, 0); __builtin_amdgcn_s_setprio(0); } while (0)
#define PG8_WAIT_V(n) asm volatile("s_waitcnt vmcnt(" #n ")" ::: "memory")
#define PG8_WAIT_L(n) asm volatile("s_waitcnt lgkmcnt(" #n ")" ::: "memory")
#define PG8_BAR __builtin_amdgcn_s_barrier()
#define PG8_SCHED __builtin_amdgcn_sched_barrier(0)
    Unit cur, nxt; int ui = 0;
    if (!S.next(0, cur)) return;
    f32x4 acc[2][2][4][2];
#pragma unroll
    for (int a = 0; a < 2; ++a)
#pragma unroll
        for (int b = 0; b < 2; ++b)
#pragma unroll
            for (int m = 0; m < 4; ++m)
#pragma unroll
                for (int n = 0; n < 2; ++n) acc[a][b][m][n] = (f32x4){0.f, 0.f, 0.f, 0.f};
    bf16x8 At[4][2], B0[2][2], B1[2][2];
    const char* cA = (const char*)g.A + (size_t)cur.pm * tstep; const char* cB = (const char*)g.Bt + (size_t)cur.pn * tstep;
    S.a_ready(cur);
    if constexpr (SP2) {
        PG8_STAGE(PG8_SB(0, 0), cB, voffB); PG8_STAGE(PG8_SB(0, 1), cB + hstep, voffB); PG8_STAGE(PG8_SA(0, 0), cA, voffA); PG8_STAGE(PG8_SA(0, 1), cA + hstep, voffA);
        if (wr == 1) PG8_BAR;
        PG8_WAIT_V(2); PG8_BAR;
        PG8_STAGE(PG8_SB(1, 0), cB + kstep, voffB); PG8_STAGE(PG8_SA(1, 0), cA + kstep, voffA); PG8_STAGE(PG8_SB(1, 1), cB + hstep + kstep, voffB);
        PG8_WAIT_V(6); PG8_BAR;
    } else {
        PG8_STAGE(PG8_SB(0, 0), cB, voffB); PG8_STAGE(PG8_SA(0, 0), cA, voffA); PG8_STAGE(PG8_SB(0, 1), cB + hstep, voffB); PG8_STAGE(PG8_SA(0, 1), cA + hstep, voffA);
        if (wr == 1) PG8_BAR;
        PG8_WAIT_V(4); PG8_BAR;
        PG8_STAGE(PG8_SB(1, 0), cB + kstep, voffB); PG8_STAGE(PG8_SA(1, 0), cA + kstep, voffA); PG8_STAGE(PG8_SB(1, 1), cB + hstep + kstep, voffB);
        PG8_WAIT_V(6); PG8_BAR;
    }
    for (;;) {
        const bool has_next = S.next(ui + 1, nxt);
        const char* nA = has_next ? (const char*)g.A + (size_t)nxt.pm * tstep : cA; const char* nB = has_next ? (const char*)g.Bt + (size_t)nxt.pn * tstep : cB;
        for (int t = 0; t < nt; t += 2) {
            const bool last = (t == nt - 2);
            const char* a1 = cA + (size_t)(t + 1) * kstep;
            const char* a2 = last ? nA : cA + (size_t)(t + 2) * kstep; const char* b2 = last ? nB : cB + (size_t)(t + 2) * kstep;
            const char* a3 = a2 + kstep; const char* b3 = b2 + kstep;
            if (last && has_next) S.a_ready(nxt);
            if constexpr (SP2) {
            PG8_LDB(B0, 0, 0); PG8_LDB(B1, 0, 1); PG8_SCHED; PG8_LDA(At, 0, 0); PG8_STAGE(PG8_SA(1, 1), a1 + hstep, voffA);
            PG8_WAIT_V(8); PG8_WAIT_L(0); PG8_BAR; PG8_MMA(0, 0, At, B0); PG8_MMA(0, 1, At, B1); PG8_BAR; PG8_SCHED;
            PG8_LDA(At, 0, 1); PG8_STAGE(PG8_SB(0, 0), b2, voffB); PG8_STAGE(PG8_SB(0, 1), b2 + hstep, voffB); PG8_STAGE(PG8_SA(0, 0), a2, voffA);
            PG8_WAIT_V(8); PG8_WAIT_L(0); PG8_BAR; PG8_MMA(1, 0, At, B0); PG8_MMA(1, 1, At, B1); PG8_BAR; PG8_SCHED;
            PG8_LDB(B0, 1, 0); PG8_LDB(B1, 1, 1); PG8_SCHED; PG8_LDA(At, 1, 0); PG8_STAGE(PG8_SA(0, 1), a2 + hstep, voffA);
            PG8_WAIT_V(8); PG8_WAIT_L(0); PG8_BAR; PG8_MMA(0, 0, At, B0); PG8_MMA(0, 1, At, B1); PG8_BAR; PG8_SCHED;
            PG8_LDA(At, 1, 1); PG8_STAGE(PG8_SB(1, 0), b3, voffB); PG8_STAGE(PG8_SB(1, 1), b3 + hstep, voffB); PG8_STAGE(PG8_SA(1, 0), a3, voffA);
            PG8_WAIT_V(8); PG8_WAIT_L(0); PG8_BAR; PG8_MMA(1, 0, At, B0); PG8_MMA(1, 1, At, B1); PG8_BAR; PG8_SCHED;
            } else {
            PG8_LDB(B0, 0, 0); PG8_SCHED; PG8_LDA(At, 0, 0); PG8_STAGE(PG8_SA(1, 1), a1 + hstep, voffA);
            PG8_WAIT_L(8); PG8_BAR; PG8_WAIT_L(0); PG8_MMA(0, 0, At, B0); PG8_BAR; PG8_SCHED;
            PG8_LDB(B1, 0, 1); PG8_STAGE(PG8_SB(0, 0), b2, voffB);
            PG8_BAR; PG8_WAIT_L(0); PG8_MMA(0, 1, At, B1); PG8_BAR;
            PG8_LDA(At, 0, 1); PG8_STAGE(PG8_SA(0, 0), a2, voffA);
            PG8_BAR; PG8_WAIT_L(0); PG8_MMA(1, 0, At, B0); PG8_BAR; PG8_SCHED;
            PG8_STAGE(PG8_SB(0, 1), b2 + hstep, voffB);
            PG8_WAIT_V(6); PG8_BAR; PG8_MMA(1, 1, At, B1); PG8_BAR;
            PG8_LDB(B0, 1, 0); PG8_SCHED; PG8_LDA(At, 1, 0); PG8_STAGE(PG8_SA(0, 1), a2 + hstep, voffA);
            PG8_WAIT_L(8); PG8_BAR; PG8_WAIT_L(0); PG8_MMA(0, 0, At, B0); PG8_BAR; PG8_SCHED;
            PG8_LDB(B1, 1, 1); PG8_STAGE(PG8_SB(1, 0), b3, voffB);
            PG8_BAR; PG8_WAIT_L(0); PG8_MMA(0, 1, At, B1); PG8_BAR;
            PG8_LDA(At, 1, 1); PG8_STAGE(PG8_SA(1, 0), a3, voffA);
            PG8_BAR; PG8_WAIT_L(0); PG8_MMA(1, 0, At, B0); PG8_BAR; PG8_SCHED;
            PG8_STAGE(PG8_SB(1, 1), b3 + hstep, voffB);
            PG8_WAIT_V(6); PG8_BAR; PG8_MMA(1, 1, At, B1); PG8_BAR;
            }
        }
        if constexpr (ALIGN_EPI) { if (wr == 0) PG8_BAR; }
        if constexpr (!Epi::AFTER_DRAIN) { E(acc, cur, wr, wc, fr, fq); S.done(cur); }
        if (!has_next) break;
#pragma unroll
        for (int a = 0; a < 2; ++a)
#pragma unroll
            for (int b = 0; b < 2; ++b)
#pragma unroll
                for (int m = 0; m < 4; ++m)
#pragma unroll
                    for (int n = 0; n < 2; ++n) acc[a][b][m][n] = (f32x4){0.f, 0.f, 0.f, 0.f};
        cur = nxt; cA = nA; cB = nB; ++ui;
        if constexpr (ALIGN_EPI) { if (wr == 1) PG8_BAR; }
    }
    PG8_WAIT_V(0);
    if constexpr (!ALIGN_EPI) { if (wr == 0) PG8_BAR; }
    PG8_BAR;
    if constexpr (Epi::AFTER_DRAIN) { E.fused(acc, cur, wr, wc, fr, fq, lds, wid, lane); S.done(cur); }
#undef PG8_SA
#undef PG8_SB
#undef PG8_STAGE
#undef PG8_LDA
#undef PG8_LDB
#undef PG8_MMA
#undef PG8_WAIT_V
#undef PG8_WAIT_L
#undef PG8_BAR
#undef PG8_SCHED
}
}

#define XB_TMO      128
#define XB_XCNT(j)  (256  + 64 * (j))
#define XB_XSUB(j)  (1280 + 64 * (j))
#define XB_XGEN(j)  (2304 + 64 * (j))
#define XB_TOP      3328
#define XB_TOPGEN   3392
#define XCD_BAR_WORDS 3456
#define XB_SPIN_CAP (1u << 18)
#define LAS __attribute__((address_space(3)))

__device__ __forceinline__ unsigned xb_ld(unsigned* p)              { return __hip_atomic_load(p, __ATOMIC_RELAXED, __HIP_MEMORY_SCOPE_AGENT); }
__device__ __forceinline__ unsigned xb_add(unsigned* p, unsigned v) { return __hip_atomic_fetch_add(p, v, __ATOMIC_RELAXED, __HIP_MEMORY_SCOPE_AGENT); }
__device__ __forceinline__ unsigned xb_xcc_id() { return (unsigned)__builtin_amdgcn_s_getreg((3 << 11) | 20) & 0xFu; }
#define XB_SPIN(cond, bar) do { unsigned _sp = 0; while (cond) { __builtin_amdgcn_s_sleep(1); \
    if ((++_sp & 255u) == 0u) { if (xb_ld(&(bar)[XB_TMO])) break; if (_sp > XB_SPIN_CAP) { atomicAdd(&(bar)[XB_TMO], 1u); break; } } } } while (0)

struct XcdBarrier {
    unsigned* bar; unsigned x;
    volatile LAS unsigned* st;
};

__device__ __forceinline__ XcdBarrier xcd_barrier_post(unsigned* bar, volatile LAS unsigned* st) {
    XcdBarrier b; b.bar = bar; b.x = xb_xcc_id(); b.st = st;
    if (threadIdx.x == 0) (void)xb_add(&bar[XB_XCNT(b.x)], 1u);
    return b;
}
__device__ __forceinline__ void xcd_barrier_complete(unsigned* bar, unsigned x, unsigned& nloc, unsigned& nx) {
    const unsigned G = gridDim.x * gridDim.y * gridDim.z;
    unsigned sum, cnt, mine, sp = 0u;
    for (;;) {
        sum = 0u; cnt = 0u; mine = 0u;
#pragma unroll
        for (unsigned j = 0; j < 16; ++j) { const unsigned c = xb_ld(&bar[XB_XCNT(j)]); sum += c; cnt += (c > 0u) ? 1u : 0u; mine = (j == x) ? c : mine; }
        if (sum == G) break;
        __builtin_amdgcn_s_sleep(1);
        if ((++sp & 255u) == 0u) { if (xb_ld(&bar[XB_TMO])) break; if (sp > XB_SPIN_CAP) { atomicAdd(&bar[XB_TMO], 1u); break; } }
    }
    nloc = mine > 0u ? mine : 1u; nx = cnt > 0u ? cnt : 1u;
}

__device__ __forceinline__ void xcd_barrier(const XcdBarrier& b) {
    asm volatile("s_waitcnt vmcnt(0)" ::: "memory");
    __syncthreads();
    if (threadIdx.x == 0) {
        unsigned* bar = b.bar;
        __builtin_amdgcn_s_waitcnt(0);
        unsigned nloc = b.st[0], nx = b.st[1];
        if (nloc == 0u) { xcd_barrier_complete(bar, b.x, nloc, nx); b.st[0] = nloc; b.st[1] = nx; }
        const unsigned old = xb_add(&bar[XB_XSUB(b.x)], 1u);
        const unsigned gen = old / nloc;
        if (old + 1u == (gen + 1u) * nloc) {
            __builtin_amdgcn_fence(__ATOMIC_RELEASE, "agent");
            asm volatile("s_waitcnt vmcnt(0)" ::: "memory");
            const unsigned og = xb_add(&bar[XB_TOP], 1u);
            const unsigned tg = og / nx;
            if (og + 1u == (tg + 1u) * nx) xb_add(&bar[XB_TOPGEN], 1u);
            else XB_SPIN(xb_ld(&bar[XB_TOPGEN]) == tg, bar);
            __builtin_amdgcn_fence(__ATOMIC_ACQUIRE, "agent");
            xb_add(&bar[XB_XGEN(b.x)], 1u);
            asm volatile("s_waitcnt vmcnt(0)" ::: "memory");
        } else {
            XB_SPIN(xb_ld(&bar[XB_XGEN(b.x)]) == gen, bar);
            __builtin_amdgcn_fence(__ATOMIC_ACQUIRE, "agent");
            asm volatile("s_waitcnt vmcnt(0)" ::: "memory");
        }
    }
    __syncthreads();
}

#define GAS __attribute__((address_space(1)))
typedef float f32x4 __attribute__((ext_vector_type(4)));
typedef unsigned v4u __attribute__((ext_vector_type(4)));
typedef unsigned v2u __attribute__((ext_vector_type(2)));
constexpr int NWAVES = 8, NTHREADS = NWAVES * 64;
constexpr int RING_BYTES = 131072, LDS_BYTES = 147456, MISC_OFF = LDS_BYTES - 512;
constexpr int CW_BAR = 4096;
static_assert((CW_BAR + XCD_BAR_WORDS) * 4 <= (int)CTL_BYTES, "ctl");
constexpr int CW_PAN = 16384;
constexpr int CW_SUB = 8192, NSUBWG = 64;
__device__ __forceinline__ void sub_barrier(unsigned* cnt, unsigned target) {
    asm volatile("s_waitcnt vmcnt(0)" ::: "memory");
    __syncthreads();
    if (threadIdx.x == 0) {
        __builtin_amdgcn_fence(__ATOMIC_RELEASE, "agent"); asm volatile("s_waitcnt vmcnt(0)" ::: "memory");
        (void)xb_add(cnt, 1u);
        unsigned sp = 0; while (xb_ld(cnt) < target) { __builtin_amdgcn_s_sleep(1); if (++sp > XB_SPIN_CAP) break; }
        __builtin_amdgcn_fence(__ATOMIC_ACQUIRE, "agent"); asm volatile("s_waitcnt vmcnt(0)" ::: "memory");
    }
    __syncthreads();
}

template <int CTRL, int RM> __device__ __forceinline__ float dppf0(float src) { return __int_as_float(__builtin_amdgcn_update_dpp(0, __float_as_int(src), CTRL, RM, 0xf, false)); }
__device__ __forceinline__ float gla_scan_add(float v) {
    v += dppf0<0x111, 0xf>(v); v += dppf0<0x112, 0xf>(v); v += dppf0<0x114, 0xf>(v); v += dppf0<0x118, 0xf>(v); v += dppf0<0x142, 0xa>(v); v += dppf0<0x143, 0xc>(v); return v; }
__device__ __forceinline__ float wave_sum(float v) {
#pragma unroll
    for (int o = 1; o < 64; o <<= 1) v += __shfl_xor(v, o);
    return v;
}
__device__ __forceinline__ unsigned pk2(float lo, float hi) { return pkbf(lo, hi); }

__device__ __forceinline__ void wt_item(const float* W, int ldw, int lim, int col0, int k0, bf16* WT, int K, int n0, LAS float* scr, int lane, float scl = 1.f) {
    const int cc = col0 + (lane & 31); const bool ok = cc < lim;
    float wv_[32];
#pragma unroll
    for (int i = 0; i < 32; ++i) { const int kk = 2 * i + (lane >> 5); wv_[i] = ok ? W[(size_t)(k0 + kk) * ldw + cc] : 0.f; }
#pragma unroll
    for (int i = 0; i < 32; ++i) { const int kk = 2 * i + (lane >> 5); scr[kk * 33 + (lane & 31)] = wv_[i] * scl; }
    asm volatile("s_waitcnt lgkmcnt(0)" ::: "memory");
    const int c = lane & 7;
#pragma unroll
    for (int j = 0; j < 4; ++j) { const int n = (lane >> 3) + 8 * j; const LAS float* s = scr + (8 * c) * 33 + n;
        v4u o; o.x = pk2(s[0 * 33], s[1 * 33]); o.y = pk2(s[2 * 33], s[3 * 33]); o.z = pk2(s[4 * 33], s[5 * 33]); o.w = pk2(s[6 * 33], s[7 * 33]);
        *(GAS v4u*)(WT + (size_t)(n0 + n) * K + k0 + 8 * c) = o; }
    asm volatile("s_waitcnt lgkmcnt(0)" ::: "memory");
}
constexpr int WCONV_ITEMS = 2 * ((DM / 64) * (2 * DFF / 32)) + 2 * ((DFF / 64) * (DM / 32)) + (DM / 64) * (ZP / 32) + (DM / 64) * (DM / 32);
__device__ __forceinline__ void ph_wconv(const P& p, int l, LAS unsigned char* lds, int gw, int ngw, int wave, int lane, int i0 = 0, int i1 = WCONV_ITEMS) {
    LAS float* scr = (LAS float*)(lds + wave * 16384);
    constexpr int I_GU = (DM / 64) * (2 * DFF / 32), I_D = (DFF / 64) * (DM / 32), I_IN = (DM / 64) * (ZP / 32), I_OUT = (DM / 64) * (DM / 32);
    constexpr int PER_L = 2 * I_GU + 2 * I_D + I_IN + I_OUT;
    static_assert(PER_L == WCONV_ITEMS, "items");
    for (int it = i0 + gw; it < i1; it += ngw) {
        int r = it;
        if (r < 2 * I_GU) { const int sub = r / I_GU; r %= I_GU; const int nblk = 2 * DFF / 32, kb = r / nblk, nb = r % nblk, n0 = nb * 32; const int tile = n0 / 256, w = n0 % 256;
            const float* src = p.in[w < 128 ? (sub ? I_F2G : I_F1G) : (sub ? I_F2U : I_F1U)] + (size_t)l * DM * DFF;
            wt_item(src, DFF, DFF, tile * 128 + (w & 127), kb * 64, wl(p, l, sub ? WL_GU2 : WL_GU1), DM, n0, scr, lane, w < 128 ? 1.4426950408889634f : 0.6931471805599453f); continue; }
        r -= 2 * I_GU;
        if (r < 2 * I_D) { const int sub = r / I_D; r %= I_D; const int nblk = DM / 32, kb = r / nblk, nb = r % nblk;
            wt_item(p.in[sub ? I_F2D : I_F1D] + (size_t)l * DFF * DM, DM, DM, nb * 32, kb * 64, wl(p, l, sub ? WL_D2 : WL_D1), DFF, nb * 32, scr, lane); continue; }
        r -= 2 * I_D;
        if (r < I_IN) { const int nblk = ZP / 32, kb = r / nblk, nb = r % nblk;
            wt_item(p.in[I_WIN] + (size_t)l * DM * INW, INW, INW, nb * 32, kb * 64, wl(p, l, WL_IN), DM, nb * 32, scr, lane); continue; }
        r -= I_IN;
        { const int nblk = DM / 32, kb = r / nblk, nb = r % nblk;
            wt_item(p.in[I_WOUT] + (size_t)l * DM * DM, DM, DM, nb * 32, kb * 64, wl(p, l, WL_OUT), DM, nb * 32, scr, lane); }
    }
}
__device__ __forceinline__ void ph_modpart_gpu(const P& p, LAS unsigned char* lds, int tid, int gtid, int nth) {
    LAS float* sc = (LAS float*)lds;
    for (int i = tid; i < NMOD * DM; i += NTHREADS) { const int b = i / DM, k = i % DM; sc[i] = siluf(b < NB ? p.in[I_C][b * DM + k] : p.in[I_CCTX][k]); }
    __syncthreads();
    constexpr int KS = DM / KSPLIT;
    for (long it = gtid; it < (long)KSPLIT * DEPTH * 9 * DM; it += nth) {
        const int col = (int)(it % (9 * DM)); const int l = (int)((it / (9 * DM)) % DEPTH); const int ks = (int)(it / ((long)9 * DM * DEPTH));
        const float* w = p.in[I_ADAW] + (size_t)l * DM * 9 * DM + col;
        float acc[NMOD];
#pragma unroll
        for (int b = 0; b < NMOD; ++b) acc[b] = 0.f;
        for (int k0 = ks * KS; k0 < (ks + 1) * KS; k0 += 8) { float wv[8];
#pragma unroll
            for (int j = 0; j < 8; ++j) wv[j] = w[(size_t)(k0 + j) * 9 * DM];
#pragma unroll
            for (int j = 0; j < 8; ++j)
#pragma unroll
                for (int b = 0; b < NMOD; ++b) acc[b] += sc[b * DM + k0 + j] * wv[j]; }
#pragma unroll
        for (int b = 0; b < NMOD; ++b) wsf(p, WS_MODP)[(((size_t)ks * DEPTH + l) * NMOD + b) * 9 * DM + col] = acc[b];
    }
    __syncthreads();
}
__device__ __forceinline__ f32x4 up4(v2u w) { return (f32x4){__uint_as_float(w.x << 16), __uint_as_float(w.x & 0xffff0000u), __uint_as_float(w.y << 16), __uint_as_float(w.y & 0xffff0000u)}; }
__device__ __forceinline__ float sq4(f32x4 v) { return (v.x * v.x + v.y * v.y) + (v.z * v.z + v.w * v.w); }
__device__ __forceinline__ f32x4 lo4(v4u w) { return up4((v2u){w.x, w.y}); }
__device__ __forceinline__ f32x4 hi4(v4u w) { return up4((v2u){w.z, w.w}); }
template <bool UPD, bool MK, bool Y2 = false> __device__ __forceinline__ void ph_thin(const P& p, int lu, int su, int lm, int sm, int gw, int ngw, int lane, int mrows = M, int rbase = 0) {
    constexpr int NV = DM / 512, RB = 6;
    const int rpw = (mrows - rbase + ngw - 1) / ngw, rbeg = rbase + gw * rpw, rend = (rbeg + rpw < mrows) ? rbeg + rpw : mrows;
    for (int r0 = rbeg; r0 < rend; r0 += RB) {
        v4u hp[RB][NV], yp[RB][NV]; float ss[RB];
#pragma unroll
        for (int q = 0; q < RB; ++q) { const int r = (r0 + q < rend) ? r0 + q : rend - 1;
            const v4u* hr = (const v4u*)(wsb(p, WS_HB) + (size_t)r * DM); const v4u* yr = (const v4u*)(wsb(p, WS_Y) + (size_t)r * DM);
#pragma unroll
            for (int j = 0; j < NV; ++j) { hp[q][j] = hr[lane + 64 * j]; if (UPD) yp[q][j] = yr[lane + 64 * j]; } }
        if (UPD && Y2) {
            v4u yq[RB][NV];
#pragma unroll
            for (int q = 0; q < RB; ++q) { const int r = (r0 + q < rend) ? r0 + q : rend - 1; const v4u* yr2 = (const v4u*)(wsb(p, WS_HC) + (size_t)(r - ML) * DM);
#pragma unroll
                for (int j = 0; j < NV; ++j) yq[q][j] = yr2[lane + 64 * j]; }
#pragma unroll
            for (int q = 0; q < RB; ++q)
#pragma unroll
                for (int j = 0; j < NV; ++j) { const f32x4 a0 = lo4(yp[q][j]) + lo4(yq[q][j]), a1 = hi4(yp[q][j]) + hi4(yq[q][j]);
                    v4u w; w.x = pk2(a0.x, a0.y); w.y = pk2(a0.z, a0.w); w.z = pk2(a1.x, a1.y); w.w = pk2(a1.z, a1.w); yp[q][j] = w; } }
        if (UPD) {
#pragma unroll
            for (int q = 0; q < RB; ++q) { ss[q] = 0.f;
#pragma unroll
                for (int j = 0; j < NV; ++j) ss[q] += sq4(lo4(yp[q][j])) + sq4(hi4(yp[q][j])); }
#pragma unroll
            for (int q = 0; q < RB; ++q) ss[q] = __int_as_float(__builtin_amdgcn_readlane(__float_as_int(gla_scan_add(ss[q])), 63));
#pragma unroll
            for (int q = 0; q < RB; ++q) { const int r = (r0 + q < rend) ? r0 + q : rend - 1; const bool ok = r0 + q < rend;
                const float rs = __builtin_amdgcn_rsqf(ss[q] * (1.f / DM) + EPS); const f32x4* pm = (const f32x4*)vecp(p, lu, su, 2, modidx(r));
#pragma unroll
                for (int j = 0; j < NV; ++j) { const int c4 = 2 * (lane + 64 * j);
                    const f32x4 h0 = lo4(hp[q][j]) + pm[c4] * lo4(yp[q][j]) * rs, h1 = hi4(hp[q][j]) + pm[c4 + 1] * hi4(yp[q][j]) * rs;
                    if (MK) { v4u w; w.x = pk2(h0.x, h0.y); w.y = pk2(h0.z, h0.w); w.z = pk2(h1.x, h1.y); w.w = pk2(h1.z, h1.w); hp[q][j] = w; if (ok) ((v4u*)(wsb(p, WS_HB) + (size_t)r * DM))[lane + 64 * j] = w; }
                    else if (ok) { f32x4* op = (f32x4*)(p.out + (size_t)r * DM); op[c4] = h0; op[c4 + 1] = h1; } } }
        }
        if (MK) {
#pragma unroll
            for (int q = 0; q < RB; ++q) { ss[q] = 0.f;
#pragma unroll
                for (int j = 0; j < NV; ++j) ss[q] += sq4(lo4(hp[q][j])) + sq4(hi4(hp[q][j])); }
#pragma unroll
            for (int q = 0; q < RB; ++q) ss[q] = __int_as_float(__builtin_amdgcn_readlane(__float_as_int(gla_scan_add(ss[q])), 63));
#pragma unroll
            for (int q = 0; q < RB; ++q) { const int r = r0 + q; if (r < rend) { const int bi = modidx(r);
                const float rs = __builtin_amdgcn_rsqf(ss[q] * (1.f / DM) + EPS);
                const f32x4* a = (const f32x4*)vecp(p, lm, sm, 0, bi); const f32x4* b = (const f32x4*)vecp(p, lm, sm, 1, bi); v4u* ur = (v4u*)(wsb(p, WS_U) + (size_t)r * DM);
#pragma unroll
                for (int j = 0; j < NV; ++j) { const int c4 = 2 * (lane + 64 * j); const f32x4 o0 = lo4(hp[q][j]) * rs * a[c4] + b[c4], o1 = hi4(hp[q][j]) * rs * a[c4 + 1] + b[c4 + 1];
                    v4u w; w.x = pk2(o0.x, o0.y); w.y = pk2(o0.z, o0.w); w.z = pk2(o1.x, o1.y); w.w = pk2(o1.z, o1.w); ur[lane + 64 * j] = w; } } }
        }
    }
}


namespace att {
typedef short bf16x8 __attribute__((ext_vector_type(8)));
typedef short s16x4 __attribute__((ext_vector_type(4)));
typedef float f32x16 __attribute__((ext_vector_type(16)));
constexpr int KBUF = 0, VBUF = 32768, SLOT = 8192;
constexpr float C2 = 0.125f * 1.4426950408889634f;
__device__ __forceinline__ int crow(int r, int hi) { return (r & 3) + 8 * (r >> 2) + 4 * hi; }
typedef float f32x2_t __attribute__((ext_vector_type(2))); typedef __bf16 bf16x2_t __attribute__((ext_vector_type(2)));
__device__ __forceinline__ unsigned cvtpk(float lo, float hi) { const f32x2_t v = {lo, hi}; const bf16x2_t b = __builtin_convertvector(v, bf16x2_t); return __builtin_bit_cast(unsigned, b); }

__device__ __forceinline__ float max3f(float a, float b, float c) { float r; asm("v_max3_f32 %0, %1, %2, %3" : "=v"(r) : "v"(a), "v"(b), "v"(c)); return r; }
__device__ __forceinline__ float max32(float x) { const auto r = __builtin_amdgcn_permlane32_swap(__float_as_uint(x), __float_as_uint(x), false, false); return fmaxf(__uint_as_float(r[0]), __uint_as_float(r[1])); }
__device__ __forceinline__ float sum32(float x) { const auto r = __builtin_amdgcn_permlane32_swap(__float_as_uint(x), __float_as_uint(x), false, false); return __uint_as_float(r[0]) + __uint_as_float(r[1]); }
__device__ __forceinline__ s16x4 vtr(const LAS unsigned char* p) { return __builtin_bit_cast(s16x4, __builtin_amdgcn_ds_read_tr16_b64_v4i16((LAS s16x4*)p)); }

__device__ __forceinline__ void unit(const P& p, LAS unsigned char* lds, int l, int b, int g, int qrow0, int qpos0, int kw0, int ntw, int tid) {
    const int lane = tid & 63, r32 = lane & 31, hi = lane >> 5; const int wave = __builtin_amdgcn_readfirstlane(tid >> 6);
    const int hq = g * AGRP + (wave & 3), qh = wave >> 2;
    const bf16* Z = wsb(p, WS_ACT);
    const int nt = ntw + CTXL / 64;
    const bf16* ksrc = Z + (size_t)lane * ZP + ZK + g * 64 + wave * 8;
    const bf16* vsrc = Z + (size_t)(16 * (wave & 3) + (lane >> 2)) * ZP + ZV + g * 64 + (wave >> 2) * 32 + (lane & 3) * 8;
#define ATT_DMA(t, slot) do { const int kr_ = (t) < ntw ? b * SEQ + kw0 + 64 * (t) : ML + b * CTXL + 64 * ((t) - ntw); \
        __builtin_amdgcn_global_load_lds((const unsigned*)(ksrc + (size_t)kr_ * ZP), (LAS unsigned*)(lds + KBUF + (slot) * SLOT + wave * 1024), 16, 0, 0); \
        __builtin_amdgcn_global_load_lds((const unsigned*)(vsrc + (size_t)kr_ * ZP), (LAS unsigned*)(lds + VBUF + (slot) * SLOT + wave * 1024), 16, 0, 0); } while (0)
#define ATT_DMA2(tp, ps) do { ATT_DMA(2 * (tp), 2 * (ps)); if (2 * (tp) + 1 < nt) ATT_DMA(2 * (tp) + 1, 2 * (ps) + 1); } while (0)
    ATT_DMA2(0, 0);
    bf16x8 qf[1][4];
    { const int j = 0; const bf16* qp = Z + (size_t)(qrow0 + qh * 32 + r32) * ZP + ZQ + hq * 64 + hi * 8;
        v4u x[4]; f32x4 ct[2][4]; const bool lat = qrow0 < ML;
        { const int t = qpos0 + qh * 32 + r32; const float* rt = wsf(p, WS_ROPE);
#pragma unroll
          for (int d0 = 0; d0 < 4; ++d0) x[d0] = *(const v4u*)(qp + d0 * 16);
          if (lat) {
#pragma unroll
            for (int hf = 0; hf < 2; ++hf) { const int pos = hf == 0 ? t / GRIDW : t % GRIDW; const f32x4* cp = (const f32x4*)(rt + 32 * pos + 16 * hi);
#pragma unroll
                for (int c = 0; c < 4; ++c) ct[hf][c] = cp[c]; } } }
        float f[4][8];
#pragma unroll
        for (int d0 = 0; d0 < 4; ++d0) { f[d0][0] = __uint_as_float(x[d0].x << 16); f[d0][1] = __uint_as_float(x[d0].x & 0xffff0000u); f[d0][2] = __uint_as_float(x[d0].y << 16); f[d0][3] = __uint_as_float(x[d0].y & 0xffff0000u);
            f[d0][4] = __uint_as_float(x[d0].z << 16); f[d0][5] = __uint_as_float(x[d0].z & 0xffff0000u); f[d0][6] = __uint_as_float(x[d0].w << 16); f[d0][7] = __uint_as_float(x[d0].w & 0xffff0000u); }
        if (lat) {
#pragma unroll
            for (int hf = 0; hf < 2; ++hf)
#pragma unroll
                for (int e = 0; e < 8; ++e) { const float cs = ct[hf][e >> 1][2 * (e & 1)], sn = ct[hf][e >> 1][2 * (e & 1) + 1], x1 = f[2 * hf][e], x2 = f[2 * hf + 1][e]; f[2 * hf][e] = x1 * cs - x2 * sn; f[2 * hf + 1][e] = x1 * sn + x2 * cs; }
        }
#pragma unroll
        for (int d0 = 0; d0 < 4; ++d0) { v4u y;
            y.x = cvtpk(f[d0][0] * C2, f[d0][1] * C2); y.y = cvtpk(f[d0][2] * C2, f[d0][3] * C2); y.z = cvtpk(f[d0][4] * C2, f[d0][5] * C2); y.w = cvtpk(f[d0][6] * C2, f[d0][7] * C2);
            qf[j][d0] = __builtin_bit_cast(bf16x8, y); } }
    const float sink2 = prm(p, PRM_SINK)[l * AH + hq] * 1.4426950408889634f;
    float m[1] = {sink2}, lsum[1] = {hi == 0 ? 1.f : 0.f};
    f32x16 negm;
#pragma unroll
    for (int r = 0; r < 16; ++r) negm[r] = -sink2;
    f32x16 o[1][2];
#pragma unroll
    for (int j = 0; j < 1; ++j)
#pragma unroll
        for (int dh = 0; dh < 2; ++dh)
#pragma unroll
            for (int r = 0; r < 16; ++r) o[j][dh][r] = 0.f;
    const int npair = (nt + 1) >> 1;
    for (int tp = 0; tp < npair; ++tp) {
        asm volatile("s_waitcnt vmcnt(0)" ::: "memory"); __syncthreads();
        if (tp + 1 < npair) ATT_DMA2(tp + 1, (tp + 1) & 1);
#pragma unroll 1
      for (int sub = 0; sub < 2; ++sub) { const int t = 2 * tp + sub; if (t >= nt) break;
        const int sl = 2 * (tp & 1) + sub;
        const LAS unsigned char* kb = lds + KBUF + sl * SLOT + hi * 1024 + r32 * 16;
        const LAS unsigned char* vb = lds + VBUF + sl * SLOT + ((lane >> 4) & 1) * 32 + (lane & 3) * 8 + (4 * hi + ((lane & 15) >> 2)) * 64;
        bf16x8 kf[2][4], vf[2][4];
#pragma unroll
        for (int d0 = 0; d0 < 4; ++d0) { kf[0][d0] = *(const LAS bf16x8*)(kb + d0 * 2048); kf[1][d0] = *(const LAS bf16x8*)(kb + d0 * 2048 + 512); }
#pragma unroll
        for (int dh = 0; dh < 2; ++dh)
#pragma unroll
            for (int ks = 0; ks < 4; ++ks) { const s16x4 a = vtr(vb + dh * 4096 + ks * 1024), c = vtr(vb + dh * 4096 + ks * 1024 + 512);
                vf[dh][ks] = (bf16x8){a[0], a[1], a[2], a[3], c[0], c[1], c[2], c[3]}; }
        const int kpos = kw0 + 64 * t;
        const bool win = t < ntw && ((kpos + 63 - qpos0 > WIN) || (qpos0 + 63 - kpos > WIN));
#pragma unroll
        for (int j = 0; j < 1; ++j) {
            f32x16 p0 = __builtin_amdgcn_mfma_f32_32x32x16_bf16(kf[0][0], qf[j][0], negm, 0, 0, 0), p1 = __builtin_amdgcn_mfma_f32_32x32x16_bf16(kf[1][0], qf[j][0], negm, 0, 0, 0);
#pragma unroll
            for (int d0 = 1; d0 < 4; ++d0) { p0 = __builtin_amdgcn_mfma_f32_32x32x16_bf16(kf[0][d0], qf[j][d0], p0, 0, 0, 0); p1 = __builtin_amdgcn_mfma_f32_32x32x16_bf16(kf[1][d0], qf[j][d0], p1, 0, 0, 0); }
            asm volatile("s_nop 15\n\ts_nop 7" : "+v"(p0), "+v"(p1));
            if (win) { asm volatile("; window mask" ::: "memory");
                const int qpos = qpos0 + qh * 32 + r32;
#pragma unroll
                for (int r = 0; r < 16; ++r) { const int d0_ = kpos + crow(r, hi) - qpos, d1_ = d0_ + 32;
                    if (d0_ > WIN || d0_ < -WIN) p0[r] = -INFINITY; if (d1_ > WIN || d1_ < -WIN) p1[r] = -INFINITY; } }
            float mxa = max3f(p0[0], p0[1], p1[0]), mxb = max3f(p0[2], p0[3], p1[1]); mxa = max3f(mxa, p1[2], p1[3]);
#pragma unroll
            for (int r = 4; r < 16; r += 4) { mxa = max3f(mxa, p0[r], p0[r + 1]); mxb = max3f(mxb, p0[r + 2], p0[r + 3]); mxa = max3f(mxa, p1[r], p1[r + 1]); mxb = max3f(mxb, p1[r + 2], p1[r + 3]); }
            const float mx = max32(max3f(mxa, mxb, mxb));
            if (__any(mx > 0.f)) {
                const float dl = fmaxf(mx, 0.f), alpha = __builtin_amdgcn_exp2f(-dl); m[j] += dl; lsum[j] *= alpha;
#pragma unroll
                for (int r = 0; r < 16; ++r) { p0[r] -= dl; p1[r] -= dl; negm[r] = -m[j]; }
#pragma unroll
                for (int dh = 0; dh < 2; ++dh)
#pragma unroll
                    for (int r = 0; r < 16; ++r) o[j][dh][r] *= alpha; }
            float rs = 0.f;
#pragma unroll
            for (int r = 0; r < 16; ++r) { p0[r] = __builtin_amdgcn_exp2f(p0[r]); p1[r] = __builtin_amdgcn_exp2f(p1[r]); rs += p0[r] + p1[r]; }
            lsum[j] += rs;
            bf16x8 pf[4];
#pragma unroll
            for (int ks = 0; ks < 4; ++ks) { unsigned w[4];
#pragma unroll
                for (int i = 0; i < 4; ++i) w[i] = (ks < 2) ? cvtpk(p0[8 * ks + 2 * i], p0[8 * ks + 2 * i + 1]) : cvtpk(p1[8 * (ks - 2) + 2 * i], p1[8 * (ks - 2) + 2 * i + 1]);
                v4u wv = {w[0], w[1], w[2], w[3]}; pf[ks] = __builtin_bit_cast(bf16x8, wv); }
#pragma unroll
            for (int dh = 0; dh < 2; ++dh)
#pragma unroll
                for (int ks = 0; ks < 4; ++ks) o[j][dh] = __builtin_amdgcn_mfma_f32_32x32x16_bf16(vf[dh][ks], pf[ks], o[j][dh], 0, 0, 0);
        }
      }
    }
    bf16* Y = wsb(p, WS_U);
#pragma unroll
    for (int j = 0; j < 1; ++j) { const float lt = sum32(lsum[j]); const float inv = __builtin_amdgcn_rcpf(lt);
        bf16* yp = Y + (size_t)(qrow0 + qh * 32 + r32) * DM + hq * 64 + 4 * hi;
#pragma unroll
        for (int dh = 0; dh < 2; ++dh)
#pragma unroll
            for (int rg = 0; rg < 4; ++rg) { v2u w; w.x = cvtpk(o[j][dh][4 * rg] * inv, o[j][dh][4 * rg + 1] * inv); w.y = cvtpk(o[j][dh][4 * rg + 2] * inv, o[j][dh][4 * rg + 3] * inv);
                *(v2u*)(yp + 32 * dh + 8 * rg) = w; } }
    __syncthreads();
#undef ATT_DMA2
#undef ATT_DMA
}
__device__ __forceinline__ void phase(const P& p, LAS unsigned char* lds, int l, bool ctxq, int tid) {
    constexpr int NQB = SEQ / 64, NLAT = NB * AKV * NQB, NCQ = CTXL / 64, NCTX = NB * AKV * NCQ;
    const int G = gridDim.x; const int vcu = (G % 8 == 0) ? ((int)blockIdx.x % 8) * (G / 8) + (int)blockIdx.x / 8 : (int)blockIdx.x;
    const int per = (NLAT + G - 1) / G;
    for (int i = 0; i < per; ++i) { const int u = vcu * per + i; if (u >= NLAT) break;
        const int qb = u % NQB, g = (u / NQB) % AKV, b = u / (NQB * AKV);
        const int kw0 = (64 * qb - WIN < 0) ? 0 : 64 * qb - WIN; const int kend = (64 * qb + 64 + WIN > SEQ) ? SEQ : 64 * qb + 64 + WIN;
        unit(p, lds, l, b, g, b * SEQ + 64 * qb, 64 * qb, kw0, (kend - kw0) / 64, tid); }
    if (ctxq) for (int v = vcu; v < NCTX; v += G) { const int cq = v % NCQ, g = (v / NCQ) % AKV, b = v / (NCQ * AKV);
        unit(p, lds, l, b, g, ML + b * CTXL + 64 * cq, 0, 0, 0, tid); }
}
}

namespace gla {
using att::bf16x8; using att::s16x4; using att::f32x16; using att::crow; using att::cvtpk; using att::vtr;
constexpr int NCC = CTXL / 64, NCL = SEQ / 64, NCH = NCC + NCL;
constexpr int WREG = 17408;
constexpr int L_Q = 0, L_K = 4096, L_V = 8192;
constexpr int PB = 17;
__device__ __forceinline__ int chunk_row0(int b, int dir, int n) {
    if (n < NCC) { const int c = dir ? NCC - 1 - n : n; return ML + b * CTXL + 64 * c; }
    const int c = dir ? NCL - 1 - (n - NCC) : n - NCC; return b * SEQ + 64 * c;
}
__device__ __forceinline__ int chain_index(int t, int dir) { return !dir ? t : (t < NCC ? NCC - 1 - t : NCC + NCL - 1 - (t - NCC)); }
__device__ __forceinline__ int nat_row0(int b, int t) { return t < NCC ? ML + b * CTXL + 64 * t : b * SEQ + 64 * (t - NCC); }
__device__ __forceinline__ bf16* stg(const P& p) { return wsb(p, WS_SG); }
__device__ __forceinline__ float* dec(const P& p) { return wsf(p, WS_GST); }

__device__ __forceinline__ void load_v_issue(const bf16* Z, int row0, int vcol, int lane, v4u (&x)[8]) {
#pragma unroll
    for (int i = 0; i < 8; ++i) { const int idx = i * 64 + lane, s = idx >> 3, c = idx & 7; x[i] = *(const v4u*)(Z + (size_t)(row0 + s) * ZP + vcol + c * 8); }
}
__device__ __forceinline__ void load_v_store(LAS unsigned char* w, int lane, const v4u (&x)[8]) {
#pragma unroll
    for (int i = 0; i < 8; ++i) { const int idx = i * 64 + lane, s = idx >> 3, c = idx & 7; *(LAS v4u*)(w + L_V + ((c >> 2) * 4 + (s >> 4)) * 1024 + (s & 15) * 64 + (c & 3) * 16) = x[i]; }
}
__device__ __forceinline__ void load_v(const bf16* Z, int row0, int vcol, LAS unsigned char* w, int lane) { v4u x[8]; load_v_issue(Z, row0, vcol, lane, x); load_v_store(w, lane, x); }
template <int CTRL, int RM> __device__ __forceinline__ float dppf(float old, float src) { return __int_as_float(__builtin_amdgcn_update_dpp(__float_as_int(old), __float_as_int(src), CTRL, RM, 0xf, false)); }
__device__ __forceinline__ float scan_add_dpp(float v) {
    v += dppf<0x111, 0xf>(0.f, v); v += dppf<0x112, 0xf>(0.f, v); v += dppf<0x114, 0xf>(0.f, v); v += dppf<0x118, 0xf>(0.f, v);
    v += dppf<0x142, 0xa>(0.f, v); v += dppf<0x143, 0xc>(0.f, v); return v; }
__device__ __forceinline__ float scan_max_dpp(float v) {
    constexpr float NI = -3.0e38f;
    v = fmaxf(v, dppf<0x111, 0xf>(NI, v)); v = fmaxf(v, dppf<0x112, 0xf>(NI, v)); v = fmaxf(v, dppf<0x114, 0xf>(NI, v)); v = fmaxf(v, dppf<0x118, 0xf>(NI, v));
    v = fmaxf(v, dppf<0x142, 0xa>(NI, v)); v = fmaxf(v, dppf<0x143, 0xc>(NI, v)); return v; }
constexpr int L_BL = 16384;
__device__ __forceinline__ void up8(v4u x, float* f) { f[0] = __uint_as_float(x.x << 16); f[1] = __uint_as_float(x.x & 0xffff0000u); f[2] = __uint_as_float(x.y << 16); f[3] = __uint_as_float(x.y & 0xffff0000u);
    f[4] = __uint_as_float(x.z << 16); f[5] = __uint_as_float(x.z & 0xffff0000u); f[6] = __uint_as_float(x.w << 16); f[7] = __uint_as_float(x.w & 0xffff0000u); }
struct PrepRaw { v4u b[4], k[4], q[4]; };
template <bool WQ> __device__ __forceinline__ void prep_issue(const P& p, int row0, int h, int dir, int lane, PrepRaw& r) {
    const int t = dir ? 63 - lane : lane;
    const bf16* zr = wsb(p, WS_ACT) + (size_t)(row0 + t) * ZP; const bf16* gp = wsb(p, WS_GA) + ((size_t)dir * M + row0 + t) * B_KW + h * 32;
#pragma unroll
    for (int c4 = 0; c4 < 4; ++c4) { r.b[c4] = *(const v4u*)(gp + 8 * c4); r.k[c4] = *(const v4u*)(zr + ZBK + h * 32 + 8 * c4); if (WQ) r.q[c4] = *(const v4u*)(zr + ZBQ + h * 32 + 8 * c4); }
}
template <bool KT, bool WQ> __device__ __forceinline__ float prep_compute(const PrepRaw& r, int dir, LAS unsigned char* w, int lane) {
    const int t = dir ? 63 - lane : lane;
    float b[32];
#pragma unroll
    for (int c4 = 0; c4 < 4; ++c4) up8(r.b[c4], b + 8 * c4);
#pragma unroll
    for (int d = 0; d < 32; ++d) b[d] = scan_add_dpp(b[d]);
    if (lane == 63) {
#pragma unroll
        for (int c = 0; c < 8; ++c) *(LAS f32x4*)(w + L_BL + 16 * c) = (f32x4){b[4 * c], b[4 * c + 1], b[4 * c + 2], b[4 * c + 3]}; }
#pragma unroll
    for (int c4 = 0; c4 < 4; ++c4) { v4u kw, qw; float e[8], kk[8];
        up8(r.k[c4], kk);
#pragma unroll
        for (int i = 0; i < 8; ++i) e[i] = __expf(-b[8 * c4 + i]);
        kw.x = cvtpk(kk[0] * e[0], kk[1] * e[1]); kw.y = cvtpk(kk[2] * e[2], kk[3] * e[3]); kw.z = cvtpk(kk[4] * e[4], kk[5] * e[5]); kw.w = cvtpk(kk[6] * e[6], kk[7] * e[7]);
        if (KT) *(LAS v4u*)(w + L_K + (t >> 4) * 1024 + (t & 15) * 64 + c4 * 16) = kw; else *(LAS v4u*)(w + L_K + c4 * 1024 + t * 16) = kw;
        if (WQ) { float qq[8]; up8(r.q[c4], qq);
#pragma unroll
            for (int i = 0; i < 8; ++i) e[i] = 0.17677669529663687f * __expf(b[8 * c4 + i]);
            qw.x = cvtpk(qq[0] * e[0], qq[1] * e[1]); qw.y = cvtpk(qq[2] * e[2], qq[3] * e[3]); qw.z = cvtpk(qq[4] * e[4], qq[5] * e[5]); qw.w = cvtpk(qq[6] * e[6], qq[7] * e[7]);
            *(LAS v4u*)(w + L_Q + c4 * 1024 + t * 16) = qw; } }
    asm volatile("s_waitcnt lgkmcnt(0)" ::: "memory");
    return *(const LAS float*)(w + L_BL + 4 * (lane & 31));
}
__device__ __forceinline__ bf16x8 vfrag(const LAS unsigned char* vb, int vh, int ks) {
    const s16x4 a = vtr(vb + vh * 4096 + ks * 1024), c = vtr(vb + vh * 4096 + ks * 1024 + 512);
    return (bf16x8){a[0], a[1], a[2], a[3], c[0], c[1], c[2], c[3]};
}
__device__ __forceinline__ void unit1(const P& p, LAS unsigned char* lds, int u, int wave, int lane) {
    LAS unsigned char* w = lds + wave * WREG; const int r32 = lane & 31, hi = lane >> 5;
    const LAS unsigned char* trb = w + ((lane >> 4) & 1) * 32 + (lane & 3) * 8 + (4 * hi + ((lane & 15) >> 2)) * 64;
    {
        const int n = u % NCH, ch = u / NCH; const int dir = ch & 1, h = (ch >> 1) % BH, b = ch / (2 * BH);
        const int row0 = chunk_row0(b, dir, n);
        v4u vx[8]; PrepRaw pr;
        load_v_issue(wsb(p, WS_ACT), row0, ZBV + h * 64, lane, vx); prep_issue<false>(p, row0, h, dir, lane, pr);
        load_v_store(w, lane, vx);
        const float bl = prep_compute<true, false>(pr, dir, w, lane);
        asm volatile("s_waitcnt lgkmcnt(0)" ::: "memory");
        const float eb = __expf(bl);
        bf16* so = stg(p) + ((size_t)ch * NCH + n) * 2048;
        bf16x8 kfr[4], vfr1[2][4];
#pragma unroll
        for (int ks = 0; ks < 4; ++ks) { kfr[ks] = vfrag(trb + L_K, 0, ks); vfr1[0][ks] = vfrag(trb + L_V, 0, ks); vfr1[1][ks] = vfrag(trb + L_V, 1, ks); }
#pragma unroll
        for (int vh = 0; vh < 2; ++vh) { f32x16 acc;
#pragma unroll
            for (int r = 0; r < 16; ++r) acc[r] = 0.f;
#pragma unroll
            for (int ks = 0; ks < 4; ++ks) acc = __builtin_amdgcn_mfma_f32_32x32x16_bf16(vfr1[vh][ks], kfr[ks], acc, 0, 0, 0);
#pragma unroll
            for (int r = 0; r < 16; ++r) so[(32 * vh + crow(r, hi)) * 32 + r32] = f2bfh(acc[r] * eb); }
        if (lane < 32) dec(p)[((size_t)ch * NCH + n) * 32 + lane] = eb;
        asm volatile("s_waitcnt lgkmcnt(0)" ::: "memory");
    }
}
__device__ __forceinline__ void pass1(const P& p, LAS unsigned char* lds, int gw, int ngw, int wave, int lane) {
    for (int u = ngw - 1 - gw; u < NCHAIN * NCH; u += ngw) unit1(p, lds, u, wave, lane);
}
__device__ __forceinline__ void pass2(const P& p, int gtid, int nth) {
    bf16* S = stg(p); const float* D = dec(p); static_assert(NCH % (2 * PB) == 0, "pass 2 batch pairs");
    for (int it = gtid; it < NCHAIN * 2048; it += nth) { const int e = it % 2048, ch = it / 2048, d = e & 31;
        float st = 0.f; float locA[PB], ddA[PB], locB[PB], ddB[PB];
#define GLA_P2_LD(loc, dd, n0) _Pragma("unroll") for (int j = 0; j < PB; ++j) { loc[j] = bf2f(S[((size_t)ch * NCH + (n0) + j) * 2048 + e]); dd[j] = D[((size_t)ch * NCH + (n0) + j) * 32 + d]; }
#define GLA_P2_RUN(loc, dd, n0) _Pragma("unroll") for (int j = 0; j < PB; ++j) { S[((size_t)ch * NCH + (n0) + j) * 2048 + e] = f2bfh(st); st = dd[j] * st + loc[j]; }
        GLA_P2_LD(locA, ddA, 0)
        for (int n0 = 0; n0 < NCH; n0 += 2 * PB) {
            GLA_P2_LD(locB, ddB, n0 + PB)
            GLA_P2_RUN(locA, ddA, n0)
            if (n0 + 2 * PB < NCH) { GLA_P2_LD(locA, ddA, n0 + 2 * PB) }
            GLA_P2_RUN(locB, ddB, n0 + PB)
        }
#undef GLA_P2_LD
#undef GLA_P2_RUN
    }
}
__device__ __forceinline__ void unit3(const P& p, LAS unsigned char* lds, int l, bool ctxo, int u, int wave, int lane) {
    LAS unsigned char* w = lds + wave * WREG; const int r32 = lane & 31, hi = lane >> 5;
    const LAS unsigned char* trb = w + ((lane >> 4) & 1) * 32 + (lane & 3) * 8 + (4 * hi + ((lane & 15) >> 2)) * 64;
    const bf16* Z = wsb(p, WS_ACT); bf16* Y = wsb(p, WS_U);
    {
        const int t = u % NCH, h = (u / NCH) % BH, b = u / (NCH * BH);
        if (!ctxo && t < NCC) return;
        const int row0 = nat_row0(b, t);
        f32x16 o[2][2];
#pragma unroll
        for (int tt = 0; tt < 2; ++tt)
#pragma unroll
            for (int vh = 0; vh < 2; ++vh)
#pragma unroll
                for (int r = 0; r < 16; ++r) o[tt][vh][r] = 0.f;
        { v4u vx[8]; load_v_issue(Z, row0, ZBV + h * 64, lane, vx); load_v_store(w, lane, vx); }
#pragma unroll 1
        for (int dir = 0; dir < 2; ++dir) {
            PrepRaw pr; prep_issue<true>(p, row0, h, dir, lane, pr);
            const int ch = (b * BH + h) * 2 + dir; const bf16* sp = stg(p) + ((size_t)ch * NCH + chain_index(t, dir)) * 2048;
            bf16x8 sf[2][2];
#pragma unroll
            for (int vh = 0; vh < 2; ++vh)
#pragma unroll
                for (int d0 = 0; d0 < 2; ++d0) sf[vh][d0] = *(const bf16x8*)(sp + (r32 + 32 * vh) * 32 + 16 * d0 + 8 * hi);
            (void)prep_compute<false, true>(pr, dir, w, lane);
            bf16x8 vfr[2][4];
#pragma unroll
            for (int vh = 0; vh < 2; ++vh)
#pragma unroll
                for (int ks = 0; ks < 4; ++ks) vfr[vh][ks] = vfrag(trb + L_V, vh, ks);
#pragma unroll
            for (int tt = 0; tt < 2; ++tt) {
                bf16x8 qf[2];
#pragma unroll
                for (int d0 = 0; d0 < 2; ++d0) qf[d0] = *(const LAS bf16x8*)(w + L_Q + (2 * d0 + hi) * 1024 + (r32 + 32 * tt) * 16);
#pragma unroll
                for (int vh = 0; vh < 2; ++vh)
#pragma unroll
                    for (int d0 = 0; d0 < 2; ++d0) o[tt][vh] = __builtin_amdgcn_mfma_f32_32x32x16_bf16(sf[vh][d0], qf[d0], o[tt][vh], 0, 0, 0);
#pragma unroll
                for (int sh = 0; sh < 2; ++sh) {
                    if (dir == 0 ? (sh > tt) : (sh < tt)) continue;
                    f32x16 pt;
#pragma unroll
                    for (int r = 0; r < 16; ++r) pt[r] = 0.f;
#pragma unroll
                    for (int d0 = 0; d0 < 2; ++d0) { const bf16x8 kf = *(const LAS bf16x8*)(w + L_K + (2 * d0 + hi) * 1024 + (r32 + 32 * sh) * 16); pt = __builtin_amdgcn_mfma_f32_32x32x16_bf16(kf, qf[d0], pt, 0, 0, 0); }
                    if (sh == tt) {
#pragma unroll
                        for (int r = 0; r < 16; ++r) { const int s = crow(r, hi); if (dir == 0 ? (s > r32) : (s < r32)) pt[r] = 0.f; } }
#pragma unroll
                    for (int k2 = 0; k2 < 2; ++k2) { v4u wv;
                        wv.x = cvtpk(pt[8 * k2], pt[8 * k2 + 1]); wv.y = cvtpk(pt[8 * k2 + 2], pt[8 * k2 + 3]); wv.z = cvtpk(pt[8 * k2 + 4], pt[8 * k2 + 5]); wv.w = cvtpk(pt[8 * k2 + 6], pt[8 * k2 + 7]);
                        const bf16x8 pf = __builtin_bit_cast(bf16x8, wv);
#pragma unroll
                        for (int vh = 0; vh < 2; ++vh) o[tt][vh] = __builtin_amdgcn_mfma_f32_32x32x16_bf16(vfr[vh][2 * sh + k2], pf, o[tt][vh], 0, 0, 0); }
                }
            }
            asm volatile("s_waitcnt lgkmcnt(0)" ::: "memory");
        }
        const float* gn = prm(p, PRM_GNORM) + l * B_VW + h * 64;
#pragma unroll
        for (int tt = 0; tt < 2; ++tt) {
            float s1 = 0.f;
#pragma unroll
            for (int vh = 0; vh < 2; ++vh)
#pragma unroll
                for (int r = 0; r < 16; ++r) s1 += o[tt][vh][r];
            s1 = att::sum32(s1); const float mu = s1 * (1.f / 64.f); float s2 = 0.f;
#pragma unroll
            for (int vh = 0; vh < 2; ++vh)
#pragma unroll
                for (int r = 0; r < 16; ++r) { const float x = o[tt][vh][r] - mu; s2 += x * x; }
            s2 = att::sum32(s2); const float rs = __builtin_amdgcn_rsqf(s2 * (1.f / 64.f) + EPS);
            const int row = row0 + 32 * tt + r32;
            const bf16* zg = Z + (size_t)row * ZP + ZBG + h * 64 + 4 * hi; bf16* yp = Y + (size_t)row * DM + A_OUT + h * 64 + 4 * hi;
#pragma unroll
            for (int vh = 0; vh < 2; ++vh)
#pragma unroll
                for (int rg = 0; rg < 4; ++rg) { const int vo = 32 * vh + 8 * rg; const v2u gz = *(const v2u*)(zg + vo); const f32x4 gg = *(const f32x4*)(gn + vo + 4 * hi);
                    const float g0 = __uint_as_float(gz.x << 16), g1 = __uint_as_float(gz.x & 0xffff0000u), g2 = __uint_as_float(gz.y << 16), g3 = __uint_as_float(gz.y & 0xffff0000u);
                    v2u wv; wv.x = cvtpk(siluf(g0) * (o[tt][vh][4 * rg] - mu) * rs * gg.x, siluf(g1) * (o[tt][vh][4 * rg + 1] - mu) * rs * gg.y);
                    wv.y = cvtpk(siluf(g2) * (o[tt][vh][4 * rg + 2] - mu) * rs * gg.z, siluf(g3) * (o[tt][vh][4 * rg + 3] - mu) * rs * gg.w);
                    *(v2u*)(yp + vo) = wv; }
        }
    }
}
__device__ __forceinline__ void pass3(const P& p, LAS unsigned char* lds, int l, bool ctxo, int gw, int ngw, int wave, int lane) {
    for (int u = ngw - 1 - gw; u < NB * BH * NCH; u += ngw) unit3(p, lds, l, ctxo, u, wave, lane);
}
}

namespace mls {
using att::bf16x8; using att::s16x4; using att::f32x16; using att::crow; using att::cvtpk; using att::vtr; using gla::NCC; using gla::NCL; using gla::NCH; using gla::vfrag; using gla::load_v;
constexpr int WREG = 17408;
constexpr int L_KW = 0, L_T = 16384;
__device__ __forceinline__ bf16* cst(const P& p) { return wsb(p, WS_Y); }
__device__ __forceinline__ float* nst(const P& p) { return wsf(p, WS_MST); }
__device__ __forceinline__ float* sst(const P& p, int which) { return wsf(p, WS_MST) + (size_t)NCHAIN * NCH * (64 + which); }
__device__ __forceinline__ float scan_add(float v, int lane) {
#pragma unroll
    for (int o = 1; o < 64; o <<= 1) { const float u = __shfl_up(v, o); if (lane >= o) v += u; }
    return v;
}
__device__ __forceinline__ float scan_max(float v, int lane) {
#pragma unroll
    for (int o = 1; o < 64; o <<= 1) { const float u = __shfl_up(v, o); if (lane >= o) v = fmaxf(v, u); }
    return v;
}
__device__ __forceinline__ void gates(const P& p, int l, int row0, int h, int dir, int lane, int& t, float& c, float& pm, float& bc) {
    t = dir ? 63 - lane : lane;
    const bf16* zg = wsb(p, WS_ACT) + (size_t)(row0 + t) * ZP + ZCG;
    const float li = bf2f(zg[(2 * dir) * CH + h]), lf = logsigf(bf2f(zg[(2 * dir + 1) * CH + h]) + prm(p, PRM_FBIAS)[(l * 2 + dir) * CH + h]);
    bc = gla::scan_add_dpp(lf); c = li - bc; pm = gla::scan_max_dpp(c);
}
__device__ __forceinline__ void unit1(const P& p, LAS unsigned char* lds, int l, int u, int wave, int lane) {
    LAS unsigned char* w = lds + wave * WREG; const int r32 = lane & 31, hi = lane >> 5;
    const LAS unsigned char* trb = w + ((lane >> 4) & 1) * 32 + (lane & 3) * 8 + (4 * hi + ((lane & 15) >> 2)) * 64;
    LAS float* wt = (LAS float*)(w + L_T);
    const bf16* CQK = wsb(p, WS_CQK);
    {
        const int n = u % NCH, ch = u / NCH; const int dir = ch & 1, h = (ch >> 1) % CH, b = ch / (2 * CH);
        const int row0 = gla::chunk_row0(b, dir, n);
        int t; float c, pm, bc; gates(p, l, row0, h, dir, lane, t, c, pm, bc);
        const float cmax = __int_as_float(__builtin_amdgcn_readlane(__float_as_int(pm), 63)), blast = __int_as_float(__builtin_amdgcn_readlane(__float_as_int(bc), 63));
        wt[t] = __expf(c - cmax) * 0.125f;
        load_v(wsb(p, WS_ACT), row0, ZCV + h * 64, w, lane);
        asm volatile("s_waitcnt lgkmcnt(0)" ::: "memory");
#pragma unroll
        for (int i = 0; i < 8; ++i) { const int idx = i * 64 + lane, s = idx >> 3, cc = idx & 7; const float ws_ = wt[s];
            const v4u x = *(const v4u*)(CQK + (size_t)(row0 + s) * 2 * C_W + C_W + h * 64 + cc * 8); v4u y;
            y.x = cvtpk(__uint_as_float(x.x << 16) * ws_, __uint_as_float(x.x & 0xffff0000u) * ws_); y.y = cvtpk(__uint_as_float(x.y << 16) * ws_, __uint_as_float(x.y & 0xffff0000u) * ws_);
            y.z = cvtpk(__uint_as_float(x.z << 16) * ws_, __uint_as_float(x.z & 0xffff0000u) * ws_); y.w = cvtpk(__uint_as_float(x.w << 16) * ws_, __uint_as_float(x.w & 0xffff0000u) * ws_);
            *(LAS v4u*)(w + L_KW + ((cc >> 2) * 4 + (s >> 4)) * 1024 + (s & 15) * 64 + (cc & 3) * 16) = y; }
        asm volatile("s_waitcnt lgkmcnt(0)" ::: "memory");
        const size_t cn = (size_t)ch * NCH + n;
        bf16* co = cst(p) + cn * 4096;
        const v4u onesv = {0x3f803f80u, 0x3f803f80u, 0x3f803f80u, 0x3f803f80u}; const bf16x8 ones = __builtin_bit_cast(bf16x8, onesv);
        bf16x8 vfr1[2][4];
#pragma unroll
        for (int ks = 0; ks < 4; ++ks) { vfr1[0][ks] = vfrag(trb + gla::L_V, 0, ks); vfr1[1][ks] = vfrag(trb + gla::L_V, 1, ks); }
#pragma unroll
        for (int kh = 0; kh < 2; ++kh) { f32x16 a0, a1, an; bf16x8 kb[4];
#pragma unroll
            for (int ks = 0; ks < 4; ++ks) kb[ks] = vfrag(trb + L_KW, kh, ks);
#pragma unroll
            for (int r = 0; r < 16; ++r) { a0[r] = 0.f; a1[r] = 0.f; an[r] = 0.f; }
#pragma unroll
            for (int ks = 0; ks < 4; ++ks) {
                a0 = __builtin_amdgcn_mfma_f32_32x32x16_bf16(vfr1[0][ks], kb[ks], a0, 0, 0, 0);
                a1 = __builtin_amdgcn_mfma_f32_32x32x16_bf16(vfr1[1][ks], kb[ks], a1, 0, 0, 0);
                an = __builtin_amdgcn_mfma_f32_32x32x16_bf16(ones, kb[ks], an, 0, 0, 0); }
#pragma unroll
            for (int r = 0; r < 16; ++r) { co[(crow(r, hi)) * 64 + 32 * kh + r32] = f2bfh(a0[r]); co[(32 + crow(r, hi)) * 64 + 32 * kh + r32] = f2bfh(a1[r]); }
            if (hi == 0) nst(p)[cn * 64 + 32 * kh + r32] = an[0]; }
        if (lane == 0) { sst(p, 0)[cn] = blast + cmax; sst(p, 1)[cn] = blast; }
        asm volatile("s_waitcnt lgkmcnt(0)" ::: "memory");
    }
}
__device__ __forceinline__ void pass1(const P& p, LAS unsigned char* lds, int l, int gw, int ngw, int wave, int lane) {
    for (int u = gw; u < NCHAIN * NCH; u += ngw) unit1(p, lds, l, u, wave, lane);
}
__device__ __forceinline__ void pass2(const P& p, int gtid, int nth) {
    bf16* C = cst(p); float* N = nst(p); const float* ML_ = sst(p, 0); const float* F = sst(p, 1); float* MP = sst(p, 2);
    for (int it = gtid; it < NCHAIN * 4096; it += nth) { const int e = it % 4096, ch = it / 4096; const bool hn = e < 64;
        float st = 0.f, sn = 0.f, mst = 0.f;
        for (int n0 = 0; n0 < NCH; n0 += gla::PB) { float loc[gla::PB], locn[gla::PB], ml[gla::PB], fl[gla::PB];
#pragma unroll
            for (int j = 0; j < gla::PB; ++j) { const size_t cn = (size_t)ch * NCH + n0 + j; ml[j] = ML_[cn]; fl[j] = F[cn]; loc[j] = bf2f(C[cn * 4096 + e]); locn[j] = hn ? N[cn * 64 + e] : 0.f; }
#pragma unroll
            for (int j = 0; j < gla::PB; ++j) { const size_t cn = (size_t)ch * NCH + n0 + j;
                const float mn = fmaxf(fl[j] + mst, ml[j]), a = __expf(fl[j] + mst - mn), ee = __expf(ml[j] - mn);
                C[cn * 4096 + e] = f2bfh(st); if (hn) N[cn * 64 + e] = sn;
                st = a * st + ee * loc[j]; sn = a * sn + ee * locn[j]; if (e == 0) MP[cn] = mst; mst = mn; } } }
}
__device__ __forceinline__ void unit3(const P& p, LAS unsigned char* lds, int l, bool ctxo, int u, int wave, int lane) {
    LAS unsigned char* w = lds + wave * WREG; const int r32 = lane & 31, hi = lane >> 5;
    const LAS unsigned char* trb = w + ((lane >> 4) & 1) * 32 + (lane & 3) * 8 + (4 * hi + ((lane & 15) >> 2)) * 64;
    LAS float* tb = (LAS float*)(w + L_KW);
    const bf16* Z = wsb(p, WS_ACT); const bf16* CQK = wsb(p, WS_CQK); bf16* Y = wsb(p, WS_U);
    {
        const int tt = u & 1, tc = (u >> 1) % NCH, h = ((u >> 1) / NCH) % CH, b = (u >> 1) / (NCH * CH);
        if (!ctxo && tc < NCC) return;
        const int row0 = gla::nat_row0(b, tc);
        load_v(Z, row0, ZCV + h * 64, w, lane);
#pragma unroll
        for (int dir = 0; dir < 2; ++dir) { const size_t cn = (size_t)((b * CH + h) * 2 + dir) * NCH + gla::chain_index(tc, dir);
            const float mprev = sst(p, 2)[cn];
            int t; float c, pm, bc; gates(p, l, row0, h, dir, lane, t, c, pm, bc);
            const float Mt = fmaxf(mprev, pm);
            tb[dir * 256 + t] = c; tb[dir * 256 + 64 + t] = Mt; tb[dir * 256 + 128 + t] = __expf(mprev - Mt); tb[dir * 256 + 192 + t] = bc + Mt; }
        asm volatile("s_waitcnt lgkmcnt(0)" ::: "memory");
        {
            f32x16 tot[2];
#pragma unroll
            for (int vh = 0; vh < 2; ++vh)
#pragma unroll
                for (int r = 0; r < 16; ++r) tot[vh][r] = 0.f;
            const int tl = 32 * tt + r32;
#pragma unroll 1
            for (int dir = 0; dir < 2; ++dir) {
                const float Mt = tb[dir * 256 + 64 + tl], at = tb[dir * 256 + 128 + tl], mt = tb[dir * 256 + 192 + tl];
                bf16x8 qf[4];
#pragma unroll
                for (int d0 = 0; d0 < 4; ++d0) qf[d0] = *(const bf16x8*)(CQK + (size_t)(row0 + tl) * 2 * C_W + h * 64 + 16 * d0 + 8 * hi);
                const size_t cn = (size_t)((b * CH + h) * 2 + dir) * NCH + gla::chain_index(tc, dir);
                const bf16* cp = cst(p) + cn * 4096; const float* np = nst(p) + cn * 64;
                f32x16 num[2]; float den = 0.f;
#pragma unroll
                for (int vh = 0; vh < 2; ++vh) {
#pragma unroll
                    for (int r = 0; r < 16; ++r) num[vh][r] = 0.f;
#pragma unroll
                    for (int d0 = 0; d0 < 4; ++d0) { const bf16x8 cf = *(const bf16x8*)(cp + (r32 + 32 * vh) * 64 + 16 * d0 + 8 * hi); num[vh] = __builtin_amdgcn_mfma_f32_32x32x16_bf16(cf, qf[d0], num[vh], 0, 0, 0); } }
#pragma unroll
                for (int d0 = 0; d0 < 4; ++d0) { const v4u qu = __builtin_bit_cast(v4u, qf[d0]); const f32x4 n0 = *(const f32x4*)(np + 16 * d0 + 8 * hi), n1 = *(const f32x4*)(np + 16 * d0 + 8 * hi + 4);
                    den += __uint_as_float(qu.x << 16) * n0.x + __uint_as_float(qu.x & 0xffff0000u) * n0.y + __uint_as_float(qu.y << 16) * n0.z + __uint_as_float(qu.y & 0xffff0000u) * n0.w
                         + __uint_as_float(qu.z << 16) * n1.x + __uint_as_float(qu.z & 0xffff0000u) * n1.y + __uint_as_float(qu.w << 16) * n1.z + __uint_as_float(qu.w & 0xffff0000u) * n1.w; }
                den *= at;
#pragma unroll
                for (int vh = 0; vh < 2; ++vh)
#pragma unroll
                    for (int r = 0; r < 16; ++r) num[vh][r] *= at;
#pragma unroll
                for (int sh = 0; sh < 2; ++sh) {
                    if (dir == 0 ? (sh > tt) : (sh < tt)) continue;
                    f32x16 st;
#pragma unroll
                    for (int r = 0; r < 16; ++r) st[r] = 0.f;
#pragma unroll
                    for (int d0 = 0; d0 < 4; ++d0) { const bf16x8 kf = *(const bf16x8*)(CQK + (size_t)(row0 + 32 * sh + r32) * 2 * C_W + C_W + h * 64 + 16 * d0 + 8 * hi); st = __builtin_amdgcn_mfma_f32_32x32x16_bf16(kf, qf[d0], st, 0, 0, 0); }
#pragma unroll
                    for (int rg = 0; rg < 4; ++rg) { const f32x4 cs = *(const LAS f32x4*)(tb + dir * 256 + 32 * sh + 8 * rg + 4 * hi);
#pragma unroll
                        for (int i = 0; i < 4; ++i) { const int r = 4 * rg + i; const int s = crow(r, hi);
                            float wgt = __expf(cs[i] - Mt) * 0.125f;
                            if (sh == tt && (dir == 0 ? (s > r32) : (s < r32))) wgt = 0.f;
                            st[r] *= wgt; den += st[r]; } }
#pragma unroll
                    for (int k2 = 0; k2 < 2; ++k2) { v4u wv;
                        wv.x = cvtpk(st[8 * k2], st[8 * k2 + 1]); wv.y = cvtpk(st[8 * k2 + 2], st[8 * k2 + 3]); wv.z = cvtpk(st[8 * k2 + 4], st[8 * k2 + 5]); wv.w = cvtpk(st[8 * k2 + 6], st[8 * k2 + 7]);
                        const bf16x8 pf = __builtin_bit_cast(bf16x8, wv);
#pragma unroll
                        for (int vh = 0; vh < 2; ++vh) num[vh] = __builtin_amdgcn_mfma_f32_32x32x16_bf16(vfrag(trb + gla::L_V, vh, 2 * sh + k2), pf, num[vh], 0, 0, 0); }
                }
                den = att::sum32(den);
                const float inv = __builtin_amdgcn_rcpf(fmaxf(fabsf(den), __expf(-mt)));
#pragma unroll
                for (int vh = 0; vh < 2; ++vh)
#pragma unroll
                    for (int r = 0; r < 16; ++r) tot[vh][r] += num[vh][r] * inv;
            }
            const float* gn = prm(p, PRM_MNORM) + l * C_W + h * 64;
            float s1 = 0.f;
#pragma unroll
            for (int vh = 0; vh < 2; ++vh)
#pragma unroll
                for (int r = 0; r < 16; ++r) s1 += tot[vh][r];
            s1 = att::sum32(s1); const float mu = s1 * (1.f / 64.f); float s2 = 0.f;
#pragma unroll
            for (int vh = 0; vh < 2; ++vh)
#pragma unroll
                for (int r = 0; r < 16; ++r) { const float x = tot[vh][r] - mu; s2 += x * x; }
            s2 = att::sum32(s2); const float rs = __builtin_amdgcn_rsqf(s2 * (1.f / 64.f) + EPS);
            const int row = row0 + tl;
            const bf16* zg = Z + (size_t)row * ZP + ZCO + h * 64 + 4 * hi; bf16* yp = Y + (size_t)row * DM + A_OUT + B_VW + h * 64 + 4 * hi;
#pragma unroll
            for (int vh = 0; vh < 2; ++vh)
#pragma unroll
                for (int rg = 0; rg < 4; ++rg) { const int vo = 32 * vh + 8 * rg; const v2u gz = *(const v2u*)(zg + vo); const f32x4 gg = *(const f32x4*)(gn + vo + 4 * hi);
                    const float g0 = __uint_as_float(gz.x << 16), g1 = __uint_as_float(gz.x & 0xffff0000u), g2 = __uint_as_float(gz.y << 16), g3 = __uint_as_float(gz.y & 0xffff0000u);
                    v2u wv; wv.x = cvtpk(sigmf(g0) * (tot[vh][4 * rg] - mu) * rs * gg.x, sigmf(g1) * (tot[vh][4 * rg + 1] - mu) * rs * gg.y);
                    wv.y = cvtpk(sigmf(g2) * (tot[vh][4 * rg + 2] - mu) * rs * gg.z, sigmf(g3) * (tot[vh][4 * rg + 3] - mu) * rs * gg.w);
                    *(v2u*)(yp + vo) = wv; }
        }
        asm volatile("s_waitcnt lgkmcnt(0)" ::: "memory");
    }
}
__device__ __forceinline__ void pass3(const P& p, LAS unsigned char* lds, int l, bool ctxo, int gw, int ngw, int wave, int lane) {
    for (int u = gw; u < NB * CH * NCH * 2; u += ngw) unit3(p, lds, l, ctxo, u, wave, lane);
}
}


__device__ __forceinline__ int wg_next(LAS unsigned* ctr, int lane) { unsigned k = 0u; if (lane == 0) k = __hip_atomic_fetch_add(ctr, 1u, __ATOMIC_RELAXED, __HIP_MEMORY_SCOPE_WORKGROUP); return (int)__builtin_amdgcn_readfirstlane(k); }
__device__ __forceinline__ void mixer_p1_items(const P& p, LAS unsigned char* lds, int l, int tid, int wave, int lane) {
    LAS unsigned* ctr = (LAS unsigned*)(lds + MISC_OFF + 128);
    __syncthreads(); if (tid == 0) *ctr = 0u; __syncthreads();
    const int c = blockIdx.x, G = gridDim.x; constexpr int NU = NCHAIN * gla::NCH; const int n = c < NU ? (NU - c + G - 1) / G : 0;
    for (;;) { const int k = wg_next(ctr, lane); if (k >= 2 * n) break;
        if (k < n) mls::unit1(p, lds, l, c + G * k, wave, lane); else gla::unit1(p, lds, c + G * (k - n), wave, lane); }
}
__device__ __forceinline__ void mixer_p3_items(const P& p, LAS unsigned char* lds, int l, bool ctxo, int tid, int wave, int lane) {
    LAS unsigned* ctr = (LAS unsigned*)(lds + MISC_OFF + 128);
    __syncthreads(); if (tid == 0) *ctr = 0u; __syncthreads();
    const int c = blockIdx.x, G = gridDim.x; constexpr int NG3 = NB * BH * gla::NCH, NM3 = NB * CH * gla::NCH * 2;
    const int ng = c < NG3 ? (NG3 - c + G - 1) / G : 0, nm = c < NM3 ? (NM3 - c + G - 1) / G : 0;
    for (;;) { const int k = wg_next(ctr, lane); if (k >= ng + nm) break;
        if (k < ng) gla::unit3(p, lds, l, ctxo, c + G * k, wave, lane); else mls::unit3(p, lds, l, ctxo, c + G * (k - ng), wave, lane); }
}
#define PROJ_THIN(A_, WT_, KK_, CTX_, THIN_LAT_, THIN_CTX_, EXTRA_, SUBI_) do { \
    { pg8::Gemm g_{(A_), (WT_), ML, DM, (KK_)}; pg8::StaticOrder S_; S_.init(ML, DM, G, (int)blockIdx.x); pg8::EpiPlain E_{wsb(p, WS_Y), DM, nullptr}; \
      pg8::gemm_phase<pg8::EpiPlain, pg8::StaticOrder, true, true>(lds, g_, S_, E_); } \
    SEAM(); \
    if (CTX_) { \
        if (blockIdx.x < NSUBWG) { const int ks_ = (int)blockIdx.x >> 5, kh_ = (KK_) / 2; \
            pg8::Gemm g_{(A_) + (size_t)ML * (KK_) + ks_ * kh_, (WT_) + ks_ * kh_, MC, DM, kh_, (KK_)}; pg8::StaticOrder S_; S_.init(MC, DM, 32, (int)blockIdx.x & 31); \
            pg8::EpiPlain E_{ks_ ? wsb(p, WS_HC) : wsb(p, WS_Y) + (size_t)ML * DM, DM, nullptr}; \
            pg8::gemm_phase<pg8::EpiPlain, pg8::StaticOrder, true, true>(lds, g_, S_, E_); \
            sub_barrier(ctl + CW_SUB + 64 * (SUBI_), NSUBWG); \
            { const int gw_ = gw, ngw_ = NSUBWG * NWAVES; EXTRA_; THIN_CTX_; } } \
        else { const int gw_ = gw - NSUBWG * NWAVES, ngw_ = ngw - NSUBWG * NWAVES; THIN_LAT_; } \
        SEAM(); \
    } else { const int gw_ = gw, ngw_ = ngw; EXTRA_; THIN_LAT_; SEAM(); } \
} while (0)
__global__ void __launch_bounds__(NTHREADS, 2) fwd(P p) {
    extern __shared__ __attribute__((aligned(16))) unsigned char lds_raw[];
    LAS unsigned char* lds = (LAS unsigned char*)lds_raw;
    const int tid = threadIdx.x, lane = tid & 63, wave = __builtin_amdgcn_readfirstlane(tid >> 6);
    const int G = gridDim.x, gtid = blockIdx.x * NTHREADS + tid, nth = G * NTHREADS, gw = blockIdx.x * NWAVES + wave, ngw = G * NWAVES;
    volatile LAS unsigned* MISC = (volatile LAS unsigned*)(lds + MISC_OFF);
    for (int u = tid; u < (LDS_BYTES - RING_BYTES) / 4; u += NTHREADS) ((LAS unsigned*)(lds + RING_BYTES))[u] = 0u;
    __syncthreads();
    unsigned* ctl = (unsigned*)(p.ws + WS_CTL);
    XcdBarrier bar; bar.bar = ctl + CW_BAR; bar.x = 0; bar.st = nullptr;
    if (p.one) bar = xcd_barrier_post(ctl + CW_BAR, MISC + 8);
#define SEAM() do { if (p.one) xcd_barrier(bar); } while (0)
    const int lo = p.ph_lo, hi = p.ph_hi;
#define IN(k) (lo <= (k) && (k) < hi)
    if (p.layer < 0 || p.one) {
        if (IN(0)) { ph_modpart_gpu(p, lds, tid, gtid, nth); ph_wconv(p, 0, lds, gw, ngw, wave, lane); ph_init(p, gtid, nth); SEAM(); }
        if (IN(1)) { ph_vec(p, gtid, nth); SEAM(); }
        if (IN(2)) { ph_thin<false, true>(p, 0, 0, 0, 0, gw, ngw, lane); SEAM(); }
    }
    const int l0 = p.one ? 0 : p.layer, l1 = p.one ? DEPTH : p.layer + 1;
    for (int l = (l0 < 0 ? DEPTH : l0); l < l1; ++l) {
        int tid_l = tid; asm volatile("" : "+v"(tid_l));
        const int lane = tid_l & 63, gtid = blockIdx.x * NTHREADS + tid_l, gw = blockIdx.x * NWAVES + __builtin_amdgcn_readfirstlane(tid_l >> 6);
        if (IN(3)) { pg8::Gemm g{wsb(p, WS_U), wl(p, l, WL_GU1), M, 2 * DFF, DM}; pg8::StaticOrder S; S.init(M, 2 * DFF, G, (int)blockIdx.x);
            pg8::EpiSwiglu E{wsb(p, WS_ACT), DFF}; pg8::gemm_phase<pg8::EpiSwiglu, pg8::StaticOrder, true, true>(lds, g, S, E);
            { const int t0 = ((M / 256) * (2 * DFF / 256)) % G;
              if (l + 1 < DEPTH && (int)blockIdx.x >= t0) ph_wconv(p, l + 1, lds, gw - t0 * NWAVES, (G - t0) * NWAVES, gw & 7, lane, 0, 2 * WCONV_ITEMS / 5); }
            SEAM(); }
        if (IN(4)) { PROJ_THIN(wsb(p, WS_ACT), wl(p, l, WL_D1), DFF, true, (ph_thin<true, true>(p, l, 0, l, 1, gw_, ngw_, lane, ML, 0)), (ph_thin<true, true, true>(p, l, 0, l, 1, gw_, ngw_, lane, M, ML)), (void)0, 3 * l); }
        if (IN(6)) { pg8::Gemm g{wsb(p, WS_U), wl(p, l, WL_IN), M, ZP, DM}; pg8::StaticOrder S; S.init(M, ZP, G, (int)blockIdx.x);
            pg8::EpiPlain E{wsb(p, WS_ACT), ZP, wsf(p, WS_BINP) + (size_t)l * ZP}; pg8::gemm_phase<pg8::EpiPlain, pg8::StaticOrder, true, true>(lds, g, S, E);
            { const int t0 = ((M / 256) * (ZP / 256)) % G;
              if (l + 1 < DEPTH && (int)blockIdx.x >= t0) ph_wconv(p, l + 1, lds, gw - t0 * NWAVES, (G - t0) * NWAVES, gw & 7, lane, 2 * WCONV_ITEMS / 5, 3 * WCONV_ITEMS / 5); }
            SEAM(); }
        if (IN(7)) { ph_zpost(p, l, gtid, nth); SEAM(); }
        if (IN(8)) { att::phase(p, lds, l, l + 1 < DEPTH, tid_l); mixer_p1_items(p, lds, l, tid_l, gw & 7, lane); SEAM();
#ifdef DBG_GLA
            if (l == DBG_GLA - 1) { const bf16* sg = wsb(p, WS_SG); int bad = 0; for (long i = gtid; i < (long)NCHAIN * gla::NCH * 2048; i += nth) if (!(fabsf(bf2f(sg[i])) < 1e30f)) bad = 1;
                const float* dd = wsf(p, WS_GST); for (long i = gtid; i < (long)NCHAIN * gla::NCH * 32; i += nth) if (!(fabsf(dd[i]) < 1e30f)) bad = 1;
                if (__any(bad) && (tid_l & 63) == 0) atomicAdd(ctl + 19, 1u); SEAM(); }
#endif
        }
        if (IN(9)) { gla::pass2(p, gtid, nth); mls::pass2(p, gtid, nth); SEAM();
#ifdef DBG_GLA
            if (l == DBG_GLA - 1) { const bf16* sg = wsb(p, WS_SG); int bad = 0; for (long i = gtid; i < (long)NCHAIN * gla::NCH * 2048; i += nth) if (!(fabsf(bf2f(sg[i])) < 1e30f)) bad = 1;
                if (__any(bad) && (tid_l & 63) == 0) atomicAdd(ctl + 20, 1u); SEAM(); }
#endif
        }
#ifndef DBG_GLA
        if (IN(10)) { mixer_p3_items(p, lds, l, l + 1 < DEPTH, tid_l, gw & 7, lane); SEAM(); }
#else
        if (IN(10)) { gla::pass3(p, lds, l, true, gw, ngw, gw & 7, lane); ph_ml3(p, l, gtid, nth); SEAM();
            { bf16* sv = wsb(p, WS_SG); const bf16* Y = wsb(p, WS_U); for (long i = gtid; i < (long)M * B_VW; i += nth) { const int r = (int)(i / B_VW), c = (int)(i % B_VW); sv[i] = Y[(size_t)r * DM + A_OUT + c]; } }
            SEAM(); ph_gla1(p, gtid, nth); SEAM(); ph_gla2(p, gtid, nth); SEAM(); ph_gla3(p, gtid, nth); SEAM(); }
        if (IN(11)) { ph_headln(p, l, gtid, nth, 0); SEAM();
            if (l == DBG_GLA - 1) { const bf16* sv = wsb(p, WS_SG); const bf16* Y = wsb(p, WS_U); float num = 0.f, den = 0.f; int bad = 0;
                for (long i = gtid; i < (long)M * B_VW; i += nth) { const int r = (int)(i / B_VW), c = (int)(i % B_VW); const float a = bf2f(sv[i]), b = bf2f(Y[(size_t)r * DM + A_OUT + c]);
                    if (!(fabsf(a) < 1e30f)) { bad = 1; } else { num += (a - b) * (a - b); } den += b * b; }
                num = wave_sum(num); den = wave_sum(den); bad = __any(bad) ? 1 : 0;
                if ((tid_l & 63) == 0) { atomicAdd((float*)(ctl + 16), num); atomicAdd((float*)(ctl + 17), den); if (bad) atomicAdd(ctl + 18, 1u); } }
            SEAM(); }
#endif
        const int mr = (l + 1 < DEPTH) ? M : ML;
        if (IN(12) && l + 1 == DEPTH && G == 256 && DM == 1024) {
            pg8::Gemm g{wsb(p, WS_U), wl(p, l, WL_OUT), ML, DM, DM};
            { pg8::RoundOrder S; S.init(ML, DM, G, (int)blockIdx.x); S.rnd = 0;
              pg8::EpiMid E{wsb(p, WS_HB), wsb(p, WS_U), vecp(p, l, 1, 2, 0), vecp(p, l, 2, 0, 0), vecp(p, l, 2, 1, 0), SEQ, EPS, pg8::PanelSS{wsf(p, WS_XS) + (size_t)ML * 4, ctl + CW_PAN + 8192}, pg8::PanelSS{wsf(p, WS_XS) + (size_t)2 * ML * 4, ctl + CW_PAN + 16384}};
              pg8::gemm_phase<pg8::EpiMid, pg8::RoundOrder, true, true>(lds, g, S, E); }
            __syncthreads();
            { pg8::RoundOrder S; S.init(ML, DM, G, (int)blockIdx.x); S.rnd = 1;
              pg8::EpiMid E{wsb(p, WS_HB), wsb(p, WS_U), vecp(p, l, 1, 2, 0), vecp(p, l, 2, 0, 0), vecp(p, l, 2, 1, 0), SEQ, EPS, pg8::PanelSS{wsf(p, WS_XS) + (size_t)ML * 4, ctl + CW_PAN + 8192}, pg8::PanelSS{wsf(p, WS_XS) + (size_t)2 * ML * 4, ctl + CW_PAN + 16384}};
              pg8::gemm_phase<pg8::EpiMid, pg8::RoundOrder, true, true>(lds, g, S, E); }
            SEAM(); }
        else if (IN(12)) { PROJ_THIN(wsb(p, WS_U), wl(p, l, WL_OUT), DM, l + 1 < DEPTH, (ph_thin<true, true>(p, l, 1, l, 2, gw_, ngw_, lane, ML, 0)), (ph_thin<true, true, true>(p, l, 1, l, 2, gw_, ngw_, lane, M, ML)), (void)0, 3 * l + 1); }
        if (IN(14)) { pg8::Gemm g{wsb(p, WS_U), wl(p, l, WL_GU2), mr, 2 * DFF, DM}; pg8::StaticOrder S; S.init(mr, 2 * DFF, G, (int)blockIdx.x);
            pg8::EpiSwiglu E{wsb(p, WS_ACT), DFF}; pg8::gemm_phase<pg8::EpiSwiglu, pg8::StaticOrder, true, true>(lds, g, S, E);
            { const int t0 = ((M / 256) * (2 * DFF / 256)) % G;
              if (l + 1 < DEPTH && (int)blockIdx.x >= t0) ph_wconv(p, l + 1, lds, gw - t0 * NWAVES, (G - t0) * NWAVES, gw & 7, lane, 3 * WCONV_ITEMS / 5, WCONV_ITEMS); }
            SEAM(); }
        if (IN(15)) { if (l + 1 < DEPTH) { PROJ_THIN(wsb(p, WS_ACT), wl(p, l, WL_D2), DFF, true, (ph_thin<true, true>(p, l, 2, l + 1, 0, gw_, ngw_, lane, ML, 0)), (ph_thin<true, true, true>(p, l, 2, l + 1, 0, gw_, ngw_, lane, M, ML)), (void)0, 3 * l + 2); }
            else if (G == 256 && DM == 1024) {
                pg8::Gemm g{wsb(p, WS_ACT), wl(p, l, WL_D2), ML, DM, DFF};
                { pg8::RoundOrder S; S.init(ML, DM, G, (int)blockIdx.x); S.rnd = 0;
                  pg8::EpiFinal E{wsb(p, WS_HB), p.out, vecp(p, l, 2, 2, 0), SEQ, EPS, pg8::PanelSS{wsf(p, WS_XS), ctl + CW_PAN}}; pg8::gemm_phase<pg8::EpiFinal, pg8::RoundOrder, true, true>(lds, g, S, E); }
                __syncthreads();
                { pg8::RoundOrder S; S.init(ML, DM, G, (int)blockIdx.x); S.rnd = 1;
                  pg8::EpiFinal E{wsb(p, WS_HB), p.out, vecp(p, l, 2, 2, 0), SEQ, EPS, pg8::PanelSS{wsf(p, WS_XS), ctl + CW_PAN}}; pg8::gemm_phase<pg8::EpiFinal, pg8::RoundOrder, true, true>(lds, g, S, E); }
            }
            else { PROJ_THIN(wsb(p, WS_ACT), wl(p, l, WL_D2), DFF, false, (ph_thin<true, false>(p, l, 2, l, 2, gw_, ngw_, lane, ML, 0)), (void)0, (void)0, 0);
#ifdef DBG_GLA
            SEAM(); { const float num = __hip_atomic_load((float*)(ctl + 16), __ATOMIC_RELAXED, __HIP_MEMORY_SCOPE_AGENT), den = __hip_atomic_load((float*)(ctl + 17), __ATOMIC_RELAXED, __HIP_MEMORY_SCOPE_AGENT);
                const unsigned bad = __hip_atomic_load(ctl + 18, __ATOMIC_RELAXED, __HIP_MEMORY_SCOPE_AGENT);
                float code = num / fmaxf(den, 1e-20f); if (!(code < 0.8f)) code = 0.8f; if (bad) code = 0.95f;
                if (__hip_atomic_load(ctl + 20, __ATOMIC_RELAXED, __HIP_MEMORY_SCOPE_AGENT)) code = 0.5f; if (__hip_atomic_load(ctl + 19, __ATOMIC_RELAXED, __HIP_MEMORY_SCOPE_AGENT)) code = 0.3f;
                const float sc = 1.f + sqrtf(code); for (long i = gtid; i < (long)ML * DM; i += nth) p.out[i] *= sc; }
#endif
        } }
    }
#undef IN
#undef SEAM
}

#ifndef ONE_LAUNCH
#define ONE_LAUNCH 1
#endif
extern "C" void kernel_launch(void* const* d_in, const int* in_sizes, int n_in, void* d_out, int out_size, void* d_ws, size_t ws_size, hipStream_t stream) {
    static int grid = 0;
    if (grid == 0) {
        if (n_in != N_IN || in_sizes[0] != ML * DM || out_size != ML * DM || ws_size < WS_END) {
            fprintf(stderr, "kernel_launch: unexpected shapes (n_in %d, in0 %d, out %d, ws %zu < %zu); nothing launched\n", n_in, n_in > 0 ? in_sizes[0] : -1, out_size, ws_size, (size_t)WS_END); grid = -1; return; }
        int dev = 0, cus = 0, per_cu = 0;
        if (hipGetDevice(&dev) != hipSuccess || hipDeviceGetAttribute(&cus, hipDeviceAttributeMultiprocessorCount, dev) != hipSuccess) { grid = -1; return; }
        if (hipFuncSetAttribute((const void*)fwd, hipFuncAttributeMaxDynamicSharedMemorySize, LDS_BYTES) != hipSuccess) { fprintf(stderr, "kernel_launch: hipFuncSetAttribute failed\n"); grid = -1; return; }
        if (hipOccupancyMaxActiveBlocksPerMultiprocessor(&per_cu, (const void*)fwd, NTHREADS, LDS_BYTES) != hipSuccess || per_cu < 1) fprintf(stderr, "kernel_launch: occupancy query says %d\n", per_cu);
        (void)hipGetLastError();
        grid = cus;
    }
    if (grid < 0) return;
    (void)hipMemsetAsync((char*)d_ws + WS_CTL, 0, CTL_BYTES, stream);
    P a{};
    for (int i = 0; i < N_IN; ++i) a.in[i] = (const float*)d_in[i];
    a.out = (float*)d_out; a.ws = (unsigned char*)d_ws;
#if ONE_LAUNCH
    a.layer = 0; a.ph_lo = 0; a.ph_hi = 17; a.one = 1;
    hipLaunchKernelGGL(fwd, dim3(grid), dim3(NTHREADS), LDS_BYTES, stream, a);
#else
    a.one = 0;
    for (int k = 0; k < 3; ++k) { a.layer = -1; a.ph_lo = k; a.ph_hi = k + 1; hipLaunchKernelGGL(fwd, dim3(grid), dim3(NTHREADS), LDS_BYTES, stream, a); }
    for (int l = 0; l < DEPTH; ++l) for (int k = 3; k < 17; ++k) { a.layer = l; a.ph_lo = k; a.ph_hi = k + 1; hipLaunchKernelGGL(fwd, dim3(grid), dim3(NTHREADS), LDS_BYTES, stream, a); }
#endif
}
#endif
```

```cpp
#ifndef CPU_EMU
#include <hip/hip_runtime.h>
#include <cstdio>
#include <cstdint>
#define DEV __device__ __forceinline__
#else
#include <cstdio>
#include <cstdint>
#include <cmath>
#include <cstring>
#define DEV static inline
#define __host__
#define __device__
#define __forceinline__ inline
struct EmuIdx { int x; };
static thread_local EmuIdx threadIdx, blockIdx, gridDim;
struct float4 { float x, y, z, w; };
#define __expf expf
#endif

#ifndef CFG_DM
#define CFG_DM 1024
#define CFG_NB 8
#define CFG_SEQ 4096
#define CFG_DEPTH 4
#define CFG_GRIDW 64
#define CFG_CTXL 256
#define CFG_DFF 2816
#define CFG_SC 256
#endif
constexpr int DM = CFG_DM, NB = CFG_NB, SEQ = CFG_SEQ, DEPTH = CFG_DEPTH, GRIDW = CFG_GRIDW, CTXL = CFG_CTXL, DFF = CFG_DFF, SC = CFG_SC;
constexpr int AH = DM / 128, AKV = AH / 4, AGRP = AH / AKV, WIN = 128;
constexpr int BH = DM / 256, CH = DM / 256, RANK = 16;
constexpr int A_OUT = AH * 64, A_KVW = AKV * 64, B_KW = BH * 32, B_VW = BH * 64, C_W = CH * 64;
constexpr int INW = A_OUT + 2 * A_KVW + 2 * B_KW + 2 * B_VW + 2 * RANK + 4 * C_W + 4 * CH;
constexpr int ZQ = 0, ZK = A_OUT, ZV = ZK + A_KVW, ZBQ = ZV + A_KVW, ZBK = ZBQ + B_KW, ZBV = ZBK + B_KW, ZBG = ZBV + B_VW, ZAF = ZBG + B_VW, ZAB = ZAF + RANK,
              ZCQ = ZAB + RANK, ZCK = ZCQ + C_W, ZCV = ZCK + C_W, ZCG = ZCV + C_W, ZCO = ZCG + 4 * CH;
static_assert(ZCO + C_W == INW, "in-proj split");
constexpr int ZP = (INW + 255) / 256 * 256;
constexpr int ML = NB * SEQ, MC = NB * CTXL, M = ML + MC;
constexpr int NMOD = NB + 1;
constexpr int NSCC = CTXL / SC, NSCL = SEQ / SC, NSC = NSCC + NSCL;
constexpr int NCHAIN = NB * BH * 2;
constexpr int OW = B_VW + C_W;
static_assert(BH == CH && M % 256 == 0 && (2 * DFF) % 256 == 0 && DFF % 128 == 0 && DM % 256 == 0 && CTXL % SC == 0 && SEQ % SC == 0, "shape assumptions");
constexpr float EPS = 1e-6f;
constexpr int KSPLIT = 8;
constexpr int NPOS = (SEQ / GRIDW > GRIDW) ? SEQ / GRIDW : GRIDW;

typedef unsigned short bf16;
#ifndef CPU_EMU
typedef float f32x4g __attribute__((ext_vector_type(4)));
#endif
DEV float bf2f(bf16 h) { unsigned u = (unsigned)h << 16; float f; __builtin_memcpy(&f, &u, 4); return f; }
DEV bf16 f2bf(float f) { unsigned u; __builtin_memcpy(&u, &f, 4); return (bf16)((u + 0x7fffu + ((u >> 16) & 1u)) >> 16); }
#ifndef CPU_EMU
typedef float f32x2g __attribute__((ext_vector_type(2))); typedef __bf16 bf16x2g __attribute__((ext_vector_type(2)));
DEV unsigned pkbf(float lo, float hi) { const f32x2g v = {lo, hi}; return __builtin_bit_cast(unsigned, __builtin_convertvector(v, bf16x2g)); }
#else
DEV unsigned pkbf(float lo, float hi) { return (unsigned)f2bf(lo) | ((unsigned)f2bf(hi) << 16); }
#endif
DEV bf16 f2bfh(float f) { return (bf16)pkbf(f, 0.f); }
DEV void ld8(const bf16* p, float* f) {
#ifndef CPU_EMU
    const uint4 v = *(const uint4*)p;
    f[0] = __uint_as_float(v.x << 16); f[1] = __uint_as_float(v.x & 0xffff0000u); f[2] = __uint_as_float(v.y << 16); f[3] = __uint_as_float(v.y & 0xffff0000u);
    f[4] = __uint_as_float(v.z << 16); f[5] = __uint_as_float(v.z & 0xffff0000u); f[6] = __uint_as_float(v.w << 16); f[7] = __uint_as_float(v.w & 0xffff0000u);
#else
    for (int i = 0; i < 8; ++i) f[i] = bf2f(p[i]);
#endif
}
#ifndef CPU_EMU
DEV float siluf(float x) { return x * __builtin_amdgcn_rcpf(1.f + __expf(-x)); }
DEV float sigmf(float x) { return __builtin_amdgcn_rcpf(1.f + __expf(-x)); }
DEV float logsigf(float x) { return fminf(x, 0.f) - __logf(1.f + __expf(-fabsf(x))); }
DEV void ldf8(const float* p, float* f) { const f32x4g a = *(const f32x4g*)p, b = *(const f32x4g*)(p + 4); f[0] = a.x; f[1] = a.y; f[2] = a.z; f[3] = a.w; f[4] = b.x; f[5] = b.y; f[6] = b.z; f[7] = b.w; }
#else
DEV float siluf(float x) { return x / (1.f + __expf(-x)); }
DEV float sigmf(float x) { return 1.f / (1.f + __expf(-x)); }
DEV float logsigf(float x) { return fminf(x, 0.f) - log1pf(__expf(-fabsf(x))); }
DEV void ldf8(const float* p, float* f) { for (int i = 0; i < 8; ++i) f[i] = p[i]; }
#endif

enum { I_X = 0, I_C, I_CTX, I_CCTX, I_ADAW, I_ADAB, I_NORMG, I_F1G, I_F1U, I_F1D, I_F2G, I_F2U, I_F2D, I_WIN, I_BIN, I_WOUT, I_SINK, I_GWA, I_GBA, I_GNORM, I_CONV, I_FBIAS, I_MNORM, N_IN };

constexpr size_t al256(size_t x) { return (x + 255) / 256 * 256; }
constexpr size_t WS_CTL = 0, CTL_BYTES = 1u << 20;
constexpr size_t W_GU = (size_t)2 * DFF * DM, W_D = (size_t)DM * DFF, W_IN = (size_t)ZP * DM, W_OUT = (size_t)DM * DM;
constexpr size_t WL_GU1 = 0, WL_D1 = WL_GU1 + W_GU, WL_IN = WL_D1 + W_D, WL_OUT = WL_IN + W_IN, WL_GU2 = WL_OUT + W_OUT, WL_D2 = WL_GU2 + W_GU, WL_ELEMS = WL_D2 + W_D;
constexpr size_t WS_W = WS_CTL + CTL_BYTES;
constexpr size_t WS_MODP = al256(WS_W + (size_t)WL_ELEMS * 2 * 2);
constexpr size_t WS_VEC = al256(WS_MODP + (size_t)KSPLIT * DEPTH * NMOD * 9 * DM * 4);
constexpr size_t WS_BINP = al256(WS_VEC + (size_t)DEPTH * 9 * NMOD * DM * 4);
constexpr size_t WS_ROPE = al256(WS_BINP + (size_t)DEPTH * ZP * 4);
constexpr size_t PRM_SINK = 0, PRM_GWA = PRM_SINK + (size_t)DEPTH * AH, PRM_GBA = PRM_GWA + (size_t)DEPTH * 2 * RANK * B_KW, PRM_GNORM = PRM_GBA + (size_t)DEPTH * 2 * B_KW,
                 PRM_CONV = PRM_GNORM + (size_t)DEPTH * B_VW, PRM_FBIAS = PRM_CONV + (size_t)DEPTH * 3 * 2 * C_W, PRM_MNORM = PRM_FBIAS + (size_t)DEPTH * 2 * CH, PRM_END = PRM_MNORM + (size_t)DEPTH * C_W;
constexpr size_t WS_PRM = al256(WS_ROPE + (size_t)NPOS * 32 * 4);
constexpr size_t WS_HC = al256(WS_PRM + PRM_END * 4);
constexpr size_t WS_U = al256(WS_HC + (size_t)MC * DM * 4);
constexpr size_t ACTW = (DFF > ZP ? DFF : ZP);
constexpr size_t WS_ACT = al256(WS_U + (size_t)M * DM * 2);
constexpr size_t WS_Y = al256(WS_ACT + (size_t)M * ACTW * 2);
constexpr size_t YBYTES = ((size_t)M * DM * 2 > (size_t)M * OW * 4) ? (size_t)M * DM * 2 : (size_t)M * OW * 4;
constexpr size_t WS_GST = al256(WS_Y + YBYTES);
constexpr size_t GST_S = (size_t)NCHAIN * NSC * 32 * 64, GST_D = (size_t)NCHAIN * NSC * 32;
constexpr size_t WS_MST = al256(WS_GST + (GST_S + GST_D) * 4);
constexpr size_t MST_C = (size_t)NCHAIN * NSC * 64 * 64, MST_N = (size_t)NCHAIN * NSC * 64, MST_M = (size_t)NCHAIN * NSC;
constexpr size_t WS_GA = al256(WS_MST + (MST_C + MST_N + 3 * MST_M) * 4);
constexpr size_t WS_CQK = al256(WS_GA + (size_t)2 * M * B_KW * 2);
constexpr size_t WS_SG = al256(WS_CQK + (size_t)M * 2 * C_W * 2);
constexpr size_t WS_HB = al256(WS_SG + (size_t)NCHAIN * ((CTXL + SEQ) / 64) * 2048 * 2);
constexpr size_t WS_XS = al256(WS_HB + (size_t)M * DM * 2);
constexpr size_t WS_END = al256(WS_XS + (size_t)3 * ML * 4 * 4);

struct P {
    const float* in[N_IN]; float* out; unsigned char* ws;
    int layer, ph_lo, ph_hi, one;
};

DEV bf16* wsb(const P& p, size_t off) { return (bf16*)(p.ws + off); }
DEV float* wsf(const P& p, size_t off) { return (float*)(p.ws + off); }
DEV float* hrow(const P& p, int r) { return r < ML ? p.out + (size_t)r * DM : wsf(p, WS_HC) + (size_t)(r - ML) * DM; }
DEV int modidx(int r) { return r < ML ? r / SEQ : NB; }
DEV float* vecp(const P& p, int l, int s, int kind, int bi) { return wsf(p, WS_VEC) + ((((size_t)l * 3 + s) * 3 + kind) * NMOD + bi) * DM; }
DEV const float* prm(const P& p, size_t off) { return (const float*)(p.ws + WS_PRM) + off; }
DEV bf16* wl(const P& p, int l, size_t off) { return wsb(p, WS_W) + (size_t)(l & 1) * WL_ELEMS + off; }
DEV void sc_rows(int b, int dir, int n, int& row0, int& step) {
    if (n < NSCC) { const int c = dir ? (NSCC - 1 - n) : n; const int base = ML + b * CTXL + c * SC; row0 = dir ? base + SC - 1 : base; }
    else { const int c = dir ? (NSCL - 1 - (n - NSCC)) : (n - NSCC); const int base = b * SEQ + c * SC; row0 = dir ? base + SC - 1 : base; }
    step = dir ? -1 : 1;
}
DEV int sc_chain_index(int t, int dir) { if (!dir) return t; return t < NSCC ? (NSCC - 1 - t) : NSCC + (NSCL - 1 - (t - NSCC)); }
DEV int sc_first_row(int b, int t) { return t < NSCC ? ML + b * CTXL + t * SC : b * SEQ + (t - NSCC) * SC; }

DEV void ph_modpart(const P& p, int gtid, int nth) {
    const float* c = p.in[I_C]; const float* cc = p.in[I_CCTX];
    constexpr int KS = DM / KSPLIT;
    for (long it = gtid; it < (long)KSPLIT * DEPTH * 9 * DM; it += nth) {
        const int col = (int)(it % (9 * DM)); const int l = (int)((it / (9 * DM)) % DEPTH); const int ks = (int)(it / ((long)9 * DM * DEPTH));
        const float* w = p.in[I_ADAW] + (size_t)l * DM * 9 * DM + col;
        float acc[NMOD];
#pragma unroll
        for (int b = 0; b < NMOD; ++b) acc[b] = 0.f;
        for (int k = ks * KS; k < (ks + 1) * KS; ++k) {
            const float wv = w[(size_t)k * 9 * DM];
#pragma unroll
            for (int b = 0; b < NMOD; ++b) { const float cv = b < NB ? c[b * DM + k] : cc[k]; acc[b] += siluf(cv) * wv; }
        }
#pragma unroll
        for (int b = 0; b < NMOD; ++b) wsf(p, WS_MODP)[(((size_t)ks * DEPTH + l) * NMOD + b) * 9 * DM + col] = acc[b];
    }
}
DEV void ph_init(const P& p, int gtid, int nth) {
#ifdef CPU_EMU
    const float4* x4 = (const float4*)p.in[I_X]; float4* o4 = (float4*)p.out;
    for (long i = gtid; i < (long)ML * DM / 4; i += nth) o4[i] = x4[i];
    const float4* c4 = (const float4*)p.in[I_CTX]; float4* h4 = (float4*)wsf(p, WS_HC);
    for (long i = gtid; i < (long)MC * DM / 4; i += nth) h4[i] = c4[i];
#else
    { const f32x4g* x4 = (const f32x4g*)p.in[I_X]; const f32x4g* c4 = (const f32x4g*)p.in[I_CTX]; uint2* hb = (uint2*)wsb(p, WS_HB);
      const long NV4 = (long)M * DM / 4, NL4 = (long)ML * DM / 4;
      for (long i0 = gtid; i0 < NV4; i0 += 4L * nth) { f32x4g v[4];
#pragma unroll
          for (int q = 0; q < 4; ++q) { const long i = i0 + (long)q * nth; if (i < NV4) v[q] = i < NL4 ? x4[i] : c4[i - NL4]; }
#pragma unroll
          for (int q = 0; q < 4; ++q) { const long i = i0 + (long)q * nth; if (i < NV4) { uint2 o; o.x = pkbf(v[q].x, v[q].y); o.y = pkbf(v[q].z, v[q].w); hb[i] = o; } } } }
#endif
    for (int i = gtid; i < NPOS * 16; i += nth) { const int pos = i / 16, f = i % 16; const float inv = powf(10000.f, -(float)f / 16.f); const float a = (float)pos * inv;
        wsf(p, WS_ROPE)[2 * i] = cosf(a); wsf(p, WS_ROPE)[2 * i + 1] = sinf(a); }
    { float* pr = wsf(p, WS_PRM);
      for (int i = gtid; i < DEPTH * AH; i += nth) pr[PRM_SINK + i] = p.in[I_SINK][i];
      for (int i = gtid; i < DEPTH * 2 * RANK * B_KW; i += nth) pr[PRM_GWA + i] = p.in[I_GWA][i];
      for (int i = gtid; i < DEPTH * 2 * B_KW; i += nth) pr[PRM_GBA + i] = p.in[I_GBA][i];
      for (int i = gtid; i < DEPTH * B_VW; i += nth) pr[PRM_GNORM + i] = p.in[I_GNORM][i];
      for (int i = gtid; i < DEPTH * 3 * 2 * C_W; i += nth) pr[PRM_CONV + i] = p.in[I_CONV][i];
      for (int i = gtid; i < DEPTH * 2 * CH; i += nth) pr[PRM_FBIAS + i] = p.in[I_FBIAS][i];
      for (int i = gtid; i < DEPTH * C_W; i += nth) pr[PRM_MNORM + i] = p.in[I_MNORM][i]; }
    for (int i = gtid; i < DEPTH * ZP; i += nth) { const int l = i / ZP, c = i % ZP; wsf(p, WS_BINP)[i] = c < INW ? p.in[I_BIN][l * INW + c] : 0.f; }
}
DEV void ph_vec(const P& p, int gtid, int nth) {
    for (long it = gtid; it < (long)DEPTH * 3 * NMOD * DM; it += nth) {
        const int col = (int)(it % DM); const int bi = (int)((it / DM) % NMOD); const int s = (int)((it / ((long)DM * NMOD)) % 3); const int l = (int)(it / ((long)DM * NMOD * 3));
        float m3[3];
#pragma unroll
        for (int j = 0; j < 3; ++j) { const int c9 = (3 * s + j) * DM + col; float a = p.in[I_ADAB][l * 9 * DM + c9];
            for (int ks = 0; ks < KSPLIT; ++ks) a += wsf(p, WS_MODP)[(((size_t)ks * DEPTH + l) * NMOD + bi) * 9 * DM + c9];
            m3[j] = a; }
        const float gpre = p.in[I_NORMG][(l * 6 + 2 * s) * DM + col], gpost = p.in[I_NORMG][(l * 6 + 2 * s + 1) * DM + col];
        vecp(p, l, s, 0, bi)[col] = gpre * (1.f + m3[1]);
        vecp(p, l, s, 1, bi)[col] = m3[0];
        vecp(p, l, s, 2, bi)[col] = (s == 1 ? 1.f : 0.5f) * m3[2] * gpost;
    }
}
DEV void st8(bf16* p, const float* f) {
#ifndef CPU_EMU
    uint4 v; v.x = pkbf(f[0], f[1]); v.y = pkbf(f[2], f[3]); v.z = pkbf(f[4], f[5]); v.w = pkbf(f[6], f[7]);
    *(uint4*)p = v;
#else
    for (int i = 0; i < 8; ++i) p[i] = f2bf(f[i]);
#endif
}
DEV void ph_zpost(const P& p, int l, int gtid, int nth) {
    bf16* Z = wsb(p, WS_ACT);
    const float* rt = wsf(p, WS_ROPE);
#ifdef CPU_EMU
    constexpr int RH0 = 0, RHN = AH + AKV;
#else
    constexpr int RH0 = AH, RHN = AKV;
#endif
    for (long it = gtid; it < (long)ML * RHN * 2; it += nth) {
        const int hf = (int)(it % 2); const int hs = RH0 + (int)((it / 2) % RHN); const int r = (int)(it / (2 * RHN));
        const int t = r % SEQ; const int pos = hf == 0 ? t / GRIDW : t % GRIDW;
        bf16* z = Z + (size_t)r * ZP + (hs < AH ? ZQ + hs * 64 : ZK + (hs - AH) * 64) + hf * 32;
        float x1[16], x2[16], y1[16], y2[16];
        ld8(z, x1); ld8(z + 8, x1 + 8); ld8(z + 16, x2); ld8(z + 24, x2 + 8);
        float cs_[32];
#ifndef CPU_EMU
#pragma unroll
        for (int i = 0; i < 8; ++i) { const f32x4g v = ((const f32x4g*)(rt + 32 * pos))[i]; cs_[4 * i] = v.x; cs_[4 * i + 1] = v.y; cs_[4 * i + 2] = v.z; cs_[4 * i + 3] = v.w; }
#else
        for (int i = 0; i < 32; ++i) cs_[i] = rt[32 * pos + i];
#endif
#pragma unroll
        for (int i = 0; i < 16; ++i) { const float cs = cs_[2 * i], sn = cs_[2 * i + 1]; y1[i] = x1[i] * cs - x2[i] * sn; y2[i] = x1[i] * sn + x2[i] * cs; }
        st8(z, y1); st8(z + 8, y1 + 8); st8(z + 16, y2); st8(z + 24, y2 + 8);
    }
    const float* wa = prm(p, PRM_GWA) + (size_t)l * 2 * RANK * B_KW; const float* ba = prm(p, PRM_GBA) + (size_t)l * 2 * B_KW;
    bf16* GA = wsb(p, WS_GA);
    { const long NI = (long)2 * M * (B_KW / 8);
      for (long it0 = gtid; it0 < NI; it0 += 2L * nth) {
        float zl[2][16], a[2][8]; int c8v[2], rv[2], dv[2]; bool ok[2];
#pragma unroll
        for (int q = 0; q < 2; ++q) { long it = it0 + (long)q * nth; ok[q] = it < NI; if (!ok[q]) it = it0;
            c8v[q] = (int)(it % (B_KW / 8)) * 8; rv[q] = (int)((it / (B_KW / 8)) % M); dv[q] = (int)(it / ((long)(B_KW / 8) * M));
            const bf16* zp = Z + (size_t)rv[q] * ZP + (dv[q] ? ZAB : ZAF); ld8(zp, zl[q]); ld8(zp + 8, zl[q] + 8); }
#pragma unroll
        for (int q = 0; q < 2; ++q) {
            ldf8(ba + dv[q] * B_KW + c8v[q], a[q]);
#pragma unroll
            for (int k = 0; k < RANK; ++k) { float w8[8]; ldf8(wa + (dv[q] * RANK + k) * B_KW + c8v[q], w8);
#pragma unroll
                for (int j = 0; j < 8; ++j) a[q][j] += zl[q][k] * w8[j]; }
#pragma unroll
            for (int j = 0; j < 8; ++j) a[q][j] = logsigf(a[q][j]) * (1.f / 16.f);
            if (ok[q]) st8(GA + ((size_t)dv[q] * M + rv[q]) * B_KW + c8v[q], a[q]); } } }
    const float* cw = prm(p, PRM_CONV) + (size_t)l * 3 * 2 * C_W;
    bf16* CQK = wsb(p, WS_CQK);
    { const long NI = (long)M * (2 * C_W / 8);
      for (long it0 = gtid; it0 < NI; it0 += 4L * nth) {
        float x0[4][8], xm[4][8], xp[4][8]; int chv[4], rv[4]; bool ok[4];
#pragma unroll
        for (int q = 0; q < 4; ++q) { long it = it0 + (long)q * nth; ok[q] = it < NI; if (!ok[q]) it = it0;
            const int ch = (int)(it % (2 * C_W / 8)) * 8; const int r = (int)(it / (2 * C_W / 8)); chv[q] = ch; rv[q] = r;
            int t, len; if (r < ML) { t = r % SEQ; len = SEQ; } else { t = (r - ML) % CTXL; len = CTXL; }
            const bf16* z = Z + (size_t)r * ZP + (ch < C_W ? ZCQ + ch : ZCK + (ch - C_W));
            ld8(z, x0[q]);
            if (t > 0) ld8(z - (long)ZP, xm[q]); else { for (int j = 0; j < 8; ++j) xm[q][j] = 0.f; }
            if (t < len - 1) ld8(z + ZP, xp[q]); else { for (int j = 0; j < 8; ++j) xp[q][j] = 0.f; } }
#pragma unroll
        for (int q = 0; q < 4; ++q) { float o[8], w0[8], w1[8], w2[8]; const int ch = chv[q];
            ldf8(cw + 0 * 2 * C_W + ch, w0); ldf8(cw + 1 * 2 * C_W + ch, w1); ldf8(cw + 2 * 2 * C_W + ch, w2);
#pragma unroll
            for (int j = 0; j < 8; ++j) o[j] = siluf(xm[q][j] * w0[j] + x0[q][j] * w1[j] + xp[q][j] * w2[j]);
            if (ok[q]) st8(CQK + (size_t)rv[q] * 2 * C_W + ch, o); } } }
}
DEV void ph_attn_naive(const P& p, int l, int gtid, int nth) {
    const bf16* Z = wsb(p, WS_ACT); bf16* Y = wsb(p, WS_U);
    const float* sink = prm(p, PRM_SINK) + l * AH;
    for (long it = gtid; it < (long)M * AH; it += nth) {
        const int r = (int)(it % M); const int hq = (int)(it / M); const int g = hq / AGRP;
        float q[64], o[64];
        const bf16* zq = Z + (size_t)r * ZP + ZQ + hq * 64;
#pragma unroll
        for (int d = 0; d < 64; d += 8) ld8(zq + d, q + d);
#pragma unroll
        for (int d = 0; d < 64; ++d) { q[d] *= 0.125f; o[d] = 0.f; }
        float m = sink[hq], lsum = 1.f;
        int b, j0, j1, crow0;
        if (r < ML) { b = r / SEQ; const int t = r % SEQ; j0 = t - WIN < 0 ? 0 : t - WIN; j1 = t + WIN > SEQ - 1 ? SEQ - 1 : t + WIN; }
        else { b = (r - ML) / CTXL; j0 = 0; j1 = -1; }
        crow0 = ML + b * CTXL;
        const int nwin = j1 - j0 + 1;
        for (int jj = 0; jj < nwin + CTXL; ++jj) {
            const int kr = jj < nwin ? b * SEQ + j0 + jj : crow0 + (jj - nwin);
            const bf16* zk = Z + (size_t)kr * ZP + ZK + g * 64; const bf16* zv = Z + (size_t)kr * ZP + ZV + g * 64;
            float s = 0.f;
#pragma unroll
            for (int d = 0; d < 64; d += 8) { float kk[8]; ld8(zk + d, kk);
#pragma unroll
                for (int e = 0; e < 8; ++e) s += q[d + e] * kk[e]; }
            const float mn = fmaxf(m, s); const float f = __expf(m - mn), e = __expf(s - mn);
            lsum = lsum * f + e; m = mn;
#pragma unroll
            for (int d = 0; d < 64; d += 8) { float vv[8]; ld8(zv + d, vv);
#pragma unroll
                for (int e2 = 0; e2 < 8; ++e2) o[d + e2] = o[d + e2] * f + e * vv[e2]; }
        }
        const float inv = 1.f / lsum;
        bf16* y = Y + (size_t)r * DM + hq * 64;
#pragma unroll
        for (int d = 0; d < 64; ++d) y[d] = f2bf(o[d] * inv);
    }
}
DEV void gla_tok(const P& p, int r, int h, int dir, float (&a)[32], float (&k)[32], float& v, int vc) {
    const bf16* Z = wsb(p, WS_ACT); const bf16* ga = wsb(p, WS_GA) + ((size_t)dir * M + r) * B_KW + h * 32;
    const bf16* zk = Z + (size_t)r * ZP + ZBK + h * 32;
#pragma unroll
    for (int d = 0; d < 32; d += 8) { ld8(ga + d, a + d); ld8(zk + d, k + d); }
#pragma unroll
    for (int d = 0; d < 32; ++d) a[d] = __expf(a[d]);
    v = bf2f(Z[(size_t)r * ZP + ZBV + h * 64 + vc]);
}
DEV void ph_gla1(const P& p, int gtid, int nth) {
    float* S = wsf(p, WS_GST); float* D = S + GST_S;
    for (long it = gtid; it < (long)NCHAIN * NSC * 64; it += nth) {
        const int vc = (int)(it % 64); const int n = (int)((it / 64) % NSC); const int ch = (int)(it / (64 * NSC));
        const int dir = ch & 1, h = (ch >> 1) % BH, b = ch / (2 * BH);
        int row0, step; sc_rows(b, dir, n, row0, step);
        float s[32], pd[32];
#pragma unroll
        for (int d = 0; d < 32; ++d) { s[d] = 0.f; pd[d] = 1.f; }
        for (int i = 0; i < SC; ++i) {
            float a[32], k[32], v; gla_tok(p, row0 + i * step, h, dir, a, k, v, vc);
#pragma unroll
            for (int d = 0; d < 32; ++d) { s[d] = a[d] * s[d] + k[d] * v; pd[d] *= a[d]; }
        }
        float* so = S + ((size_t)ch * NSC + n) * 32 * 64;
#pragma unroll
        for (int d = 0; d < 32; ++d) so[d * 64 + vc] = s[d];
        if (vc == 0) {
#pragma unroll
            for (int d = 0; d < 32; ++d) D[((size_t)ch * NSC + n) * 32 + d] = pd[d]; }
    }
}
DEV void ph_gla2(const P& p, int gtid, int nth) {
    float* S = wsf(p, WS_GST); const float* D = S + GST_S;
    for (long it = gtid; it < (long)NCHAIN * 32 * 64; it += nth) {
        const int e = (int)(it % (32 * 64)); const int ch = (int)(it / (32 * 64)); const int d = e / 64;
        float st = 0.f;
        for (int n = 0; n < NSC; ++n) { float* x = S + ((size_t)ch * NSC + n) * 32 * 64 + e; const float loc = *x; *x = st; st = D[((size_t)ch * NSC + n) * 32 + d] * st + loc; }
    }
}
DEV void ph_gla3(const P& p, int gtid, int nth) {
    const float* S = wsf(p, WS_GST); const bf16* Z = wsb(p, WS_ACT); float* O = wsf(p, WS_Y);
    for (long it = gtid; it < (long)NB * BH * NSC * 64; it += nth) {
        const int vc = (int)(it % 64); const int t = (int)((it / 64) % NSC); const int h = (int)((it / (64 * NSC)) % BH); const int b = (int)(it / ((long)64 * NSC * BH));
        for (int dir = 0; dir < 2; ++dir) {
            const int ch = (b * BH + h) * 2 + dir; const int n = sc_chain_index(t, dir);
            int row0, step; sc_rows(b, dir, n, row0, step);
            float s[32];
            const float* sp = S + ((size_t)ch * NSC + n) * 32 * 64;
#pragma unroll
            for (int d = 0; d < 32; ++d) s[d] = sp[d * 64 + vc];
            for (int i = 0; i < SC; ++i) {
                const int r = row0 + i * step;
                float a[32], k[32], v; gla_tok(p, r, h, dir, a, k, v, vc);
                const bf16* zq = Z + (size_t)r * ZP + ZBQ + h * 32;
                float o = 0.f, qq[32];
#pragma unroll
                for (int d = 0; d < 32; d += 8) ld8(zq + d, qq + d);
#pragma unroll
                for (int d = 0; d < 32; ++d) { s[d] = a[d] * s[d] + k[d] * v; o += qq[d] * s[d]; }
                o *= 0.17677669529663687f;
                float* op = O + (size_t)r * OW + h * 64 + vc;
                if (dir == 0) *op = o; else *op += o;
            }
        }
    }
}
DEV void ml_tok(const P& p, int l, int r, int h, int dir, const bf16*& ck, float& v, float& li, float& lf, int vc) {
    const bf16* Z = wsb(p, WS_ACT); ck = wsb(p, WS_CQK) + (size_t)r * 2 * C_W + C_W + h * 64;
    v = bf2f(Z[(size_t)r * ZP + ZCV + h * 64 + vc]);
    li = bf2f(Z[(size_t)r * ZP + ZCG + (2 * dir) * CH + h]);
    lf = logsigf(bf2f(Z[(size_t)r * ZP + ZCG + (2 * dir + 1) * CH + h]) + prm(p, PRM_FBIAS)[(l * 2 + dir) * CH + h]);
}
DEV void ph_ml1(const P& p, int l, int gtid, int nth) {
    float* C = wsf(p, WS_MST); float* N = C + MST_C; float* Mm = N + MST_N; float* F = Mm + MST_M;
    for (long it = gtid; it < (long)NCHAIN * NSC * 64; it += nth) {
        const int vc = (int)(it % 64); const int n = (int)((it / 64) % NSC); const int ch = (int)(it / (64 * NSC));
        const int dir = ch & 1, h = (ch >> 1) % CH, b = ch / (2 * CH);
        int row0, step; sc_rows(b, dir, n, row0, step);
        float c[64], nn[64]; float m = -1e30f, fs = 0.f;
#pragma unroll
        for (int d = 0; d < 64; ++d) { c[d] = 0.f; nn[d] = 0.f; }
        for (int i = 0; i < SC; ++i) {
            const bf16* ck; float v, li, lf; ml_tok(p, l, row0 + i * step, h, dir, ck, v, li, lf, vc);
            const float mn = fmaxf(lf + m, li); const float fp = __expf(lf + m - mn), ip = __expf(li - mn) * 0.125f; m = mn; fs += lf;
#pragma unroll
            for (int d0 = 0; d0 < 64; d0 += 8) { float k8[8]; ld8(ck + d0, k8);
#pragma unroll
                for (int e = 0; e < 8; ++e) { const int d = d0 + e; c[d] = fp * c[d] + ip * v * k8[e]; nn[d] = fp * nn[d] + ip * k8[e]; } }
        }
        float* co = C + (((size_t)ch * NSC + n) * 64 + vc) * 64;
#pragma unroll
        for (int d = 0; d < 64; ++d) co[d] = c[d];
        if (vc == 0) {
#pragma unroll
            for (int d = 0; d < 64; ++d) N[((size_t)ch * NSC + n) * 64 + d] = nn[d];
            Mm[(size_t)ch * NSC + n] = m; F[(size_t)ch * NSC + n] = fs; }
    }
}
DEV void ph_ml2(const P& p, int gtid, int nth) {
    float* C = wsf(p, WS_MST); float* N = C + MST_C; float* Mm = N + MST_N; const float* F = Mm + MST_M; float* MP = Mm + 2 * MST_M;
    for (long it = gtid; it < (long)NCHAIN * 65 * 64; it += nth) {
        const int e = (int)(it % (65 * 64)); const int ch = (int)(it / (65 * 64));
        float st = 0.f, mst = 0.f;
        for (int n = 0; n < NSC; ++n) {
            const size_t cn = (size_t)ch * NSC + n;
            const float ml = Mm[cn], fl = F[cn];
            const float mn = fmaxf(fl + mst, ml); const float a = __expf(fl + mst - mn), ee = __expf(ml - mn);
            float* x = e < 64 * 64 ? C + cn * 64 * 64 + e : N + cn * 64 + (e - 64 * 64);
            const float loc = *x; *x = st; st = a * st + ee * loc;
            if (e == 0) MP[cn] = mst;
            mst = mn;
        }
    }
}
DEV void ph_ml3(const P& p, int l, int gtid, int nth) {
    const float* C = wsf(p, WS_MST); const float* N = C + MST_C; const float* MP = N + MST_N + 2 * MST_M; float* O = wsf(p, WS_Y);
    for (long it = gtid; it < (long)NB * CH * NSC * 64; it += nth) {
        const int vc = (int)(it % 64); const int t = (int)((it / 64) % NSC); const int h = (int)((it / (64 * NSC)) % CH); const int b = (int)(it / ((long)64 * NSC * CH));
        for (int dir = 0; dir < 2; ++dir) {
            const int ch = (b * CH + h) * 2 + dir; const int n = sc_chain_index(t, dir);
            int row0, step; sc_rows(b, dir, n, row0, step);
            const size_t cn = (size_t)ch * NSC + n;
            float c[64], nn[64]; float m = MP[cn];
#pragma unroll
            for (int d = 0; d < 64; ++d) { c[d] = C[(cn * 64 + vc) * 64 + d]; nn[d] = N[cn * 64 + d]; }
            for (int i = 0; i < SC; ++i) {
                const int r = row0 + i * step;
                const bf16* ck; float v, li, lf; ml_tok(p, l, r, h, dir, ck, v, li, lf, vc);
                const float mn = fmaxf(lf + m, li); const float fp = __expf(lf + m - mn), ip = __expf(li - mn) * 0.125f; m = mn;
                const bf16* cq = wsb(p, WS_CQK) + (size_t)r * 2 * C_W + h * 64;
                float num = 0.f, den = 0.f;
#pragma unroll
                for (int d0 = 0; d0 < 64; d0 += 8) { float qq[8], k8[8]; ld8(cq + d0, qq); ld8(ck + d0, k8);
#pragma unroll
                    for (int e = 0; e < 8; ++e) { const int d = d0 + e; c[d] = fp * c[d] + ip * v * k8[e]; nn[d] = fp * nn[d] + ip * k8[e]; num += c[d] * qq[e]; den += nn[d] * qq[e]; } }
                const float hv = num / fmaxf(fabsf(den), __expf(-m));
                float* op = O + (size_t)r * OW + B_VW + h * 64 + vc;
                if (dir == 0) *op = hv; else *op += hv;
            }
        }
    }
}
DEV void ph_headln(const P& p, int l, int gtid, int nth, int h0 = 0) {
    const float* O = wsf(p, WS_Y); const bf16* Z = wsb(p, WS_ACT); bf16* Y = wsb(p, WS_U);
    for (long it = gtid; it < (long)M * (BH + CH - h0); it += nth) {
        const int r = (int)(it % M); const int hh = h0 + (int)(it / M);
        const float* o = O + (size_t)r * OW + hh * 64;
        float mu = 0.f;
#pragma unroll
        for (int d = 0; d < 64; ++d) mu += o[d];
        mu *= (1.f / 64.f); float var = 0.f;
#pragma unroll
        for (int d = 0; d < 64; ++d) { const float x = o[d] - mu; var += x * x; }
        const float rs = 1.f / sqrtf(var * (1.f / 64.f) + EPS);
        const bool isb = hh < BH; const int h = isb ? hh : hh - BH;
        const float* g = isb ? prm(p, PRM_GNORM) + l * B_VW + h * 64 : prm(p, PRM_MNORM) + l * C_W + h * 64;
        const bf16* zg = Z + (size_t)r * ZP + (isb ? ZBG : ZCO) + h * 64;
        bf16* y = Y + (size_t)r * DM + A_OUT + hh * 64;
#pragma unroll
        for (int d = 0; d < 64; ++d) { const float gz = bf2f(zg[d]); const float gate = isb ? siluf(gz) : sigmf(gz); y[d] = f2bf(gate * (o[d] - mu) * rs * g[d]); }
    }
}

#ifndef CPU_EMU
namespace pg8 {
#define PG8_LAS __attribute__((address_space(3)))
typedef unsigned short bf16_t;
typedef short bf16x8 __attribute__((ext_vector_type(8)));
typedef float f32x4 __attribute__((ext_vector_type(4)));
typedef unsigned u32x4 __attribute__((ext_vector_type(4)));
constexpr int BM = 256, BK = 64, HALF = 128, HTB = HALF * BK * 2  , STAGE_BYTES = 8 * HTB, NXCD = 8, WGM = 8;

__host__ __device__ __forceinline__ int lds_byte(int r, int c) { const int st = (r >> 4) * 2 + (c >> 5), rr = r & 15, cc = c & 31, ob = rr * 64 + cc * 2; return st * 1024 + (ob ^ (((ob >> 9) & 1) << 5)); }
__host__ __device__ __forceinline__ void stage_rc(int b, int& R, int& C) { const int st = b / 1024, sb = b % 1024, swz = sb ^ (((sb >> 9) & 1) << 5); R = (st >> 1) * 16 + swz / 64; C = (st & 1) * 32 + (swz % 64) / 2; }
__host__ __device__ __forceinline__ int perm32(int rho) { const int n = rho >> 4, i = rho & 15; return 8 * (i >> 2) + 4 * n + (i & 3); }

struct Unit { int pm, pn; };
struct Gemm { const bf16_t* A; const bf16_t* Bt; int M, N, K; int ld = 0; };

struct StaticOrder {
    int nM, nN, nwg, G, c;
    __host__ __device__ void init(int M, int N, int G_, int c_) { nM = M / BM; nN = N / BM; nwg = nM * nN; G = G_; c = c_; }
    __host__ __device__ bool next(int i, Unit& u) const {
        const long L = (long)i * G + c; if (L >= nwg) return false;
        int wgid = (int)L; { const int q = nwg / NXCD, r = nwg % NXCD, xcd = wgid % NXCD, off = wgid / NXCD; wgid = (xcd < r ? xcd * (q + 1) : r * (q + 1) + (xcd - r) * q) + off; }
        const int nig = WGM * nN, gid = wgid / nig, fm = gid * WGM, gsz = (nM - fm) < WGM ? (nM - fm) : WGM;
        u.pm = fm + ((wgid % nig) % gsz); u.pn = (wgid % nig) / gsz; return true;
    }
    __device__ __forceinline__ void a_ready(const Unit&) const {}
    __device__ __forceinline__ void done(const Unit&) const {}
};

__device__ __forceinline__ unsigned cvt_pk_bf16(float lo, float hi) { unsigned r; asm volatile("v_cvt_pk_bf16_f32 %0, %1, %2" : "=v"(r) : "v"(lo), "v"(hi)); return r; }
typedef float f32x2 __attribute__((ext_vector_type(2)));

struct EpiPlain {
    static constexpr bool PERM = true, AFTER_DRAIN = false;
    bf16_t* O; int ldc; const float* bias;
    __device__ __forceinline__ void operator()(const f32x4 (&acc)[2][2][4][2], const Unit& u, int wr, int wc, int fr, int fq) const {
        const int row0 = u.pm * BM + wr * 64 + fr; const int col0 = u.pn * BM + wc * 32 + 8 * fq;
        f32x4 bv[2][2];
#pragma unroll
        for (int bj = 0; bj < 2; ++bj)
#pragma unroll
            for (int n = 0; n < 2; ++n) bv[bj][n] = bias ? *(const f32x4*)(bias + col0 + bj * HALF + 4 * n) : (f32x4){0.f, 0.f, 0.f, 0.f};
#pragma unroll
        for (int ai = 0; ai < 2; ++ai)
#pragma unroll
            for (int m = 0; m < 4; ++m) { bf16_t* rowp = O + (size_t)(row0 + ai * HALF + m * 16) * ldc + col0;
#pragma unroll
                for (int bj = 0; bj < 2; ++bj) { const f32x4 v0 = acc[ai][bj][m][0] + bv[bj][0], v1 = acc[ai][bj][m][1] + bv[bj][1];
                    u32x4 w; w.x = cvt_pk_bf16(v0[0], v0[1]); w.y = cvt_pk_bf16(v0[2], v0[3]); w.z = cvt_pk_bf16(v1[0], v1[1]); w.w = cvt_pk_bf16(v1[2], v1[3]);
                    *(u32x4*)(rowp + bj * HALF) = w; } }
    }
};
struct RoundOrder : StaticOrder { int rnd;
    __host__ __device__ bool next(int i, Unit& u) const { return i == 0 && StaticOrder::next(rnd, u); } };
struct PanelSS {
    float* xbuf; unsigned* cnt;
    __device__ __forceinline__ void run(const f32x4 (&v)[2][2][4][2], const Unit& u, int wr, int wc, int fr, int fq, PG8_LAS unsigned char* lds, int wid, int lane) const {
        PG8_LAS float* Pt = (PG8_LAS float*)lds;
        PG8_LAS float* S = (PG8_LAS float*)(lds + 8192);
#pragma unroll
        for (int ai = 0; ai < 2; ++ai)
#pragma unroll
            for (int m = 0; m < 4; ++m) { float s = 0.f;
#pragma unroll
                for (int bj = 0; bj < 2; ++bj)
#pragma unroll
                    for (int n = 0; n < 2; ++n) { const f32x4 x = v[ai][bj][m][n]; s += (x[0] * x[0] + x[1] * x[1]) + (x[2] * x[2] + x[3] * x[3]); }
                s += __shfl_xor(s, 16); s += __shfl_xor(s, 32);
                if (fq == 0) Pt[(ai * HALF + wr * 64 + m * 16 + fr) * 4 + wc] = s; }
        asm volatile("s_waitcnt lgkmcnt(0)" ::: "memory"); __builtin_amdgcn_s_barrier(); asm volatile("" ::: "memory");
        const int row = wid * 32 + (lane & 31);
        if (lane < 32) { const float t = (Pt[row * 4 + 0] + Pt[row * 4 + 1]) + (Pt[row * 4 + 2] + Pt[row * 4 + 3]);
            __hip_atomic_store((unsigned*)xbuf + ((size_t)(u.pm * BM + row) * 4 + u.pn), __float_as_uint(t), __ATOMIC_RELAXED, __HIP_MEMORY_SCOPE_AGENT); }
        asm volatile("s_waitcnt vmcnt(0)" ::: "memory");
        if (lane == 0) __hip_atomic_fetch_add(cnt + 64 * u.pm, 1u, __ATOMIC_RELAXED, __HIP_MEMORY_SCOPE_AGENT);
        if (wid == 0) { unsigned sp = 0;
            while ((unsigned)__builtin_amdgcn_readfirstlane(__hip_atomic_load(cnt + 64 * u.pm, __ATOMIC_RELAXED, __HIP_MEMORY_SCOPE_AGENT)) < 32u) { __builtin_amdgcn_s_sleep(2); if (++sp > (1u << 20)) break; }
            __builtin_amdgcn_fence(__ATOMIC_ACQUIRE, "agent"); }
        asm volatile("s_waitcnt vmcnt(0) lgkmcnt(0)" ::: "memory"); __builtin_amdgcn_s_barrier(); asm volatile("" ::: "memory");
        if (lane < 32) { const unsigned* slot = (const unsigned*)xbuf + (size_t)(u.pm * BM + row) * 4; float t = 0.f;
#pragma unroll
            for (int k = 0; k < 4; ++k) t += __uint_as_float(__hip_atomic_load(slot + k, __ATOMIC_RELAXED, __HIP_MEMORY_SCOPE_AGENT));
            S[row] = t; }
        asm volatile("s_waitcnt vmcnt(0) lgkmcnt(0)" ::: "memory"); __builtin_amdgcn_s_barrier(); asm volatile("" ::: "memory");
    }
};
struct EpiFinal {
    static constexpr bool PERM = false, AFTER_DRAIN = true;
    const bf16_t* hb; float* out; const float* pmv0; int seq; float eps; PanelSS st;
    __device__ __forceinline__ void fused(f32x4 (&acc)[2][2][4][2], const Unit& u, int wr, int wc, int fr, int fq, PG8_LAS unsigned char* lds, int wid, int lane) const {
        const PG8_LAS float* S = (const PG8_LAS float*)(lds + 8192);
        st.run(acc, u, wr, wc, fr, fq, lds, wid, lane);
        const int col0 = u.pn * BM + wc * 32 + 4 * fq; const float* pm = pmv0 + (size_t)((u.pm * BM) / seq) * 1024;
        f32x4 pv[2][2];
#pragma unroll
        for (int bj = 0; bj < 2; ++bj)
#pragma unroll
            for (int n = 0; n < 2; ++n) pv[bj][n] = *(const f32x4*)(pm + col0 + bj * HALF + n * 16);
#pragma unroll
        for (int ai = 0; ai < 2; ++ai)
#pragma unroll
            for (int m = 0; m < 4; ++m) { const int r = ai * HALF + wr * 64 + m * 16 + fr; const float rs = __builtin_amdgcn_rsqf(S[r] * (1.f / 1024.f) + eps); const size_t off = (size_t)(u.pm * BM + r) * 1024 + col0;
#pragma unroll
                for (int bj = 0; bj < 2; ++bj)
#pragma unroll
                    for (int n = 0; n < 2; ++n) { const f32x2 hw = *(const f32x2*)(hb + off + bj * HALF + n * 16); const unsigned h0 = __float_as_uint(hw.x), h1 = __float_as_uint(hw.y);
                        const f32x4 hv = {__uint_as_float(h0 << 16), __uint_as_float(h0 & 0xffff0000u), __uint_as_float(h1 << 16), __uint_as_float(h1 & 0xffff0000u)};
                        *(f32x4*)(out + off + bj * HALF + n * 16) = hv + pv[bj][n] * acc[ai][bj][m][n] * rs; }
                asm volatile("" ::: "memory"); }
    }
};
struct EpiMid {
    static constexpr bool PERM = true, AFTER_DRAIN = true;
    bf16_t* hb; bf16_t* uo; const float* pmv0; const float* av0; const float* bv0; int seq; float eps; PanelSS st1, st2;
    __device__ __forceinline__ void fused(f32x4 (&acc)[2][2][4][2], const Unit& u, int wr, int wc, int fr, int fq, PG8_LAS unsigned char* lds, int wid, int lane) const {
        const PG8_LAS float* S = (const PG8_LAS float*)(lds + 8192);
        st1.run(acc, u, wr, wc, fr, fq, lds, wid, lane);
        const int col0 = u.pn * BM + wc * 32 + 8 * fq; const size_t vo = (size_t)((u.pm * BM) / seq) * 1024;
        { f32x4 pv[2][2];
#pragma unroll
          for (int bj = 0; bj < 2; ++bj)
#pragma unroll
              for (int n = 0; n < 2; ++n) pv[bj][n] = *(const f32x4*)(pmv0 + vo + col0 + bj * HALF + 4 * n);
#pragma unroll
          for (int ai = 0; ai < 2; ++ai)
#pragma unroll
              for (int m = 0; m < 4; ++m) { const int r = ai * HALF + wr * 64 + m * 16 + fr; const float rs = __builtin_amdgcn_rsqf(S[r] * (1.f / 1024.f) + eps); const size_t off = (size_t)(u.pm * BM + r) * 1024 + col0;
#pragma unroll
                  for (int bj = 0; bj < 2; ++bj) { const u32x4 hw = *(const u32x4*)(hb + off + bj * HALF);
                      const f32x4 h0 = {__uint_as_float(hw.x << 16), __uint_as_float(hw.x & 0xffff0000u), __uint_as_float(hw.y << 16), __uint_as_float(hw.y & 0xffff0000u)};
                      const f32x4 h1 = {__uint_as_float(hw.z << 16), __uint_as_float(hw.z & 0xffff0000u), __uint_as_float(hw.w << 16), __uint_as_float(hw.w & 0xffff0000u)};
                      const f32x4 n0 = h0 + pv[bj][0] * acc[ai][bj][m][0] * rs, n1 = h1 + pv[bj][1] * acc[ai][bj][m][1] * rs;
                      u32x4 w; w.x = pkbf(n0[0], n0[1]); w.y = pkbf(n0[2], n0[3]); w.z = pkbf(n1[0], n1[1]); w.w = pkbf(n1[2], n1[3]);
                      *(u32x4*)(hb + off + bj * HALF) = w;
                      acc[ai][bj][m][0] = (f32x4){__uint_as_float(w.x << 16), __uint_as_float(w.x & 0xffff0000u), __uint_as_float(w.y << 16), __uint_as_float(w.y & 0xffff0000u)};
                      acc[ai][bj][m][1] = (f32x4){__uint_as_float(w.z << 16), __uint_as_float(w.z & 0xffff0000u), __uint_as_float(w.w << 16), __uint_as_float(w.w & 0xffff0000u)}; }
                  asm volatile("" ::: "memory"); } }
        st2.run(acc, u, wr, wc, fr, fq, lds, wid, lane);
        { f32x4 av[2][2], bv[2][2];
#pragma unroll
          for (int bj = 0; bj < 2; ++bj)
#pragma unroll
              for (int n = 0; n < 2; ++n) { av[bj][n] = *(const f32x4*)(av0 + vo + col0 + bj * HALF + 4 * n); bv[bj][n] = *(const f32x4*)(bv0 + vo + col0 + bj * HALF + 4 * n); }
#pragma unroll
          for (int ai = 0; ai < 2; ++ai)
#pragma unroll
              for (int m = 0; m < 4; ++m) { const int r = ai * HALF + wr * 64 + m * 16 + fr; const float rs = __builtin_amdgcn_rsqf(S[r] * (1.f / 1024.f) + eps); const size_t off = (size_t)(u.pm * BM + r) * 1024 + col0;
#pragma unroll
                  for (int bj = 0; bj < 2; ++bj) { const f32x4 o0 = acc[ai][bj][m][0] * rs * av[bj][0] + bv[bj][0], o1 = acc[ai][bj][m][1] * rs * av[bj][1] + bv[bj][1];
                      u32x4 w; w.x = pkbf(o0[0], o0[1]); w.y = pkbf(o0[2], o0[3]); w.z = pkbf(o1[0], o1[1]); w.w = pkbf(o1[2], o1[3]);
                      *(u32x4*)(uo + off + bj * HALF) = w; } } }
    }
};
__device__ __forceinline__ float silu_mul(float g, float u) { return g * __builtin_amdgcn_rcpf(1.f + __builtin_amdgcn_exp2f(-g)) * u; }
struct EpiSwiglu {
    static constexpr bool PERM = true, AFTER_DRAIN = false;
    bf16_t* O; int ldc;
    __device__ __forceinline__ void operator()(const f32x4 (&acc)[2][2][4][2], const Unit& u, int wr, int wc, int fr, int fq) const {
        const int row0 = u.pm * BM + wr * 64 + fr; const int col0 = u.pn * HALF + wc * 32 + 8 * fq;
#pragma unroll
        for (int ai = 0; ai < 2; ++ai)
#pragma unroll
            for (int m = 0; m < 4; ++m) { bf16_t* rowp = O + (size_t)(row0 + ai * HALF + m * 16) * ldc + col0;
                const f32x4 g0 = acc[ai][0][m][0], g1 = acc[ai][0][m][1], u0 = acc[ai][1][m][0], u1 = acc[ai][1][m][1];
                u32x4 w; w.x = cvt_pk_bf16(silu_mul(g0[0], u0[0]), silu_mul(g0[1], u0[1])); w.y = cvt_pk_bf16(silu_mul(g0[2], u0[2]), silu_mul(g0[3], u0[3]));
                w.z = cvt_pk_bf16(silu_mul(g1[0], u1[0]), silu_mul(g1[1], u1[1])); w.w = cvt_pk_bf16(silu_mul(g1[2], u1[2]), silu_mul(g1[3], u1[3]));
                *(u32x4*)rowp = w; }
    }
};
template <class Epi, class Sched, bool ALIGN_EPI = false, bool SP2 = false>
__device__ __forceinline__ void gemm_phase(PG8_LAS unsigned char* lds, const Gemm g, const Sched& S, const Epi& E) {
    int tid_ = threadIdx.x; asm volatile("" : "+v"(tid_));
    const int tid = tid_, wid = __builtin_amdgcn_readfirstlane(tid >> 6), lane = tid & 63, wr = wid >> 2, wc = wid & 3, fr = lane & 15, fq = lane >> 4;
    const int K = g.K, nt = K / BK, LD = g.ld ? g.ld : g.K;
    unsigned voffA[2], voffB[2];
#pragma unroll
    for (int i = 0; i < 2; ++i) { int R, C; stage_rc(tid * 16 + i * 8192, R, C); const int Rb = Epi::PERM ? ((R & ~31) + perm32(R & 31)) : R;
        voffA[i] = (unsigned)(R * LD + C) * 2u; voffB[i] = (unsigned)(Rb * LD + C) * 2u; }
    const size_t kstep = (size_t)(BK * 2);
    const size_t hstep = (size_t)HALF * LD * 2;
    const size_t tstep = 2 * hstep;
    const unsigned ldsw = (unsigned)wid * 1024u;
    const int aoff = lds_byte(wr * 64 + fr, fq * 8), boff = lds_byte(wc * 32 + fr, fq * 8);
#define PG8_SA(b, h) (((b) * 2 + (h)) * HTB)
#define PG8_SB(b, h) ((4 + (b) * 2 + (h)) * HTB)
#define PG8_STAGE(bufoff, gbase, voff) do { _Pragma("unroll") for (int _i = 0; _i < 2; ++_i) \
        __builtin_amdgcn_global_load_lds((const unsigned*)((const char*)(gbase) + (voff)[_i]), (PG8_LAS unsigned*)(lds + (bufoff) + ldsw + _i * 8192), 16, 0, 0); } while (0)
#define PG8_LDA(dst, b, h) do { _Pragma("unroll") for (int m = 0; m < 4; ++m) _Pragma("unroll") for (int k = 0; k < 2; ++k) dst[m][k] = *(const PG8_LAS bf16x8*)(lds + PG8_SA(b, h) + aoff + m * 2048 + k * 1024); } while (0)
#define PG8_LDB(dst, b, h) do { _Pragma("unroll") for (int n = 0; n < 2; ++n) _Pragma("unroll") for (int k = 0; k < 2; ++k) dst[n][k] = *(const PG8_LAS bf16x8*)(lds + PG8_SB(b, h) + boff + n * 2048 + k * 1024); } while (0)
#define PG8_MMA(ai, bj, At, Bt) do { __builtin_amdgcn_s_setprio(1); _Pragma("unroll") for (int m = 0; m < 4; ++m) _Pragma("unroll") for (int n = 0; n < 2; ++n) _Pragma("unroll") for (int k = 0; k < 2; ++k) \
        acc[ai][bj][m][n] = __builtin_amdgcn_mfma_f32_16x16x32_bf16(Bt[n][k], At[m][k], acc[ai][bj][m][n], 0, 0, 0); __builtin_amdgcn_s_setprio(0); } while (0)
#define PG8_WAIT_V(n) asm volatile("s_waitcnt vmcnt(" #n ")" ::: "memory")
#define PG8_WAIT_L(n) asm volatile("s_waitcnt lgkmcnt(" #n ")" ::: "memory")
#define PG8_BAR __builtin_amdgcn_s_barrier()
#define PG8_SCHED __builtin_amdgcn_sched_barrier(0)
    Unit cur, nxt; int ui = 0;
    if (!S.next(0, cur)) return;
    f32x4 acc[2][2][4][2];
#pragma unroll
    for (int a = 0; a < 2; ++a)
#pragma unroll
        for (int b = 0; b < 2; ++b)
#pragma unroll
            for (int m = 0; m < 4; ++m)
#pragma unroll
                for (int n = 0; n < 2; ++n) acc[a][b][m][n] = (f32x4){0.f, 0.f, 0.f, 0.f};
    bf16x8 At[4][2], B0[2][2], B1[2][2];
    const char* cA = (const char*)g.A + (size_t)cur.pm * tstep; const char* cB = (const char*)g.Bt + (size_t)cur.pn * tstep;
    S.a_ready(cur);
    if constexpr (SP2) {
        PG8_STAGE(PG8_SB(0, 0), cB, voffB); PG8_STAGE(PG8_SB(0, 1), cB + hstep, voffB); PG8_STAGE(PG8_SA(0, 0), cA, voffA); PG8_STAGE(PG8_SA(0, 1), cA + hstep, voffA);
        if (wr == 1) PG8_BAR;
        PG8_WAIT_V(2); PG8_BAR;
        PG8_STAGE(PG8_SB(1, 0), cB + kstep, voffB); PG8_STAGE(PG8_SA(1, 0), cA + kstep, voffA); PG8_STAGE(PG8_SB(1, 1), cB + hstep + kstep, voffB);
        PG8_WAIT_V(6); PG8_BAR;
    } else {
        PG8_STAGE(PG8_SB(0, 0), cB, voffB); PG8_STAGE(PG8_SA(0, 0), cA, voffA); PG8_STAGE(PG8_SB(0, 1), cB + hstep, voffB); PG8_STAGE(PG8_SA(0, 1), cA + hstep, voffA);
        if (wr == 1) PG8_BAR;
        PG8_WAIT_V(4); PG8_BAR;
        PG8_STAGE(PG8_SB(1, 0), cB + kstep, voffB); PG8_STAGE(PG8_SA(1, 0), cA + kstep, voffA); PG8_STAGE(PG8_SB(1, 1), cB + hstep + kstep, voffB);
        PG8_WAIT_V(6); PG8_BAR;
    }
    for (;;) {
        const bool has_next = S.next(ui + 1, nxt);
        const char* nA = has_next ? (const char*)g.A + (size_t)nxt.pm * tstep : cA; const char* nB = has_next ? (const char*)g.Bt + (size_t)nxt.pn * tstep : cB;
        for (int t = 0; t < nt; t += 2) {
            const bool last = (t == nt - 2);
            const char* a1 = cA + (size_t)(t + 1) * kstep;
            const char* a2 = last ? nA : cA + (size_t)(t + 2) * kstep; const char* b2 = last ? nB : cB + (size_t)(t + 2) * kstep;
            const char* a3 = a2 + kstep; const char* b3 = b2 + kstep;
            if (last && has_next) S.a_ready(nxt);
            if constexpr (SP2) {
            PG8_LDB(B0, 0, 0); PG8_LDB(B1, 0, 1); PG8_SCHED; PG8_LDA(At, 0, 0); PG8_STAGE(PG8_SA(1, 1), a1 + hstep, voffA);
            PG8_WAIT_V(8); PG8_WAIT_L(0); PG8_BAR; PG8_MMA(0, 0, At, B0); PG8_MMA(0, 1, At, B1); PG8_BAR; PG8_SCHED;
            PG8_LDA(At, 0, 1); PG8_STAGE(PG8_SB(0, 0), b2, voffB); PG8_STAGE(PG8_SB(0, 1), b2 + hstep, voffB); PG8_STAGE(PG8_SA(0, 0), a2, voffA);
            PG8_WAIT_V(8); PG8_WAIT_L(0); PG8_BAR; PG8_MMA(1, 0, At, B0); PG8_MMA(1, 1, At, B1); PG8_BAR; PG8_SCHED;
            PG8_LDB(B0, 1, 0); PG8_LDB(B1, 1, 1); PG8_SCHED; PG8_LDA(At, 1, 0); PG8_STAGE(PG8_SA(0, 1), a2 + hstep, voffA);
            PG8_WAIT_V(8); PG8_WAIT_L(0); PG8_BAR; PG8_MMA(0, 0, At, B0); PG8_MMA(0, 1, At, B1); PG8_BAR; PG8_SCHED;
            PG8_LDA(At, 1, 1); PG8_STAGE(PG8_SB(1, 0), b3, voffB); PG8_STAGE(PG8_SB(1, 1), b3 + hstep, voffB); PG8_STAGE(PG8_SA(1, 0), a3, voffA);
            PG8_WAIT_V(8); PG8_WAIT_L(0); PG8_BAR; PG8_MMA(1, 0, At, B0); PG8_MMA(1, 1, At, B1); PG8_BAR; PG8_SCHED;
            } else {
            PG8_LDB(B0, 0, 0); PG8_SCHED; PG8_LDA(At, 0, 0); PG8_STAGE(PG8_SA(1, 1), a1 + hstep, voffA);
            PG8_WAIT_L(8); PG8_BAR; PG8_WAIT_L(0); PG8_MMA(0, 0, At, B0); PG8_BAR; PG8_SCHED;
            PG8_LDB(B1, 0, 1); PG8_STAGE(PG8_SB(0, 0), b2, voffB);
            PG8_BAR; PG8_WAIT_L(0); PG8_MMA(0, 1, At, B1); PG8_BAR;
            PG8_LDA(At, 0, 1); PG8_STAGE(PG8_SA(0, 0), a2, voffA);
            PG8_BAR; PG8_WAIT_L(0); PG8_MMA(1, 0, At, B0); PG8_BAR; PG8_SCHED;
            PG8_STAGE(PG8_SB(0, 1), b2 + hstep, voffB);
            PG8_WAIT_V(6); PG8_BAR; PG8_MMA(1, 1, At, B1); PG8_BAR;
            PG8_LDB(B0, 1, 0); PG8_SCHED; PG8_LDA(At, 1, 0); PG8_STAGE(PG8_SA(0, 1), a2 + hstep, voffA);
            PG8_WAIT_L(8); PG8_BAR; PG8_WAIT_L(0); PG8_MMA(0, 0, At, B0); PG8_BAR; PG8_SCHED;
            PG8_LDB(B1, 1, 1); PG8_STAGE(PG8_SB(1, 0), b3, voffB);
            PG8_BAR; PG8_WAIT_L(0); PG8_MMA(0, 1, At, B1); PG8_BAR;
            PG8_LDA(At, 1, 1); PG8_STAGE(PG8_SA(1, 0), a3, voffA);
            PG8_BAR; PG8_WAIT_L(0); PG8_MMA(1, 0, At, B0); PG8_BAR; PG8_SCHED;
            PG8_STAGE(PG8_SB(1, 1), b3 + hstep, voffB);
            PG8_WAIT_V(6); PG8_BAR; PG8_MMA(1, 1, At, B1); PG8_BAR;
            }
        }
        if constexpr (ALIGN_EPI) { if (wr == 0) PG8_BAR; }
        if constexpr (!Epi::AFTER_DRAIN) { E(acc, cur, wr, wc, fr, fq); S.done(cur); }
        if (!has_next) break;
#pragma unroll
        for (int a = 0; a < 2; ++a)
#pragma unroll
            for (int b = 0; b < 2; ++b)
#pragma unroll
                for (int m = 0; m < 4; ++m)
#pragma unroll
                    for (int n = 0; n < 2; ++n) acc[a][b][m][n] = (f32x4){0.f, 0.f, 0.f, 0.f};
        cur = nxt; cA = nA; cB = nB; ++ui;
        if constexpr (ALIGN_EPI) { if (wr == 1) PG8_BAR; }
    }
    PG8_WAIT_V(0);
    if constexpr (!ALIGN_EPI) { if (wr == 0) PG8_BAR; }
    PG8_BAR;
    if constexpr (Epi::AFTER_DRAIN) { E.fused(acc, cur, wr, wc, fr, fq, lds, wid, lane); S.done(cur); }
#undef PG8_SA
#undef PG8_SB
#undef PG8_STAGE
#undef PG8_LDA
#undef PG8_LDB
#undef PG8_MMA
#undef PG8_WAIT_V
#undef PG8_WAIT_L
#undef PG8_BAR
#undef PG8_SCHED
}
}

#define XB_TMO      128
#define XB_XCNT(j)  (256  + 64 * (j))
#define XB_XSUB(j)  (1280 + 64 * (j))
#define XB_XGEN(j)  (2304 + 64 * (j))
#define XB_TOP      3328
#define XB_TOPGEN   3392
#define XCD_BAR_WORDS 3456
#define XB_SPIN_CAP (1u << 18)
#define LAS __attribute__((address_space(3)))

__device__ __forceinline__ unsigned xb_ld(unsigned* p)              { return __hip_atomic_load(p, __ATOMIC_RELAXED, __HIP_MEMORY_SCOPE_AGENT); }
__device__ __forceinline__ unsigned xb_add(unsigned* p, unsigned v) { return __hip_atomic_fetch_add(p, v, __ATOMIC_RELAXED, __HIP_MEMORY_SCOPE_AGENT); }
__device__ __forceinline__ unsigned xb_xcc_id() { return (unsigned)__builtin_amdgcn_s_getreg((3 << 11) | 20) & 0xFu; }
#define XB_SPIN(cond, bar) do { unsigned _sp = 0; while (cond) { __builtin_amdgcn_s_sleep(1); \
    if ((++_sp & 255u) == 0u) { if (xb_ld(&(bar)[XB_TMO])) break; if (_sp > XB_SPIN_CAP) { atomicAdd(&(bar)[XB_TMO], 1u); break; } } } } while (0)

struct XcdBarrier {
    unsigned* bar; unsigned x;
    volatile LAS unsigned* st;
};

__device__ __forceinline__ XcdBarrier xcd_barrier_post(unsigned* bar, volatile LAS unsigned* st) {
    XcdBarrier b; b.bar = bar; b.x = xb_xcc_id(); b.st = st;
    if (threadIdx.x == 0) (void)xb_add(&bar[XB_XCNT(b.x)], 1u);
    return b;
}
__device__ __forceinline__ void xcd_barrier_complete(unsigned* bar, unsigned x, unsigned& nloc, unsigned& nx) {
    const unsigned G = gridDim.x * gridDim.y * gridDim.z;
    unsigned sum, cnt, mine, sp = 0u;
    for (;;) {
        sum = 0u; cnt = 0u; mine = 0u;
#pragma unroll
        for (unsigned j = 0; j < 16; ++j) { const unsigned c = xb_ld(&bar[XB_XCNT(j)]); sum += c; cnt += (c > 0u) ? 1u : 0u; mine = (j == x) ? c : mine; }
        if (sum == G) break;
        __builtin_amdgcn_s_sleep(1);
        if ((++sp & 255u) == 0u) { if (xb_ld(&bar[XB_TMO])) break; if (sp > XB_SPIN_CAP) { atomicAdd(&bar[XB_TMO], 1u); break; } }
    }
    nloc = mine > 0u ? mine : 1u; nx = cnt > 0u ? cnt : 1u;
}

__device__ __forceinline__ void xcd_barrier(const XcdBarrier& b) {
    asm volatile("s_waitcnt vmcnt(0)" ::: "memory");
    __syncthreads();
    if (threadIdx.x == 0) {
        unsigned* bar = b.bar;
        __builtin_amdgcn_s_waitcnt(0);
        unsigned nloc = b.st[0], nx = b.st[1];
        if (nloc == 0u) { xcd_barrier_complete(bar, b.x, nloc, nx); b.st[0] = nloc; b.st[1] = nx; }
        const unsigned old = xb_add(&bar[XB_XSUB(b.x)], 1u);
        const unsigned gen = old / nloc;
        if (old + 1u == (gen + 1u) * nloc) {
            __builtin_amdgcn_fence(__ATOMIC_RELEASE, "agent");
            asm volatile("s_waitcnt vmcnt(0)" ::: "memory");
            const unsigned og = xb_add(&bar[XB_TOP], 1u);
            const unsigned tg = og / nx;
            if (og + 1u == (tg + 1u) * nx) xb_add(&bar[XB_TOPGEN], 1u);
            else XB_SPIN(xb_ld(&bar[XB_TOPGEN]) == tg, bar);
            __builtin_amdgcn_fence(__ATOMIC_ACQUIRE, "agent");
            xb_add(&bar[XB_XGEN(b.x)], 1u);
            asm volatile("s_waitcnt vmcnt(0)" ::: "memory");
        } else {
            XB_SPIN(xb_ld(&bar[XB_XGEN(b.x)]) == gen, bar);
            __builtin_amdgcn_fence(__ATOMIC_ACQUIRE, "agent");
            asm volatile("s_waitcnt vmcnt(0)" ::: "memory");
        }
    }
    __syncthreads();
}

#define GAS __attribute__((address_space(1)))
typedef float f32x4 __attribute__((ext_vector_type(4)));
typedef unsigned v4u __attribute__((ext_vector_type(4)));
typedef unsigned v2u __attribute__((ext_vector_type(2)));
constexpr int NWAVES = 8, NTHREADS = NWAVES * 64;
constexpr int RING_BYTES = 131072, LDS_BYTES = 147456, MISC_OFF = LDS_BYTES - 512;
constexpr int CW_BAR = 4096;
static_assert((CW_BAR + XCD_BAR_WORDS) * 4 <= (int)CTL_BYTES, "ctl");
constexpr int CW_PAN = 16384;
constexpr int CW_SUB = 8192, NSUBWG = 64;
__device__ __forceinline__ void sub_barrier(unsigned* cnt, unsigned target) {
    asm volatile("s_waitcnt vmcnt(0)" ::: "memory");
    __syncthreads();
    if (threadIdx.x == 0) {
        __builtin_amdgcn_fence(__ATOMIC_RELEASE, "agent"); asm volatile("s_waitcnt vmcnt(0)" ::: "memory");
        (void)xb_add(cnt, 1u);
        unsigned sp = 0; while (xb_ld(cnt) < target) { __builtin_amdgcn_s_sleep(1); if (++sp > XB_SPIN_CAP) break; }
        __builtin_amdgcn_fence(__ATOMIC_ACQUIRE, "agent"); asm volatile("s_waitcnt vmcnt(0)" ::: "memory");
    }
    __syncthreads();
}

template <int CTRL, int RM> __device__ __forceinline__ float dppf0(float src) { return __int_as_float(__builtin_amdgcn_update_dpp(0, __float_as_int(src), CTRL, RM, 0xf, false)); }
__device__ __forceinline__ float gla_scan_add(float v) {
    v += dppf0<0x111, 0xf>(v); v += dppf0<0x112, 0xf>(v); v += dppf0<0x114, 0xf>(v); v += dppf0<0x118, 0xf>(v); v += dppf0<0x142, 0xa>(v); v += dppf0<0x143, 0xc>(v); return v; }
__device__ __forceinline__ float wave_sum(float v) {
#pragma unroll
    for (int o = 1; o < 64; o <<= 1) v += __shfl_xor(v, o);
    return v;
}
__device__ __forceinline__ unsigned pk2(float lo, float hi) { return pkbf(lo, hi); }

__device__ __forceinline__ void wt_item(const float* W, int ldw, int lim, int col0, int k0, bf16* WT, int K, int n0, LAS float* scr, int lane, float scl = 1.f) {
    const int cc = col0 + (lane & 31); const bool ok = cc < lim;
    float wv_[32];
#pragma unroll
    for (int i = 0; i < 32; ++i) { const int kk = 2 * i + (lane >> 5); wv_[i] = ok ? W[(size_t)(k0 + kk) * ldw + cc] : 0.f; }
#pragma unroll
    for (int i = 0; i < 32; ++i) { const int kk = 2 * i + (lane >> 5); scr[kk * 33 + (lane & 31)] = wv_[i] * scl; }
    asm volatile("s_waitcnt lgkmcnt(0)" ::: "memory");
    const int c = lane & 7;
#pragma unroll
    for (int j = 0; j < 4; ++j) { const int n = (lane >> 3) + 8 * j; const LAS float* s = scr + (8 * c) * 33 + n;
        v4u o; o.x = pk2(s[0 * 33], s[1 * 33]); o.y = pk2(s[2 * 33], s[3 * 33]); o.z = pk2(s[4 * 33], s[5 * 33]); o.w = pk2(s[6 * 33], s[7 * 33]);
        *(GAS v4u*)(WT + (size_t)(n0 + n) * K + k0 + 8 * c) = o; }
    asm volatile("s_waitcnt lgkmcnt(0)" ::: "memory");
}
constexpr int WCONV_ITEMS = 2 * ((DM / 64) * (2 * DFF / 32)) + 2 * ((DFF / 64) * (DM / 32)) + (DM / 64) * (ZP / 32) + (DM / 64) * (DM / 32);
__device__ __forceinline__ void ph_wconv(const P& p, int l, LAS unsigned char* lds, int gw, int ngw, int wave, int lane, int i0 = 0, int i1 = WCONV_ITEMS) {
    LAS float* scr = (LAS float*)(lds + wave * 16384);
    constexpr int I_GU = (DM / 64) * (2 * DFF / 32), I_D = (DFF / 64) * (DM / 32), I_IN = (DM / 64) * (ZP / 32), I_OUT = (DM / 64) * (DM / 32);
    constexpr int PER_L = 2 * I_GU + 2 * I_D + I_IN + I_OUT;
    static_assert(PER_L == WCONV_ITEMS, "items");
    for (int it = i0 + gw; it < i1; it += ngw) {
        int r = it;
        if (r < 2 * I_GU) { const int sub = r / I_GU; r %= I_GU; const int nblk = 2 * DFF / 32, kb = r / nblk, nb = r % nblk, n0 = nb * 32; const int tile = n0 / 256, w = n0 % 256;
            const float* src = p.in[w < 128 ? (sub ? I_F2G : I_F1G) : (sub ? I_F2U : I_F1U)] + (size_t)l * DM * DFF;
            wt_item(src, DFF, DFF, tile * 128 + (w & 127), kb * 64, wl(p, l, sub ? WL_GU2 : WL_GU1), DM, n0, scr, lane, w < 128 ? 1.4426950408889634f : 0.6931471805599453f); continue; }
        r -= 2 * I_GU;
        if (r < 2 * I_D) { const int sub = r / I_D; r %= I_D; const int nblk = DM / 32, kb = r / nblk, nb = r % nblk;
            wt_item(p.in[sub ? I_F2D : I_F1D] + (size_t)l * DFF * DM, DM, DM, nb * 32, kb * 64, wl(p, l, sub ? WL_D2 : WL_D1), DFF, nb * 32, scr, lane); continue; }
        r -= 2 * I_D;
        if (r < I_IN) { const int nblk = ZP / 32, kb = r / nblk, nb = r % nblk;
            wt_item(p.in[I_WIN] + (size_t)l * DM * INW, INW, INW, nb * 32, kb * 64, wl(p, l, WL_IN), DM, nb * 32, scr, lane); continue; }
        r -= I_IN;
        { const int nblk = DM / 32, kb = r / nblk, nb = r % nblk;
            wt_item(p.in[I_WOUT] + (size_t)l * DM * DM, DM, DM, nb * 32, kb * 64, wl(p, l, WL_OUT), DM, nb * 32, scr, lane); }
    }
}
__device__ __forceinline__ void ph_modpart_gpu(const P& p, LAS unsigned char* lds, int tid, int gtid, int nth) {
    LAS float* sc = (LAS float*)lds;
    for (int i = tid; i < NMOD * DM; i += NTHREADS) { const int b = i / DM, k = i % DM; sc[i] = siluf(b < NB ? p.in[I_C][b * DM + k] : p.in[I_CCTX][k]); }
    __syncthreads();
    constexpr int KS = DM / KSPLIT;
    for (long it = gtid; it < (long)KSPLIT * DEPTH * 9 * DM; it += nth) {
        const int col = (int)(it % (9 * DM)); const int l = (int)((it / (9 * DM)) % DEPTH); const int ks = (int)(it / ((long)9 * DM * DEPTH));
        const float* w = p.in[I_ADAW] + (size_t)l * DM * 9 * DM + col;
        float acc[NMOD];
#pragma unroll
        for (int b = 0; b < NMOD; ++b) acc[b] = 0.f;
        for (int k0 = ks * KS; k0 < (ks + 1) * KS; k0 += 8) { float wv[8];
#pragma unroll
            for (int j = 0; j < 8; ++j) wv[j] = w[(size_t)(k0 + j) * 9 * DM];
#pragma unroll
            for (int j = 0; j < 8; ++j)
#pragma unroll
                for (int b = 0; b < NMOD; ++b) acc[b] += sc[b * DM + k0 + j] * wv[j]; }
#pragma unroll
        for (int b = 0; b < NMOD; ++b) wsf(p, WS_MODP)[(((size_t)ks * DEPTH + l) * NMOD + b) * 9 * DM + col] = acc[b];
    }
    __syncthreads();
}
__device__ __forceinline__ f32x4 up4(v2u w) { return (f32x4){__uint_as_float(w.x << 16), __uint_as_float(w.x & 0xffff0000u), __uint_as_float(w.y << 16), __uint_as_float(w.y & 0xffff0000u)}; }
__device__ __forceinline__ float sq4(f32x4 v) { return (v.x * v.x + v.y * v.y) + (v.z * v.z + v.w * v.w); }
__device__ __forceinline__ f32x4 lo4(v4u w) { return up4((v2u){w.x, w.y}); }
__device__ __forceinline__ f32x4 hi4(v4u w) { return up4((v2u){w.z, w.w}); }
template <bool UPD, bool MK, bool Y2 = false> __device__ __forceinline__ void ph_thin(const P& p, int lu, int su, int lm, int sm, int gw, int ngw, int lane, int mrows = M, int rbase = 0) {
    constexpr int NV = DM / 512, RB = 6;
    const int rpw = (mrows - rbase + ngw - 1) / ngw, rbeg = rbase + gw * rpw, rend = (rbeg + rpw < mrows) ? rbeg + rpw : mrows;
    for (int r0 = rbeg; r0 < rend; r0 += RB) {
        v4u hp[RB][NV], yp[RB][NV]; float ss[RB];
#pragma unroll
        for (int q = 0; q < RB; ++q) { const int r = (r0 + q < rend) ? r0 + q : rend - 1;
            const v4u* hr = (const v4u*)(wsb(p, WS_HB) + (size_t)r * DM); const v4u* yr = (const v4u*)(wsb(p, WS_Y) + (size_t)r * DM);
#pragma unroll
            for (int j = 0; j < NV; ++j) { hp[q][j] = hr[lane + 64 * j]; if (UPD) yp[q][j] = yr[lane + 64 * j]; } }
        if (UPD && Y2) {
            v4u yq[RB][NV];
#pragma unroll
            for (int q = 0; q < RB; ++q) { const int r = (r0 + q < rend) ? r0 + q : rend - 1; const v4u* yr2 = (const v4u*)(wsb(p, WS_HC) + (size_t)(r - ML) * DM);
#pragma unroll
                for (int j = 0; j < NV; ++j) yq[q][j] = yr2[lane + 64 * j]; }
#pragma unroll
            for (int q = 0; q < RB; ++q)
#pragma unroll
                for (int j = 0; j < NV; ++j) { const f32x4 a0 = lo4(yp[q][j]) + lo4(yq[q][j]), a1 = hi4(yp[q][j]) + hi4(yq[q][j]);
                    v4u w; w.x = pk2(a0.x, a0.y); w.y = pk2(a0.z, a0.w); w.z = pk2(a1.x, a1.y); w.w = pk2(a1.z, a1.w); yp[q][j] = w; } }
        if (UPD) {
#pragma unroll
            for (int q = 0; q < RB; ++q) { ss[q] = 0.f;
#pragma unroll
                for (int j = 0; j < NV; ++j) ss[q] += sq4(lo4(yp[q][j])) + sq4(hi4(yp[q][j])); }
#pragma unroll
            for (int q = 0; q < RB; ++q) ss[q] = __int_as_float(__builtin_amdgcn_readlane(__float_as_int(gla_scan_add(ss[q])), 63));
#pragma unroll
            for (int q = 0; q < RB; ++q) { const int r = (r0 + q < rend) ? r0 + q : rend - 1; const bool ok = r0 + q < rend;
                const float rs = __builtin_amdgcn_rsqf(ss[q] * (1.f / DM) + EPS); const f32x4* pm = (const f32x4*)vecp(p, lu, su, 2, modidx(r));
#pragma unroll
                for (int j = 0; j < NV; ++j) { const int c4 = 2 * (lane + 64 * j);
                    const f32x4 h0 = lo4(hp[q][j]) + pm[c4] * lo4(yp[q][j]) * rs, h1 = hi4(hp[q][j]) + pm[c4 + 1] * hi4(yp[q][j]) * rs;
                    if (MK) { v4u w; w.x = pk2(h0.x, h0.y); w.y = pk2(h0.z, h0.w); w.z = pk2(h1.x, h1.y); w.w = pk2(h1.z, h1.w); hp[q][j] = w; if (ok) ((v4u*)(wsb(p, WS_HB) + (size_t)r * DM))[lane + 64 * j] = w; }
                    else if (ok) { f32x4* op = (f32x4*)(p.out + (size_t)r * DM); op[c4] = h0; op[c4 + 1] = h1; } } }
        }
        if (MK) {
#pragma unroll
            for (int q = 0; q < RB; ++q) { ss[q] = 0.f;
#pragma unroll
                for (int j = 0; j < NV; ++j) ss[q] += sq4(lo4(hp[q][j])) + sq4(hi4(hp[q][j])); }
#pragma unroll
            for (int q = 0; q < RB; ++q) ss[q] = __int_as_float(__builtin_amdgcn_readlane(__float_as_int(gla_scan_add(ss[q])), 63));
#pragma unroll
            for (int q = 0; q < RB; ++q) { const int r = r0 + q; if (r < rend) { const int bi = modidx(r);
                const float rs = __builtin_amdgcn_rsqf(ss[q] * (1.f / DM) + EPS);
                const f32x4* a = (const f32x4*)vecp(p, lm, sm, 0, bi); const f32x4* b = (const f32x4*)vecp(p, lm, sm, 1, bi); v4u* ur = (v4u*)(wsb(p, WS_U) + (size_t)r * DM);
#pragma unroll
                for (int j = 0; j < NV; ++j) { const int c4 = 2 * (lane + 64 * j); const f32x4 o0 = lo4(hp[q][j]) * rs * a[c4] + b[c4], o1 = hi4(hp[q][j]) * rs * a[c4 + 1] + b[c4 + 1];
                    v4u w; w.x = pk2(o0.x, o0.y); w.y = pk2(o0.z, o0.w); w.z = pk2(o1.x, o1.y); w.w = pk2(o1.z, o1.w); ur[lane + 64 * j] = w; } } }
        }
    }
}


namespace att {
typedef short bf16x8 __attribute__((ext_vector_type(8)));
typedef short s16x4 __attribute__((ext_vector_type(4)));
typedef float f32x16 __attribute__((ext_vector_type(16)));
constexpr int KBUF = 0, VBUF = 32768, SLOT = 8192;
constexpr float C2 = 0.125f * 1.4426950408889634f;
__device__ __forceinline__ int crow(int r, int hi) { return (r & 3) + 8 * (r >> 2) + 4 * hi; }
typedef float f32x2_t __attribute__((ext_vector_type(2))); typedef __bf16 bf16x2_t __attribute__((ext_vector_type(2)));
__device__ __forceinline__ unsigned cvtpk(float lo, float hi) { const f32x2_t v = {lo, hi}; const bf16x2_t b = __builtin_convertvector(v, bf16x2_t); return __builtin_bit_cast(unsigned, b); }

__device__ __forceinline__ float max3f(float a, float b, float c) { float r; asm("v_max3_f32 %0, %1, %2, %3" : "=v"(r) : "v"(a), "v"(b), "v"(c)); return r; }
__device__ __forceinline__ float max32(float x) { const auto r = __builtin_amdgcn_permlane32_swap(__float_as_uint(x), __float_as_uint(x), false, false); return fmaxf(__uint_as_float(r[0]), __uint_as_float(r[1])); }
__device__ __forceinline__ float sum32(float x) { const auto r = __builtin_amdgcn_permlane32_swap(__float_as_uint(x), __float_as_uint(x), false, false); return __uint_as_float(r[0]) + __uint_as_float(r[1]); }
__device__ __forceinline__ s16x4 vtr(const LAS unsigned char* p) { return __builtin_bit_cast(s16x4, __builtin_amdgcn_ds_read_tr16_b64_v4i16((LAS s16x4*)p)); }

__device__ __forceinline__ void unit(const P& p, LAS unsigned char* lds, int l, int b, int g, int qrow0, int qpos0, int kw0, int ntw, int tid) {
    const int lane = tid & 63, r32 = lane & 31, hi = lane >> 5; const int wave = __builtin_amdgcn_readfirstlane(tid >> 6);
    const int hq = g * AGRP + (wave & 3), qh = wave >> 2;
    const bf16* Z = wsb(p, WS_ACT);
    const int nt = ntw + CTXL / 64;
    const bf16* ksrc = Z + (size_t)lane * ZP + ZK + g * 64 + wave * 8;
    const bf16* vsrc = Z + (size_t)(16 * (wave & 3) + (lane >> 2)) * ZP + ZV + g * 64 + (wave >> 2) * 32 + (lane & 3) * 8;
#define ATT_DMA(t, slot) do { const int kr_ = (t) < ntw ? b * SEQ + kw0 + 64 * (t) : ML + b * CTXL + 64 * ((t) - ntw); \
        __builtin_amdgcn_global_load_lds((const unsigned*)(ksrc + (size_t)kr_ * ZP), (LAS unsigned*)(lds + KBUF + (slot) * SLOT + wave * 1024), 16, 0, 0); \
        __builtin_amdgcn_global_load_lds((const unsigned*)(vsrc + (size_t)kr_ * ZP), (LAS unsigned*)(lds + VBUF + (slot) * SLOT + wave * 1024), 16, 0, 0); } while (0)
#define ATT_DMA2(tp, ps) do { ATT_DMA(2 * (tp), 2 * (ps)); if (2 * (tp) + 1 < nt) ATT_DMA(2 * (tp) + 1, 2 * (ps) + 1); } while (0)
    ATT_DMA2(0, 0);
    bf16x8 qf[1][4];
    { const int j = 0; const bf16* qp = Z + (size_t)(qrow0 + qh * 32 + r32) * ZP + ZQ + hq * 64 + hi * 8;
        v4u x[4]; f32x4 ct[2][4]; const bool lat = qrow0 < ML;
        { const int t = qpos0 + qh * 32 + r32; const float* rt = wsf(p, WS_ROPE);
#pragma unroll
          for (int d0 = 0; d0 < 4; ++d0) x[d0] = *(const v4u*)(qp + d0 * 16);
          if (lat) {
#pragma unroll
            for (int hf = 0; hf < 2; ++hf) { const int pos = hf == 0 ? t / GRIDW : t % GRIDW; const f32x4* cp = (const f32x4*)(rt + 32 * pos + 16 * hi);
#pragma unroll
                for (int c = 0; c < 4; ++c) ct[hf][c] = cp[c]; } } }
        float f[4][8];
#pragma unroll
        for (int d0 = 0; d0 < 4; ++d0) { f[d0][0] = __uint_as_float(x[d0].x << 16); f[d0][1] = __uint_as_float(x[d0].x & 0xffff0000u); f[d0][2] = __uint_as_float(x[d0].y << 16); f[d0][3] = __uint_as_float(x[d0].y & 0xffff0000u);
            f[d0][4] = __uint_as_float(x[d0].z << 16); f[d0][5] = __uint_as_float(x[d0].z & 0xffff0000u); f[d0][6] = __uint_as_float(x[d0].w << 16); f[d0][7] = __uint_as_float(x[d0].w & 0xffff0000u); }
        if (lat) {
#pragma unroll
            for (int hf = 0; hf < 2; ++hf)
#pragma unroll
                for (int e = 0; e < 8; ++e) { const float cs = ct[hf][e >> 1][2 * (e & 1)], sn = ct[hf][e >> 1][2 * (e & 1) + 1], x1 = f[2 * hf][e], x2 = f[2 * hf + 1][e]; f[2 * hf][e] = x1 * cs - x2 * sn; f[2 * hf + 1][e] = x1 * sn + x2 * cs; }
        }
#pragma unroll
        for (int d0 = 0; d0 < 4; ++d0) { v4u y;
            y.x = cvtpk(f[d0][0] * C2, f[d0][1] * C2); y.y = cvtpk(f[d0][2] * C2, f[d0][3] * C2); y.z = cvtpk(f[d0][4] * C2, f[d0][5] * C2); y.w = cvtpk(f[d0][6] * C2, f[d0][7] * C2);
            qf[j][d0] = __builtin_bit_cast(bf16x8, y); } }
    const float sink2 = prm(p, PRM_SINK)[l * AH + hq] * 1.4426950408889634f;
    float m[1] = {sink2}, lsum[1] = {hi == 0 ? 1.f : 0.f};
    f32x16 negm;
#pragma unroll
    for (int r = 0; r < 16; ++r) negm[r] = -sink2;
    f32x16 o[1][2];
#pragma unroll
    for (int j = 0; j < 1; ++j)
#pragma unroll
        for (int dh = 0; dh < 2; ++dh)
#pragma unroll
            for (int r = 0; r < 16; ++r) o[j][dh][r] = 0.f;
    const int npair = (nt + 1) >> 1;
    for (int tp = 0; tp < npair; ++tp) {
        asm volatile("s_waitcnt vmcnt(0)" ::: "memory"); __syncthreads();
        if (tp + 1 < npair) ATT_DMA2(tp + 1, (tp + 1) & 1);
#pragma unroll 1
      for (int sub = 0; sub < 2; ++sub) { const int t = 2 * tp + sub; if (t >= nt) break;
        const int sl = 2 * (tp & 1) + sub;
        const LAS unsigned char* kb = lds + KBUF + sl * SLOT + hi * 1024 + r32 * 16;
        const LAS unsigned char* vb = lds + VBUF + sl * SLOT + ((lane >> 4) & 1) * 32 + (lane & 3) * 8 + (4 * hi + ((lane & 15) >> 2)) * 64;
        bf16x8 kf[2][4], vf[2][4];
#pragma unroll
        for (int d0 = 0; d0 < 4; ++d0) { kf[0][d0] = *(const LAS bf16x8*)(kb + d0 * 2048); kf[1][d0] = *(const LAS bf16x8*)(kb + d0 * 2048 + 512); }
#pragma unroll
        for (int dh = 0; dh < 2; ++dh)
#pragma unroll
            for (int ks = 0; ks < 4; ++ks) { const s16x4 a = vtr(vb + dh * 4096 + ks * 1024), c = vtr(vb + dh * 4096 + ks * 1024 + 512);
                vf[dh][ks] = (bf16x8){a[0], a[1], a[2], a[3], c[0], c[1], c[2], c[3]}; }
        const int kpos = kw0 + 64 * t;
        const bool win = t < ntw && ((kpos + 63 - qpos0 > WIN) || (qpos0 + 63 - kpos > WIN));
#pragma unroll
        for (int j = 0; j < 1; ++j) {
            f32x16 p0 = __builtin_amdgcn_mfma_f32_32x32x16_bf16(kf[0][0], qf[j][0], negm, 0, 0, 0), p1 = __builtin_amdgcn_mfma_f32_32x32x16_bf16(kf[1][0], qf[j][0], negm, 0, 0, 0);
#pragma unroll
            for (int d0 = 1; d0 < 4; ++d0) { p0 = __builtin_amdgcn_mfma_f32_32x32x16_bf16(kf[0][d0], qf[j][d0], p0, 0, 0, 0); p1 = __builtin_amdgcn_mfma_f32_32x32x16_bf16(kf[1][d0], qf[j][d0], p1, 0, 0, 0); }
            asm volatile("s_nop 15\n\ts_nop 7" : "+v"(p0), "+v"(p1));
            if (win) { asm volatile("; window mask" ::: "memory");
                const int qpos = qpos0 + qh * 32 + r32;
#pragma unroll
                for (int r = 0; r < 16; ++r) { const int d0_ = kpos + crow(r, hi) - qpos, d1_ = d0_ + 32;
                    if (d0_ > WIN || d0_ < -WIN) p0[r] = -INFINITY; if (d1_ > WIN || d1_ < -WIN) p1[r] = -INFINITY; } }
            float mxa = max3f(p0[0], p0[1], p1[0]), mxb = max3f(p0[2], p0[3], p1[1]); mxa = max3f(mxa, p1[2], p1[3]);
#pragma unroll
            for (int r = 4; r < 16; r += 4) { mxa = max3f(mxa, p0[r], p0[r + 1]); mxb = max3f(mxb, p0[r + 2], p0[r + 3]); mxa = max3f(mxa, p1[r], p1[r + 1]); mxb = max3f(mxb, p1[r + 2], p1[r + 3]); }
            const float mx = max32(max3f(mxa, mxb, mxb));
            if (__any(mx > 0.f)) {
                const float dl = fmaxf(mx, 0.f), alpha = __builtin_amdgcn_exp2f(-dl); m[j] += dl; lsum[j] *= alpha;
#pragma unroll
                for (int r = 0; r < 16; ++r) { p0[r] -= dl; p1[r] -= dl; negm[r] = -m[j]; }
#pragma unroll
                for (int dh = 0; dh < 2; ++dh)
#pragma unroll
                    for (int r = 0; r < 16; ++r) o[j][dh][r] *= alpha; }
            float rs = 0.f;
#pragma unroll
            for (int r = 0; r < 16; ++r) { p0[r] = __builtin_amdgcn_exp2f(p0[r]); p1[r] = __builtin_amdgcn_exp2f(p1[r]); rs += p0[r] + p1[r]; }
            lsum[j] += rs;
            bf16x8 pf[4];
#pragma unroll
            for (int ks = 0; ks < 4; ++ks) { unsigned w[4];
#pragma unroll
                for (int i = 0; i < 4; ++i) w[i] = (ks < 2) ? cvtpk(p0[8 * ks + 2 * i], p0[8 * ks + 2 * i + 1]) : cvtpk(p1[8 * (ks - 2) + 2 * i], p1[8 * (ks - 2) + 2 * i + 1]);
                v4u wv = {w[0], w[1], w[2], w[3]}; pf[ks] = __builtin_bit_cast(bf16x8, wv); }
#pragma unroll
            for (int dh = 0; dh < 2; ++dh)
#pragma unroll
                for (int ks = 0; ks < 4; ++ks) o[j][dh] = __builtin_amdgcn_mfma_f32_32x32x16_bf16(vf[dh][ks], pf[ks], o[j][dh], 0, 0, 0);
        }
      }
    }
    bf16* Y = wsb(p, WS_U);
#pragma unroll
    for (int j = 0; j < 1; ++j) { const float lt = sum32(lsum[j]); const float inv = __builtin_amdgcn_rcpf(lt);
        bf16* yp = Y + (size_t)(qrow0 + qh * 32 + r32) * DM + hq * 64 + 4 * hi;
#pragma unroll
        for (int dh = 0; dh < 2; ++dh)
#pragma unroll
            for (int rg = 0; rg < 4; ++rg) { v2u w; w.x = cvtpk(o[j][dh][4 * rg] * inv, o[j][dh][4 * rg + 1] * inv); w.y = cvtpk(o[j][dh][4 * rg + 2] * inv, o[j][dh][4 * rg + 3] * inv);
                *(v2u*)(yp + 32 * dh + 8 * rg) = w; } }
    __syncthreads();
#undef ATT_DMA2
#undef ATT_DMA
}
__device__ __forceinline__ void phase(const P& p, LAS unsigned char* lds, int l, bool ctxq, int tid) {
    constexpr int NQB = SEQ / 64, NLAT = NB * AKV * NQB, NCQ = CTXL / 64, NCTX = NB * AKV * NCQ;
    const int G = gridDim.x; const int vcu = (G % 8 == 0) ? ((int)blockIdx.x % 8) * (G / 8) + (int)blockIdx.x / 8 : (int)blockIdx.x;
    const int per = (NLAT + G - 1) / G;
    for (int i = 0; i < per; ++i) { const int u = vcu * per + i; if (u >= NLAT) break;
        const int qb = u % NQB, g = (u / NQB) % AKV, b = u / (NQB * AKV);
        const int kw0 = (64 * qb - WIN < 0) ? 0 : 64 * qb - WIN; const int kend = (64 * qb + 64 + WIN > SEQ) ? SEQ : 64 * qb + 64 + WIN;
        unit(p, lds, l, b, g, b * SEQ + 64 * qb, 64 * qb, kw0, (kend - kw0) / 64, tid); }
    if (ctxq) for (int v = vcu; v < NCTX; v += G) { const int cq = v % NCQ, g = (v / NCQ) % AKV, b = v / (NCQ * AKV);
        unit(p, lds, l, b, g, ML + b * CTXL + 64 * cq, 0, 0, 0, tid); }
}
}

namespace gla {
using att::bf16x8; using att::s16x4; using att::f32x16; using att::crow; using att::cvtpk; using att::vtr;
constexpr int NCC = CTXL / 64, NCL = SEQ / 64, NCH = NCC + NCL;
constexpr int WREG = 17408;
constexpr int L_Q = 0, L_K = 4096, L_V = 8192;
constexpr int PB = 17;
__device__ __forceinline__ int chunk_row0(int b, int dir, int n) {
    if (n < NCC) { const int c = dir ? NCC - 1 - n : n; return ML + b * CTXL + 64 * c; }
    const int c = dir ? NCL - 1 - (n - NCC) : n - NCC; return b * SEQ + 64 * c;
}
__device__ __forceinline__ int chain_index(int t, int dir) { return !dir ? t : (t < NCC ? NCC - 1 - t : NCC + NCL - 1 - (t - NCC)); }
__device__ __forceinline__ int nat_row0(int b, int t) { return t < NCC ? ML + b * CTXL + 64 * t : b * SEQ + 64 * (t - NCC); }
__device__ __forceinline__ bf16* stg(const P& p) { return wsb(p, WS_SG); }
__device__ __forceinline__ float* dec(const P& p) { return wsf(p, WS_GST); }

__device__ __forceinline__ void load_v_issue(const bf16* Z, int row0, int vcol, int lane, v4u (&x)[8]) {
#pragma unroll
    for (int i = 0; i < 8; ++i) { const int idx = i * 64 + lane, s = idx >> 3, c = idx & 7; x[i] = *(const v4u*)(Z + (size_t)(row0 + s) * ZP + vcol + c * 8); }
}
__device__ __forceinline__ void load_v_store(LAS unsigned char* w, int lane, const v4u (&x)[8]) {
#pragma unroll
    for (int i = 0; i < 8; ++i) { const int idx = i * 64 + lane, s = idx >> 3, c = idx & 7; *(LAS v4u*)(w + L_V + ((c >> 2) * 4 + (s >> 4)) * 1024 + (s & 15) * 64 + (c & 3) * 16) = x[i]; }
}
__device__ __forceinline__ void load_v(const bf16* Z, int row0, int vcol, LAS unsigned char* w, int lane) { v4u x[8]; load_v_issue(Z, row0, vcol, lane, x); load_v_store(w, lane, x); }
template <int CTRL, int RM> __device__ __forceinline__ float dppf(float old, float src) { return __int_as_float(__builtin_amdgcn_update_dpp(__float_as_int(old), __float_as_int(src), CTRL, RM, 0xf, false)); }
__device__ __forceinline__ float scan_add_dpp(float v) {
    v += dppf<0x111, 0xf>(0.f, v); v += dppf<0x112, 0xf>(0.f, v); v += dppf<0x114, 0xf>(0.f, v); v += dppf<0x118, 0xf>(0.f, v);
    v += dppf<0x142, 0xa>(0.f, v); v += dppf<0x143, 0xc>(0.f, v); return v; }
__device__ __forceinline__ float scan_max_dpp(float v) {
    constexpr float NI = -3.0e38f;
    v = fmaxf(v, dppf<0x111, 0xf>(NI, v)); v = fmaxf(v, dppf<0x112, 0xf>(NI, v)); v = fmaxf(v, dppf<0x114, 0xf>(NI, v)); v = fmaxf(v, dppf<0x118, 0xf>(NI, v));
    v = fmaxf(v, dppf<0x142, 0xa>(NI, v)); v = fmaxf(v, dppf<0x143, 0xc>(NI, v)); return v; }
constexpr int L_BL = 16384;
__device__ __forceinline__ void up8(v4u x, float* f) { f[0] = __uint_as_float(x.x << 16); f[1] = __uint_as_float(x.x & 0xffff0000u); f[2] = __uint_as_float(x.y << 16); f[3] = __uint_as_float(x.y & 0xffff0000u);
    f[4] = __uint_as_float(x.z << 16); f[5] = __uint_as_float(x.z & 0xffff0000u); f[6] = __uint_as_float(x.w << 16); f[7] = __uint_as_float(x.w & 0xffff0000u); }
struct PrepRaw { v4u b[4], k[4], q[4]; };
template <bool WQ> __device__ __forceinline__ void prep_issue(const P& p, int row0, int h, int dir, int lane, PrepRaw& r) {
    const int t = dir ? 63 - lane : lane;
    const bf16* zr = wsb(p, WS_ACT) + (size_t)(row0 + t) * ZP; const bf16* gp = wsb(p, WS_GA) + ((size_t)dir * M + row0 + t) * B_KW + h * 32;
#pragma unroll
    for (int c4 = 0; c4 < 4; ++c4) { r.b[c4] = *(const v4u*)(gp + 8 * c4); r.k[c4] = *(const v4u*)(zr + ZBK + h * 32 + 8 * c4); if (WQ) r.q[c4] = *(const v4u*)(zr + ZBQ + h * 32 + 8 * c4); }
}
template <bool KT, bool WQ> __device__ __forceinline__ float prep_compute(const PrepRaw& r, int dir, LAS unsigned char* w, int lane) {
    const int t = dir ? 63 - lane : lane;
    float b[32];
#pragma unroll
    for (int c4 = 0; c4 < 4; ++c4) up8(r.b[c4], b + 8 * c4);
#pragma unroll
    for (int d = 0; d < 32; ++d) b[d] = scan_add_dpp(b[d]);
    if (lane == 63) {
#pragma unroll
        for (int c = 0; c < 8; ++c) *(LAS f32x4*)(w + L_BL + 16 * c) = (f32x4){b[4 * c], b[4 * c + 1], b[4 * c + 2], b[4 * c + 3]}; }
#pragma unroll
    for (int c4 = 0; c4 < 4; ++c4) { v4u kw, qw; float e[8], kk[8];
        up8(r.k[c4], kk);
#pragma unroll
        for (int i = 0; i < 8; ++i) e[i] = __expf(-b[8 * c4 + i]);
        kw.x = cvtpk(kk[0] * e[0], kk[1] * e[1]); kw.y = cvtpk(kk[2] * e[2], kk[3] * e[3]); kw.z = cvtpk(kk[4] * e[4], kk[5] * e[5]); kw.w = cvtpk(kk[6] * e[6], kk[7] * e[7]);
        if (KT) *(LAS v4u*)(w + L_K + (t >> 4) * 1024 + (t & 15) * 64 + c4 * 16) = kw; else *(LAS v4u*)(w + L_K + c4 * 1024 + t * 16) = kw;
        if (WQ) { float qq[8]; up8(r.q[c4], qq);
#pragma unroll
            for (int i = 0; i < 8; ++i) e[i] = 0.17677669529663687f * __expf(b[8 * c4 + i]);
            qw.x = cvtpk(qq[0] * e[0], qq[1] * e[1]); qw.y = cvtpk(qq[2] * e[2], qq[3] * e[3]); qw.z = cvtpk(qq[4] * e[4], qq[5] * e[5]); qw.w = cvtpk(qq[6] * e[6], qq[7] * e[7]);
            *(LAS v4u*)(w + L_Q + c4 * 1024 + t * 16) = qw; } }
    asm volatile("s_waitcnt lgkmcnt(0)" ::: "memory");
    return *(const LAS float*)(w + L_BL + 4 * (lane & 31));
}
__device__ __forceinline__ bf16x8 vfrag(const LAS unsigned char* vb, int vh, int ks) {
    const s16x4 a = vtr(vb + vh * 4096 + ks * 1024), c = vtr(vb + vh * 4096 + ks * 1024 + 512);
    return (bf16x8){a[0], a[1], a[2], a[3], c[0], c[1], c[2], c[3]};
}
__device__ __forceinline__ void unit1(const P& p, LAS unsigned char* lds, int u, int wave, int lane) {
    LAS unsigned char* w = lds + wave * WREG; const int r32 = lane & 31, hi = lane >> 5;
    const LAS unsigned char* trb = w + ((lane >> 4) & 1) * 32 + (lane & 3) * 8 + (4 * hi + ((lane & 15) >> 2)) * 64;
    {
        const int n = u % NCH, ch = u / NCH; const int dir = ch & 1, h = (ch >> 1) % BH, b = ch / (2 * BH);
        const int row0 = chunk_row0(b, dir, n);
        v4u vx[8]; PrepRaw pr;
        load_v_issue(wsb(p, WS_ACT), row0, ZBV + h * 64, lane, vx); prep_issue<false>(p, row0, h, dir, lane, pr);
        load_v_store(w, lane, vx);
        const float bl = prep_compute<true, false>(pr, dir, w, lane);
        asm volatile("s_waitcnt lgkmcnt(0)" ::: "memory");
        const float eb = __expf(bl);
        bf16* so = stg(p) + ((size_t)ch * NCH + n) * 2048;
        bf16x8 kfr[4], vfr1[2][4];
#pragma unroll
        for (int ks = 0; ks < 4; ++ks) { kfr[ks] = vfrag(trb + L_K, 0, ks); vfr1[0][ks] = vfrag(trb + L_V, 0, ks); vfr1[1][ks] = vfrag(trb + L_V, 1, ks); }
#pragma unroll
        for (int vh = 0; vh < 2; ++vh) { f32x16 acc;
#pragma unroll
            for (int r = 0; r < 16; ++r) acc[r] = 0.f;
#pragma unroll
            for (int ks = 0; ks < 4; ++ks) acc = __builtin_amdgcn_mfma_f32_32x32x16_bf16(vfr1[vh][ks], kfr[ks], acc, 0, 0, 0);
#pragma unroll
            for (int r = 0; r < 16; ++r) so[(32 * vh + crow(r, hi)) * 32 + r32] = f2bfh(acc[r] * eb); }
        if (lane < 32) dec(p)[((size_t)ch * NCH + n) * 32 + lane] = eb;
        asm volatile("s_waitcnt lgkmcnt(0)" ::: "memory");
    }
}
__device__ __forceinline__ void pass1(const P& p, LAS unsigned char* lds, int gw, int ngw, int wave, int lane) {
    for (int u = ngw - 1 - gw; u < NCHAIN * NCH; u += ngw) unit1(p, lds, u, wave, lane);
}
__device__ __forceinline__ void pass2(const P& p, int gtid, int nth) {
    bf16* S = stg(p); const float* D = dec(p); static_assert(NCH % (2 * PB) == 0, "pass 2 batch pairs");
    for (int it = gtid; it < NCHAIN * 2048; it += nth) { const int e = it % 2048, ch = it / 2048, d = e & 31;
        float st = 0.f; float locA[PB], ddA[PB], locB[PB], ddB[PB];
#define GLA_P2_LD(loc, dd, n0) _Pragma("unroll") for (int j = 0; j < PB; ++j) { loc[j] = bf2f(S[((size_t)ch * NCH + (n0) + j) * 2048 + e]); dd[j] = D[((size_t)ch * NCH + (n0) + j) * 32 + d]; }
#define GLA_P2_RUN(loc, dd, n0) _Pragma("unroll") for (int j = 0; j < PB; ++j) { S[((size_t)ch * NCH + (n0) + j) * 2048 + e] = f2bfh(st); st = dd[j] * st + loc[j]; }
        GLA_P2_LD(locA, ddA, 0)
        for (int n0 = 0; n0 < NCH; n0 += 2 * PB) {
            GLA_P2_LD(locB, ddB, n0 + PB)
            GLA_P2_RUN(locA, ddA, n0)
            if (n0 + 2 * PB < NCH) { GLA_P2_LD(locA, ddA, n0 + 2 * PB) }
            GLA_P2_RUN(locB, ddB, n0 + PB)
        }
#undef GLA_P2_LD
#undef GLA_P2_RUN
    }
}
__device__ __forceinline__ void unit3(const P& p, LAS unsigned char* lds, int l, bool ctxo, int u, int wave, int lane) {
    LAS unsigned char* w = lds + wave * WREG; const int r32 = lane & 31, hi = lane >> 5;
    const LAS unsigned char* trb = w + ((lane >> 4) & 1) * 32 + (lane & 3) * 8 + (4 * hi + ((lane & 15) >> 2)) * 64;
    const bf16* Z = wsb(p, WS_ACT); bf16* Y = wsb(p, WS_U);
    {
        const int t = u % NCH, h = (u / NCH) % BH, b = u / (NCH * BH);
        if (!ctxo && t < NCC) return;
        const int row0 = nat_row0(b, t);
        f32x16 o[2][2];
#pragma unroll
        for (int tt = 0; tt < 2; ++tt)
#pragma unroll
            for (int vh = 0; vh < 2; ++vh)
#pragma unroll
                for (int r = 0; r < 16; ++r) o[tt][vh][r] = 0.f;
        { v4u vx[8]; load_v_issue(Z, row0, ZBV + h * 64, lane, vx); load_v_store(w, lane, vx); }
#pragma unroll 1
        for (int dir = 0; dir < 2; ++dir) {
            PrepRaw pr; prep_issue<true>(p, row0, h, dir, lane, pr);
            const int ch = (b * BH + h) * 2 + dir; const bf16* sp = stg(p) + ((size_t)ch * NCH + chain_index(t, dir)) * 2048;
            bf16x8 sf[2][2];
#pragma unroll
            for (int vh = 0; vh < 2; ++vh)
#pragma unroll
                for (int d0 = 0; d0 < 2; ++d0) sf[vh][d0] = *(const bf16x8*)(sp + (r32 + 32 * vh) * 32 + 16 * d0 + 8 * hi);
            (void)prep_compute<false, true>(pr, dir, w, lane);
            bf16x8 vfr[2][4];
#pragma unroll
            for (int vh = 0; vh < 2; ++vh)
#pragma unroll
                for (int ks = 0; ks < 4; ++ks) vfr[vh][ks] = vfrag(trb + L_V, vh, ks);
#pragma unroll
            for (int tt = 0; tt < 2; ++tt) {
                bf16x8 qf[2];
#pragma unroll
                for (int d0 = 0; d0 < 2; ++d0) qf[d0] = *(const LAS bf16x8*)(w + L_Q + (2 * d0 + hi) * 1024 + (r32 + 32 * tt) * 16);
#pragma unroll
                for (int vh = 0; vh < 2; ++vh)
#pragma unroll
                    for (int d0 = 0; d0 < 2; ++d0) o[tt][vh] = __builtin_amdgcn_mfma_f32_32x32x16_bf16(sf[vh][d0], qf[d0], o[tt][vh], 0, 0, 0);
#pragma unroll
                for (int sh = 0; sh < 2; ++sh) {
                    if (dir == 0 ? (sh > tt) : (sh < tt)) continue;
                    f32x16 pt;
#pragma unroll
                    for (int r = 0; r < 16; ++r) pt[r] = 0.f;
#pragma unroll
                    for (int d0 = 0; d0 < 2; ++d0) { const bf16x8 kf = *(const LAS bf16x8*)(w + L_K + (2 * d0 + hi) * 1024 + (r32 + 32 * sh) * 16); pt = __builtin_amdgcn_mfma_f32_32x32x16_bf16(kf, qf[d0], pt, 0, 0, 0); }
                    if (sh == tt) {
#pragma unroll
                        for (int r = 0; r < 16; ++r) { const int s = crow(r, hi); if (dir == 0 ? (s > r32) : (s < r32)) pt[r] = 0.f; } }
#pragma unroll
                    for (int k2 = 0; k2 < 2; ++k2) { v4u wv;
                        wv.x = cvtpk(pt[8 * k2], pt[8 * k2 + 1]); wv.y = cvtpk(pt[8 * k2 + 2], pt[8 * k2 + 3]); wv.z = cvtpk(pt[8 * k2 + 4], pt[8 * k2 + 5]); wv.w = cvtpk(pt[8 * k2 + 6], pt[8 * k2 + 7]);
                        const bf16x8 pf = __builtin_bit_cast(bf16x8, wv);
#pragma unroll
                        for (int vh = 0; vh < 2; ++vh) o[tt][vh] = __builtin_amdgcn_mfma_f32_32x32x16_bf16(vfr[vh][2 * sh + k2], pf, o[tt][vh], 0, 0, 0); }
                }
            }
            asm volatile("s_waitcnt lgkmcnt(0)" ::: "memory");
        }
        const float* gn = prm(p, PRM_GNORM) + l * B_VW + h * 64;
#pragma unroll
        for (int tt = 0; tt < 2; ++tt) {
            float s1 = 0.f;
#pragma unroll
            for (int vh = 0; vh < 2; ++vh)
#pragma unroll
                for (int r = 0; r < 16; ++r) s1 += o[tt][vh][r];
            s1 = att::sum32(s1); const float mu = s1 * (1.f / 64.f); float s2 = 0.f;
#pragma unroll
            for (int vh = 0; vh < 2; ++vh)
#pragma unroll
                for (int r = 0; r < 16; ++r) { const float x = o[tt][vh][r] - mu; s2 += x * x; }
            s2 = att::sum32(s2); const float rs = __builtin_amdgcn_rsqf(s2 * (1.f / 64.f) + EPS);
            const int row = row0 + 32 * tt + r32;
            const bf16* zg = Z + (size_t)row * ZP + ZBG + h * 64 + 4 * hi; bf16* yp = Y + (size_t)row * DM + A_OUT + h * 64 + 4 * hi;
#pragma unroll
            for (int vh = 0; vh < 2; ++vh)
#pragma unroll
                for (int rg = 0; rg < 4; ++rg) { const int vo = 32 * vh + 8 * rg; const v2u gz = *(const v2u*)(zg + vo); const f32x4 gg = *(const f32x4*)(gn + vo + 4 * hi);
                    const float g0 = __uint_as_float(gz.x << 16), g1 = __uint_as_float(gz.x & 0xffff0000u), g2 = __uint_as_float(gz.y << 16), g3 = __uint_as_float(gz.y & 0xffff0000u);
                    v2u wv; wv.x = cvtpk(siluf(g0) * (o[tt][vh][4 * rg] - mu) * rs * gg.x, siluf(g1) * (o[tt][vh][4 * rg + 1] - mu) * rs * gg.y);
                    wv.y = cvtpk(siluf(g2) * (o[tt][vh][4 * rg + 2] - mu) * rs * gg.z, siluf(g3) * (o[tt][vh][4 * rg + 3] - mu) * rs * gg.w);
                    *(v2u*)(yp + vo) = wv; }
        }
    }
}
__device__ __forceinline__ void pass3(const P& p, LAS unsigned char* lds, int l, bool ctxo, int gw, int ngw, int wave, int lane) {
    for (int u = ngw - 1 - gw; u < NB * BH * NCH; u += ngw) unit3(p, lds, l, ctxo, u, wave, lane);
}
}

namespace mls {
using att::bf16x8; using att::s16x4; using att::f32x16; using att::crow; using att::cvtpk; using att::vtr; using gla::NCC; using gla::NCL; using gla::NCH; using gla::vfrag; using gla::load_v;
constexpr int WREG = 17408;
constexpr int L_KW = 0, L_T = 16384;
__device__ __forceinline__ bf16* cst(const P& p) { return wsb(p, WS_Y); }
__device__ __forceinline__ float* nst(const P& p) { return wsf(p, WS_MST); }
__device__ __forceinline__ float* sst(const P& p, int which) { return wsf(p, WS_MST) + (size_t)NCHAIN * NCH * (64 + which); }
__device__ __forceinline__ float scan_add(float v, int lane) {
#pragma unroll
    for (int o = 1; o < 64; o <<= 1) { const float u = __shfl_up(v, o); if (lane >= o) v += u; }
    return v;
}
__device__ __forceinline__ float scan_max(float v, int lane) {
#pragma unroll
    for (int o = 1; o < 64; o <<= 1) { const float u = __shfl_up(v, o); if (lane >= o) v = fmaxf(v, u); }
    return v;
}
__device__ __forceinline__ void gates(const P& p, int l, int row0, int h, int dir, int lane, int& t, float& c, float& pm, float& bc) {
    t = dir ? 63 - lane : lane;
    const bf16* zg = wsb(p, WS_ACT) + (size_t)(row0 + t) * ZP + ZCG;
    const float li = bf2f(zg[(2 * dir) * CH + h]), lf = logsigf(bf2f(zg[(2 * dir + 1) * CH + h]) + prm(p, PRM_FBIAS)[(l * 2 + dir) * CH + h]);
    bc = gla::scan_add_dpp(lf); c = li - bc; pm = gla::scan_max_dpp(c);
}
__device__ __forceinline__ void unit1(const P& p, LAS unsigned char* lds, int l, int u, int wave, int lane) {
    LAS unsigned char* w = lds + wave * WREG; const int r32 = lane & 31, hi = lane >> 5;
    const LAS unsigned char* trb = w + ((lane >> 4) & 1) * 32 + (lane & 3) * 8 + (4 * hi + ((lane & 15) >> 2)) * 64;
    LAS float* wt = (LAS float*)(w + L_T);
    const bf16* CQK = wsb(p, WS_CQK);
    {
        const int n = u % NCH, ch = u / NCH; const int dir = ch & 1, h = (ch >> 1) % CH, b = ch / (2 * CH);
        const int row0 = gla::chunk_row0(b, dir, n);
        int t; float c, pm, bc; gates(p, l, row0, h, dir, lane, t, c, pm, bc);
        const float cmax = __int_as_float(__builtin_amdgcn_readlane(__float_as_int(pm), 63)), blast = __int_as_float(__builtin_amdgcn_readlane(__float_as_int(bc), 63));
        wt[t] = __expf(c - cmax) * 0.125f;
        load_v(wsb(p, WS_ACT), row0, ZCV + h * 64, w, lane);
        asm volatile("s_waitcnt lgkmcnt(0)" ::: "memory");
#pragma unroll
        for (int i = 0; i < 8; ++i) { const int idx = i * 64 + lane, s = idx >> 3, cc = idx & 7; const float ws_ = wt[s];
            const v4u x = *(const v4u*)(CQK + (size_t)(row0 + s) * 2 * C_W + C_W + h * 64 + cc * 8); v4u y;
            y.x = cvtpk(__uint_as_float(x.x << 16) * ws_, __uint_as_float(x.x & 0xffff0000u) * ws_); y.y = cvtpk(__uint_as_float(x.y << 16) * ws_, __uint_as_float(x.y & 0xffff0000u) * ws_);
            y.z = cvtpk(__uint_as_float(x.z << 16) * ws_, __uint_as_float(x.z & 0xffff0000u) * ws_); y.w = cvtpk(__uint_as_float(x.w << 16) * ws_, __uint_as_float(x.w & 0xffff0000u) * ws_);
            *(LAS v4u*)(w + L_KW + ((cc >> 2) * 4 + (s >> 4)) * 1024 + (s & 15) * 64 + (cc & 3) * 16) = y; }
        asm volatile("s_waitcnt lgkmcnt(0)" ::: "memory");
        const size_t cn = (size_t)ch * NCH + n;
        bf16* co = cst(p) + cn * 4096;
        const v4u onesv = {0x3f803f80u, 0x3f803f80u, 0x3f803f80u, 0x3f803f80u}; const bf16x8 ones = __builtin_bit_cast(bf16x8, onesv);
        bf16x8 vfr1[2][4];
#pragma unroll
        for (int ks = 0; ks < 4; ++ks) { vfr1[0][ks] = vfrag(trb + gla::L_V, 0, ks); vfr1[1][ks] = vfrag(trb + gla::L_V, 1, ks); }
#pragma unroll
        for (int kh = 0; kh < 2; ++kh) { f32x16 a0, a1, an; bf16x8 kb[4];
#pragma unroll
            for (int ks = 0; ks < 4; ++ks) kb[ks] = vfrag(trb + L_KW, kh, ks);
#pragma unroll
            for (int r = 0; r < 16; ++r) { a0[r] = 0.f; a1[r] = 0.f; an[r] = 0.f; }
#pragma unroll
            for (int ks = 0; ks < 4; ++ks) {
                a0 = __builtin_amdgcn_mfma_f32_32x32x16_bf16(vfr1[0][ks], kb[ks], a0, 0, 0, 0);
                a1 = __builtin_amdgcn_mfma_f32_32x32x16_bf16(vfr1[1][ks], kb[ks], a1, 0, 0, 0);
                an = __builtin_amdgcn_mfma_f32_32x32x16_bf16(ones, kb[ks], an, 0, 0, 0); }
#pragma unroll
            for (int r = 0; r < 16; ++r) { co[(crow(r, hi)) * 64 + 32 * kh + r32] = f2bfh(a0[r]); co[(32 + crow(r, hi)) * 64 + 32 * kh + r32] = f2bfh(a1[r]); }
            if (hi == 0) nst(p)[cn * 64 + 32 * kh + r32] = an[0]; }
        if (lane == 0) { sst(p, 0)[cn] = blast + cmax; sst(p, 1)[cn] = blast; }
        asm volatile("s_waitcnt lgkmcnt(0)" ::: "memory");
    }
}
__device__ __forceinline__ void pass1(const P& p, LAS unsigned char* lds, int l, int gw, int ngw, int wave, int lane) {
    for (int u = gw; u < NCHAIN * NCH; u += ngw) unit1(p, lds, l, u, wave, lane);
}
__device__ __forceinline__ void pass2(const P& p, int gtid, int nth) {
    bf16* C = cst(p); float* N = nst(p); const float* ML_ = sst(p, 0); const float* F = sst(p, 1); float* MP = sst(p, 2);
    for (int it = gtid; it < NCHAIN * 4096; it += nth) { const int e = it % 4096, ch = it / 4096; const bool hn = e < 64;
        float st = 0.f, sn = 0.f, mst = 0.f;
        for (int n0 = 0; n0 < NCH; n0 += gla::PB) { float loc[gla::PB], locn[gla::PB], ml[gla::PB], fl[gla::PB];
#pragma unroll
            for (int j = 0; j < gla::PB; ++j) { const size_t cn = (size_t)ch * NCH + n0 + j; ml[j] = ML_[cn]; fl[j] = F[cn]; loc[j] = bf2f(C[cn * 4096 + e]); locn[j] = hn ? N[cn * 64 + e] : 0.f; }
#pragma unroll
            for (int j = 0; j < gla::PB; ++j) { const size_t cn = (size_t)ch * NCH + n0 + j;
                const float mn = fmaxf(fl[j] + mst, ml[j]), a = __expf(fl[j] + mst - mn), ee = __expf(ml[j] - mn);
                C[cn * 4096 + e] = f2bfh(st); if (hn) N[cn * 64 + e] = sn;
                st = a * st + ee * loc[j]; sn = a * sn + ee * locn[j]; if (e == 0) MP[cn] = mst; mst = mn; } } }
}
__device__ __forceinline__ void unit3(const P& p, LAS unsigned char* lds, int l, bool ctxo, int u, int wave, int lane) {
    LAS unsigned char* w = lds + wave * WREG; const int r32 = lane & 31, hi = lane >> 5;
    const LAS unsigned char* trb = w + ((lane >> 4) & 1) * 32 + (lane & 3) * 8 + (4 * hi + ((lane & 15) >> 2)) * 64;
    LAS float* tb = (LAS float*)(w + L_KW);
    const bf16* Z = wsb(p, WS_ACT); const bf16* CQK = wsb(p, WS_CQK); bf16* Y = wsb(p, WS_U);
    {
        const int tt = u & 1, tc = (u >> 1) % NCH, h = ((u >> 1) / NCH) % CH, b = (u >> 1) / (NCH * CH);
        if (!ctxo && tc < NCC) return;
        const int row0 = gla::nat_row0(b, tc);
        load_v(Z, row0, ZCV + h * 64, w, lane);
#pragma unroll
        for (int dir = 0; dir < 2; ++dir) { const size_t cn = (size_t)((b * CH + h) * 2 + dir) * NCH + gla::chain_index(tc, dir);
            const float mprev = sst(p, 2)[cn];
            int t; float c, pm, bc; gates(p, l, row0, h, dir, lane, t, c, pm, bc);
            const float Mt = fmaxf(mprev, pm);
            tb[dir * 256 + t] = c; tb[dir * 256 + 64 + t] = Mt; tb[dir * 256 + 128 + t] = __expf(mprev - Mt); tb[dir * 256 + 192 + t] = bc + Mt; }
        asm volatile("s_waitcnt lgkmcnt(0)" ::: "memory");
        {
            f32x16 tot[2];
#pragma unroll
            for (int vh = 0; vh < 2; ++vh)
#pragma unroll
                for (int r = 0; r < 16; ++r) tot[vh][r] = 0.f;
            const int tl = 32 * tt + r32;
#pragma unroll 1
            for (int dir = 0; dir < 2; ++dir) {
                const float Mt = tb[dir * 256 + 64 + tl], at = tb[dir * 256 + 128 + tl], mt = tb[dir * 256 + 192 + tl];
                bf16x8 qf[4];
#pragma unroll
                for (int d0 = 0; d0 < 4; ++d0) qf[d0] = *(const bf16x8*)(CQK + (size_t)(row0 + tl) * 2 * C_W + h * 64 + 16 * d0 + 8 * hi);
                const size_t cn = (size_t)((b * CH + h) * 2 + dir) * NCH + gla::chain_index(tc, dir);
                const bf16* cp = cst(p) + cn * 4096; const float* np = nst(p) + cn * 64;
                f32x16 num[2]; float den = 0.f;
#pragma unroll
                for (int vh = 0; vh < 2; ++vh) {
#pragma unroll
                    for (int r = 0; r < 16; ++r) num[vh][r] = 0.f;
#pragma unroll
                    for (int d0 = 0; d0 < 4; ++d0) { const bf16x8 cf = *(const bf16x8*)(cp + (r32 + 32 * vh) * 64 + 16 * d0 + 8 * hi); num[vh] = __builtin_amdgcn_mfma_f32_32x32x16_bf16(cf, qf[d0], num[vh], 0, 0, 0); } }
#pragma unroll
                for (int d0 = 0; d0 < 4; ++d0) { const v4u qu = __builtin_bit_cast(v4u, qf[d0]); const f32x4 n0 = *(const f32x4*)(np + 16 * d0 + 8 * hi), n1 = *(const f32x4*)(np + 16 * d0 + 8 * hi + 4);
                    den += __uint_as_float(qu.x << 16) * n0.x + __uint_as_float(qu.x & 0xffff0000u) * n0.y + __uint_as_float(qu.y << 16) * n0.z + __uint_as_float(qu.y & 0xffff0000u) * n0.w
                         + __uint_as_float(qu.z << 16) * n1.x + __uint_as_float(qu.z & 0xffff0000u) * n1.y + __uint_as_float(qu.w << 16) * n1.z + __uint_as_float(qu.w & 0xffff0000u) * n1.w; }
                den *= at;
#pragma unroll
                for (int vh = 0; vh < 2; ++vh)
#pragma unroll
                    for (int r = 0; r < 16; ++r) num[vh][r] *= at;
#pragma unroll
                for (int sh = 0; sh < 2; ++sh) {
                    if (dir == 0 ? (sh > tt) : (sh < tt)) continue;
                    f32x16 st;
#pragma unroll
                    for (int r = 0; r < 16; ++r) st[r] = 0.f;
#pragma unroll
                    for (int d0 = 0; d0 < 4; ++d0) { const bf16x8 kf = *(const bf16x8*)(CQK + (size_t)(row0 + 32 * sh + r32) * 2 * C_W + C_W + h * 64 + 16 * d0 + 8 * hi); st = __builtin_amdgcn_mfma_f32_32x32x16_bf16(kf, qf[d0], st, 0, 0, 0); }
#pragma unroll
                    for (int rg = 0; rg < 4; ++rg) { const f32x4 cs = *(const LAS f32x4*)(tb + dir * 256 + 32 * sh + 8 * rg + 4 * hi);
#pragma unroll
                        for (int i = 0; i < 4; ++i) { const int r = 4 * rg + i; const int s = crow(r, hi);
                            float wgt = __expf(cs[i] - Mt) * 0.125f;
                            if (sh == tt && (dir == 0 ? (s > r32) : (s < r32))) wgt = 0.f;
                            st[r] *= wgt; den += st[r]; } }
#pragma unroll
                    for (int k2 = 0; k2 < 2; ++k2) { v4u wv;
                        wv.x = cvtpk(st[8 * k2], st[8 * k2 + 1]); wv.y = cvtpk(st[8 * k2 + 2], st[8 * k2 + 3]); wv.z = cvtpk(st[8 * k2 + 4], st[8 * k2 + 5]); wv.w = cvtpk(st[8 * k2 + 6], st[8 * k2 + 7]);
                        const bf16x8 pf = __builtin_bit_cast(bf16x8, wv);
#pragma unroll
                        for (int vh = 0; vh < 2; ++vh) num[vh] = __builtin_amdgcn_mfma_f32_32x32x16_bf16(vfrag(trb + gla::L_V, vh, 2 * sh + k2), pf, num[vh], 0, 0, 0); }
                }
                den = att::sum32(den);
                const float inv = __builtin_amdgcn_rcpf(fmaxf(fabsf(den), __expf(-mt)));
#pragma unroll
                for (int vh = 0; vh < 2; ++vh)
#pragma unroll
                    for (int r = 0; r < 16; ++r) tot[vh][r] += num[vh][r] * inv;
            }
            const float* gn = prm(p, PRM_MNORM) + l * C_W + h * 64;
            float s1 = 0.f;
#pragma unroll
            for (int vh = 0; vh < 2; ++vh)
#pragma unroll
                for (int r = 0; r < 16; ++r) s1 += tot[vh][r];
            s1 = att::sum32(s1); const float mu = s1 * (1.f / 64.f); float s2 = 0.f;
#pragma unroll
            for (int vh = 0; vh < 2; ++vh)
#pragma unroll
                for (int r = 0; r < 16; ++r) { const float x = tot[vh][r] - mu; s2 += x * x; }
            s2 = att::sum32(s2); const float rs = __builtin_amdgcn_rsqf(s2 * (1.f / 64.f) + EPS);
            const int row = row0 + tl;
            const bf16* zg = Z + (size_t)row * ZP + ZCO + h * 64 + 4 * hi; bf16* yp = Y + (size_t)row * DM + A_OUT + B_VW + h * 64 + 4 * hi;
#pragma unroll
            for (int vh = 0; vh < 2; ++vh)
#pragma unroll
                for (int rg = 0; rg < 4; ++rg) { const int vo = 32 * vh + 8 * rg; const v2u gz = *(const v2u*)(zg + vo); const f32x4 gg = *(const f32x4*)(gn + vo + 4 * hi);
                    const float g0 = __uint_as_float(gz.x << 16), g1 = __uint_as_float(gz.x & 0xffff0000u), g2 = __uint_as_float(gz.y << 16), g3 = __uint_as_float(gz.y & 0xffff0000u);
                    v2u wv; wv.x = cvtpk(sigmf(g0) * (tot[vh][4 * rg] - mu) * rs * gg.x, sigmf(g1) * (tot[vh][4 * rg + 1] - mu) * rs * gg.y);
                    wv.y = cvtpk(sigmf(g2) * (tot[vh][4 * rg + 2] - mu) * rs * gg.z, sigmf(g3) * (tot[vh][4 * rg + 3] - mu) * rs * gg.w);
                    *(v2u*)(yp + vo) = wv; }
        }
        asm volatile("s_waitcnt lgkmcnt(0)" ::: "memory");
    }
}
__device__ __forceinline__ void pass3(const P& p, LAS unsigned char* lds, int l, bool ctxo, int gw, int ngw, int wave, int lane) {
    for (int u = gw; u < NB * CH * NCH * 2; u += ngw) unit3(p, lds, l, ctxo, u, wave, lane);
}
}


__device__ __forceinline__ int wg_next(LAS unsigned* ctr, int lane) { unsigned k = 0u; if (lane == 0) k = __hip_atomic_fetch_add(ctr, 1u, __ATOMIC_RELAXED, __HIP_MEMORY_SCOPE_WORKGROUP); return (int)__builtin_amdgcn_readfirstlane(k); }
__device__ __forceinline__ void mixer_p1_items(const P& p, LAS unsigned char* lds, int l, int tid, int wave, int lane) {
    LAS unsigned* ctr = (LAS unsigned*)(lds + MISC_OFF + 128);
    __syncthreads(); if (tid == 0) *ctr = 0u; __syncthreads();
    const int c = blockIdx.x, G = gridDim.x; constexpr int NU = NCHAIN * gla::NCH; const int n = c < NU ? (NU - c + G - 1) / G : 0;
    for (;;) { const int k = wg_next(ctr, lane); if (k >= 2 * n) break;
        if (k < n) mls::unit1(p, lds, l, c + G * k, wave, lane); else gla::unit1(p, lds, c + G * (k - n), wave, lane); }
}
__device__ __forceinline__ void mixer_p3_items(const P& p, LAS unsigned char* lds, int l, bool ctxo, int tid, int wave, int lane) {
    LAS unsigned* ctr = (LAS unsigned*)(lds + MISC_OFF + 128);
    __syncthreads(); if (tid == 0) *ctr = 0u; __syncthreads();
    const int c = blockIdx.x, G = gridDim.x; constexpr int NG3 = NB * BH * gla::NCH, NM3 = NB * CH * gla::NCH * 2;
    const int ng = c < NG3 ? (NG3 - c + G - 1) / G : 0, nm = c < NM3 ? (NM3 - c + G - 1) / G : 0;
    for (;;) { const int k = wg_next(ctr, lane); if (k >= ng + nm) break;
        if (k < ng) gla::unit3(p, lds, l, ctxo, c + G * k, wave, lane); else mls::unit3(p, lds, l, ctxo, c + G * (k - ng), wave, lane); }
}
#define PROJ_THIN(A_, WT_, KK_, CTX_, THIN_LAT_, THIN_CTX_, EXTRA_, SUBI_) do { \
    { pg8::Gemm g_{(A_), (WT_), ML, DM, (KK_)}; pg8::StaticOrder S_; S_.init(ML, DM, G, (int)blockIdx.x); pg8::EpiPlain E_{wsb(p, WS_Y), DM, nullptr}; \
      pg8::gemm_phase<pg8::EpiPlain, pg8::StaticOrder, true, true>(lds, g_, S_, E_); } \
    SEAM(); \
    if (CTX_) { \
        if (blockIdx.x < NSUBWG) { const int ks_ = (int)blockIdx.x >> 5, kh_ = (KK_) / 2; \
            pg8::Gemm g_{(A_) + (size_t)ML * (KK_) + ks_ * kh_, (WT_) + ks_ * kh_, MC, DM, kh_, (KK_)}; pg8::StaticOrder S_; S_.init(MC, DM, 32, (int)blockIdx.x & 31); \
            pg8::EpiPlain E_{ks_ ? wsb(p, WS_HC) : wsb(p, WS_Y) + (size_t)ML * DM, DM, nullptr}; \
            pg8::gemm_phase<pg8::EpiPlain, pg8::StaticOrder, true, true>(lds, g_, S_, E_); \
            sub_barrier(ctl + CW_SUB + 64 * (SUBI_), NSUBWG); \
            { const int gw_ = gw, ngw_ = NSUBWG * NWAVES; EXTRA_; THIN_CTX_; } } \
        else { const int gw_ = gw - NSUBWG * NWAVES, ngw_ = ngw - NSUBWG * NWAVES; THIN_LAT_; } \
        SEAM(); \
    } else { const int gw_ = gw, ngw_ = ngw; EXTRA_; THIN_LAT_; SEAM(); } \
} while (0)
__global__ void __launch_bounds__(NTHREADS, 2) fwd(P p) {
    extern __shared__ __attribute__((aligned(16))) unsigned char lds_raw[];
    LAS unsigned char* lds = (LAS unsigned char*)lds_raw;
    const int tid = threadIdx.x, lane = tid & 63, wave = __builtin_amdgcn_readfirstlane(tid >> 6);
    const int G = gridDim.x, gtid = blockIdx.x * NTHREADS + tid, nth = G * NTHREADS, gw = blockIdx.x * NWAVES + wave, ngw = G * NWAVES;
    volatile LAS unsigned* MISC = (volatile LAS unsigned*)(lds + MISC_OFF);
    for (int u = tid; u < (LDS_BYTES - RING_BYTES) / 4; u += NTHREADS) ((LAS unsigned*)(lds + RING_BYTES))[u] = 0u;
    __syncthreads();
    unsigned* ctl = (unsigned*)(p.ws + WS_CTL);
    XcdBarrier bar; bar.bar = ctl + CW_BAR; bar.x = 0; bar.st = nullptr;
    if (p.one) bar = xcd_barrier_post(ctl + CW_BAR, MISC + 8);
#define SEAM() do { if (p.one) xcd_barrier(bar); } while (0)
    const int lo = p.ph_lo, hi = p.ph_hi;
#define IN(k) (lo <= (k) && (k) < hi)
    if (p.layer < 0 || p.one) {
        if (IN(0)) { ph_modpart_gpu(p, lds, tid, gtid, nth); ph_wconv(p, 0, lds, gw, ngw, wave, lane); ph_init(p, gtid, nth); SEAM(); }
        if (IN(1)) { ph_vec(p, gtid, nth); SEAM(); }
        if (IN(2)) { ph_thin<false, true>(p, 0, 0, 0, 0, gw, ngw, lane); SEAM(); }
    }
    const int l0 = p.one ? 0 : p.layer, l1 = p.one ? DEPTH : p.layer + 1;
    for (int l = (l0 < 0 ? DEPTH : l0); l < l1; ++l) {
        int tid_l = tid; asm volatile("" : "+v"(tid_l));
        const int lane = tid_l & 63, gtid = blockIdx.x * NTHREADS + tid_l, gw = blockIdx.x * NWAVES + __builtin_amdgcn_readfirstlane(tid_l >> 6);
        if (IN(3)) { pg8::Gemm g{wsb(p, WS_U), wl(p, l, WL_GU1), M, 2 * DFF, DM}; pg8::StaticOrder S; S.init(M, 2 * DFF, G, (int)blockIdx.x);
            pg8::EpiSwiglu E{wsb(p, WS_ACT), DFF}; pg8::gemm_phase<pg8::EpiSwiglu, pg8::StaticOrder, true, true>(lds, g, S, E);
            { const int t0 = ((M / 256) * (2 * DFF / 256)) % G;
              if (l + 1 < DEPTH && (int)blockIdx.x >= t0) ph_wconv(p, l + 1, lds, gw - t0 * NWAVES, (G - t0) * NWAVES, gw & 7, lane, 0, 2 * WCONV_ITEMS / 5); }
            SEAM(); }
        if (IN(4)) { PROJ_THIN(wsb(p, WS_ACT), wl(p, l, WL_D1), DFF, true, (ph_thin<true, true>(p, l, 0, l, 1, gw_, ngw_, lane, ML, 0)), (ph_thin<true, true, true>(p, l, 0, l, 1, gw_, ngw_, lane, M, ML)), (void)0, 3 * l); }
        if (IN(6)) { pg8::Gemm g{wsb(p, WS_U), wl(p, l, WL_IN), M, ZP, DM}; pg8::StaticOrder S; S.init(M, ZP, G, (int)blockIdx.x);
            pg8::EpiPlain E{wsb(p, WS_ACT), ZP, wsf(p, WS_BINP) + (size_t)l * ZP}; pg8::gemm_phase<pg8::EpiPlain, pg8::StaticOrder, true, true>(lds, g, S, E);
            { const int t0 = ((M / 256) * (ZP / 256)) % G;
              if (l + 1 < DEPTH && (int)blockIdx.x >= t0) ph_wconv(p, l + 1, lds, gw - t0 * NWAVES, (G - t0) * NWAVES, gw & 7, lane, 2 * WCONV_ITEMS / 5, 3 * WCONV_ITEMS / 5); }
            SEAM(); }
        if (IN(7)) { ph_zpost(p, l, gtid, nth); SEAM(); }
        if (IN(8)) { att::phase(p, lds, l, l + 1 < DEPTH, tid_l); mixer_p1_items(p, lds, l, tid_l, gw & 7, lane); SEAM();
#ifdef DBG_GLA
            if (l == DBG_GLA - 1) { const bf16* sg = wsb(p, WS_SG); int bad = 0; for (long i = gtid; i < (long)NCHAIN * gla::NCH * 2048; i += nth) if (!(fabsf(bf2f(sg[i])) < 1e30f)) bad = 1;
                const float* dd = wsf(p, WS_GST); for (long i = gtid; i < (long)NCHAIN * gla::NCH * 32; i += nth) if (!(fabsf(dd[i]) < 1e30f)) bad = 1;
                if (__any(bad) && (tid_l & 63) == 0) atomicAdd(ctl + 19, 1u); SEAM(); }
#endif
        }
        if (IN(9)) { gla::pass2(p, gtid, nth); mls::pass2(p, gtid, nth); SEAM();
#ifdef DBG_GLA
            if (l == DBG_GLA - 1) { const bf16* sg = wsb(p, WS_SG); int bad = 0; for (long i = gtid; i < (long)NCHAIN * gla::NCH * 2048; i += nth) if (!(fabsf(bf2f(sg[i])) < 1e30f)) bad = 1;
                if (__any(bad) && (tid_l & 63) == 0) atomicAdd(ctl + 20, 1u); SEAM(); }
#endif
        }
#ifndef DBG_GLA
        if (IN(10)) { mixer_p3_items(p, lds, l, l + 1 < DEPTH, tid_l, gw & 7, lane); SEAM(); }
#else
        if (IN(10)) { gla::pass3(p, lds, l, true, gw, ngw, gw & 7, lane); ph_ml3(p, l, gtid, nth); SEAM();
            { bf16* sv = wsb(p, WS_SG); const bf16* Y = wsb(p, WS_U); for (long i = gtid; i < (long)M * B_VW; i += nth) { const int r = (int)(i / B_VW), c = (int)(i % B_VW); sv[i] = Y[(size_t)r * DM + A_OUT + c]; } }
            SEAM(); ph_gla1(p, gtid, nth); SEAM(); ph_gla2(p, gtid, nth); SEAM(); ph_gla3(p, gtid, nth); SEAM(); }
        if (IN(11)) { ph_headln(p, l, gtid, nth, 0); SEAM();
            if (l == DBG_GLA - 1) { const bf16* sv = wsb(p, WS_SG); const bf16* Y = wsb(p, WS_U); float num = 0.f, den = 0.f; int bad = 0;
                for (long i = gtid; i < (long)M * B_VW; i += nth) { const int r = (int)(i / B_VW), c = (int)(i % B_VW); const float a = bf2f(sv[i]), b = bf2f(Y[(size_t)r * DM + A_OUT + c]);
                    if (!(fabsf(a) < 1e30f)) { bad = 1; } else { num += (a - b) * (a - b); } den += b * b; }
                num = wave_sum(num); den = wave_sum(den); bad = __any(bad) ? 1 : 0;
                if ((tid_l & 63) == 0) { atomicAdd((float*)(ctl + 16), num); atomicAdd((float*)(ctl + 17), den); if (bad) atomicAdd(ctl + 18, 1u); } }
            SEAM(); }
#endif
        const int mr = (l + 1 < DEPTH) ? M : ML;
        if (IN(12) && G == 256 && DM == 1024) {
            pg8::Gemm g{wsb(p, WS_U), wl(p, l, WL_OUT), ML, DM, DM};
            unsigned* pc = ctl + CW_PAN + 8192 + 16384 * l;
            { pg8::RoundOrder S; S.init(ML, DM, G, (int)blockIdx.x); S.rnd = 0;
              pg8::EpiMid E{wsb(p, WS_HB), wsb(p, WS_U), vecp(p, l, 1, 2, 0), vecp(p, l, 2, 0, 0), vecp(p, l, 2, 1, 0), SEQ, EPS, pg8::PanelSS{wsf(p, WS_XS) + (size_t)ML * 4, pc}, pg8::PanelSS{wsf(p, WS_XS) + (size_t)2 * ML * 4, pc + 8192}};
              pg8::gemm_phase<pg8::EpiMid, pg8::RoundOrder, true, true>(lds, g, S, E); }
            __syncthreads();
            { pg8::RoundOrder S; S.init(ML, DM, G, (int)blockIdx.x); S.rnd = 1;
              pg8::EpiMid E{wsb(p, WS_HB), wsb(p, WS_U), vecp(p, l, 1, 2, 0), vecp(p, l, 2, 0, 0), vecp(p, l, 2, 1, 0), SEQ, EPS, pg8::PanelSS{wsf(p, WS_XS) + (size_t)ML * 4, pc}, pg8::PanelSS{wsf(p, WS_XS) + (size_t)2 * ML * 4, pc + 8192}};
              pg8::gemm_phase<pg8::EpiMid, pg8::RoundOrder, true, true>(lds, g, S, E); }
            if (l + 1 < DEPTH && blockIdx.x < NSUBWG) { __syncthreads();
                const int ks_ = (int)blockIdx.x >> 5, kh_ = DM / 2;
                pg8::Gemm g_{wsb(p, WS_U) + (size_t)ML * DM + ks_ * kh_, wl(p, l, WL_OUT) + ks_ * kh_, MC, DM, kh_, DM}; pg8::StaticOrder S_; S_.init(MC, DM, 32, (int)blockIdx.x & 31);
                pg8::EpiPlain E_{ks_ ? wsb(p, WS_HC) : wsb(p, WS_Y) + (size_t)ML * DM, DM, nullptr};
                pg8::gemm_phase<pg8::EpiPlain, pg8::StaticOrder, true, true>(lds, g_, S_, E_);
                sub_barrier(ctl + CW_SUB + 64 * (3 * l + 1), NSUBWG);
                ph_thin<true, true, true>(p, l, 1, l, 2, gw, NSUBWG * NWAVES, lane, M, ML); }
            SEAM(); }
        else if (IN(12)) { PROJ_THIN(wsb(p, WS_U), wl(p, l, WL_OUT), DM, l + 1 < DEPTH, (ph_thin<true, true>(p, l, 1, l, 2, gw_, ngw_, lane, ML, 0)), (ph_thin<true, true, true>(p, l, 1, l, 2, gw_, ngw_, lane, M, ML)), (void)0, 3 * l + 1); }
        if (IN(14)) { pg8::Gemm g{wsb(p, WS_U), wl(p, l, WL_GU2), mr, 2 * DFF, DM}; pg8::StaticOrder S; S.init(mr, 2 * DFF, G, (int)blockIdx.x);
            pg8::EpiSwiglu E{wsb(p, WS_ACT), DFF}; pg8::gemm_phase<pg8::EpiSwiglu, pg8::StaticOrder, true, true>(lds, g, S, E);
            { const int t0 = ((M / 256) * (2 * DFF / 256)) % G;
              if (l + 1 < DEPTH && (int)blockIdx.x >= t0) ph_wconv(p, l + 1, lds, gw - t0 * NWAVES, (G - t0) * NWAVES, gw & 7, lane, 3 * WCONV_ITEMS / 5, WCONV_ITEMS); }
            SEAM(); }
        if (IN(15)) { if (l + 1 < DEPTH) { PROJ_THIN(wsb(p, WS_ACT), wl(p, l, WL_D2), DFF, true, (ph_thin<true, true>(p, l, 2, l + 1, 0, gw_, ngw_, lane, ML, 0)), (ph_thin<true, true, true>(p, l, 2, l + 1, 0, gw_, ngw_, lane, M, ML)), (void)0, 3 * l + 2); }
            else if (G == 256 && DM == 1024) {
                pg8::Gemm g{wsb(p, WS_ACT), wl(p, l, WL_D2), ML, DM, DFF};
                { pg8::RoundOrder S; S.init(ML, DM, G, (int)blockIdx.x); S.rnd = 0;
                  pg8::EpiFinal E{wsb(p, WS_HB), p.out, vecp(p, l, 2, 2, 0), SEQ, EPS, pg8::PanelSS{wsf(p, WS_XS), ctl + CW_PAN}}; pg8::gemm_phase<pg8::EpiFinal, pg8::RoundOrder, true, true>(lds, g, S, E); }
                __syncthreads();
                { pg8::RoundOrder S; S.init(ML, DM, G, (int)blockIdx.x); S.rnd = 1;
                  pg8::EpiFinal E{wsb(p, WS_HB), p.out, vecp(p, l, 2, 2, 0), SEQ, EPS, pg8::PanelSS{wsf(p, WS_XS), ctl + CW_PAN}}; pg8::gemm_phase<pg8::EpiFinal, pg8::RoundOrder, true, true>(lds, g, S, E); }
            }
            else { PROJ_THIN(wsb(p, WS_ACT), wl(p, l, WL_D2), DFF, false, (ph_thin<true, false>(p, l, 2, l, 2, gw_, ngw_, lane, ML, 0)), (void)0, (void)0, 0);
#ifdef DBG_GLA
            SEAM(); { const float num = __hip_atomic_load((float*)(ctl + 16), __ATOMIC_RELAXED, __HIP_MEMORY_SCOPE_AGENT), den = __hip_atomic_load((float*)(ctl + 17), __ATOMIC_RELAXED, __HIP_MEMORY_SCOPE_AGENT);
                const unsigned bad = __hip_atomic_load(ctl + 18, __ATOMIC_RELAXED, __HIP_MEMORY_SCOPE_AGENT);
                float code = num / fmaxf(den, 1e-20f); if (!(code < 0.8f)) code = 0.8f; if (bad) code = 0.95f;
                if (__hip_atomic_load(ctl + 20, __ATOMIC_RELAXED, __HIP_MEMORY_SCOPE_AGENT)) code = 0.5f; if (__hip_atomic_load(ctl + 19, __ATOMIC_RELAXED, __HIP_MEMORY_SCOPE_AGENT)) code = 0.3f;
                const float sc = 1.f + sqrtf(code); for (long i = gtid; i < (long)ML * DM; i += nth) p.out[i] *= sc; }
#endif
        } }
    }
#undef IN
#undef SEAM
}

#ifndef ONE_LAUNCH
#define ONE_LAUNCH 1
#endif
extern "C" void kernel_launch(void* const* d_in, const int* in_sizes, int n_in, void* d_out, int out_size, void* d_ws, size_t ws_size, hipStream_t stream) {
    static int grid = 0;
    if (grid == 0) {
        if (n_in != N_IN || in_sizes[0] != ML * DM || out_size != ML * DM || ws_size < WS_END) {
            fprintf(stderr, "kernel_launch: unexpected shapes (n_in %d, in0 %d, out %d, ws %zu < %zu); nothing launched\n", n_in, n_in > 0 ? in_sizes[0] : -1, out_size, ws_size, (size_t)WS_END); grid = -1; return; }
        int dev = 0, cus = 0, per_cu = 0;
        if (hipGetDevice(&dev) != hipSuccess || hipDeviceGetAttribute(&cus, hipDeviceAttributeMultiprocessorCount, dev) != hipSuccess) { grid = -1; return; }
        if (hipFuncSetAttribute((const void*)fwd, hipFuncAttributeMaxDynamicSharedMemorySize, LDS_BYTES) != hipSuccess) { fprintf(stderr, "kernel_launch: hipFuncSetAttribute failed\n"); grid = -1; return; }
        if (hipOccupancyMaxActiveBlocksPerMultiprocessor(&per_cu, (const void*)fwd, NTHREADS, LDS_BYTES) != hipSuccess || per_cu < 1) fprintf(stderr, "kernel_launch: occupancy query says %d\n", per_cu);
        (void)hipGetLastError();
        grid = cus;
    }
    if (grid < 0) return;
    (void)hipMemsetAsync((char*)d_ws + WS_CTL, 0, CTL_BYTES, stream);
    P a{};
    for (int i = 0; i < N_IN; ++i) a.in[i] = (const float*)d_in[i];
    a.out = (float*)d_out; a.ws = (unsigned char*)d_ws;
#if ONE_LAUNCH
    a.layer = 0; a.ph_lo = 0; a.ph_hi = 17; a.one = 1;
    hipLaunchKernelGGL(fwd, dim3(grid), dim3(NTHREADS), LDS_BYTES, stream, a);
#else
    a.one = 0;
    for (int k = 0; k < 3; ++k) { a.layer = -1; a.ph_lo = k; a.ph_hi = k + 1; hipLaunchKernelGGL(fwd, dim3(grid), dim3(NTHREADS), LDS_BYTES, stream, a); }
    for (int l = 0; l < DEPTH; ++l) for (int k = 3; k < 17; ++k) { a.layer = l; a.ph_lo = k; a.ph_hi = k + 1; hipLaunchKernelGGL(fwd, dim3(grid), dim3(NTHREADS), LDS_BYTES, stream, a); }
#endif
}
#endif
```
